# Optimizing an MI355X kernel written in HIP

```python
import jax, jax.numpy as jnp
from jax import lax
import numpy as np

D_MODEL = 1024
BATCH = 8
SEQ = 2048
DEPTH = 4

GRID_W = 64
CTX_LEN = 256
HEAD_DIM = 64
NA_HEADS = 4
NA_WIN_ROWS = 8
NA_WIN_COLS = 16
NA_SCALE = HEAD_DIM ** -0.5
POOL_GROUPS = 4
POOL_CH = 64
POOL_WINDOWS = (2, 4, 8, 16)
FFT_GROUPS = 4
FFT_CH = 64
MLA_HEADS = 4
MLA_Q_RANK = 256
MLA_KV_RANK = 128
MLA_NOPE = 64
MLA_ROPE = 32
MLA_V = 64
MLA_SCALE = (MLA_NOPE + MLA_ROPE) ** -0.5
ROPE_BASE = 10000.0
NA_W = NA_HEADS * HEAD_DIM
POOL_W = POOL_GROUPS * POOL_CH
FFT_W = FFT_GROUPS * FFT_CH
MLA_W = MLA_HEADS * MLA_V
BRANCH_W = NA_W
N_BRANCH = 4
IN_SPLITS = tuple(int(s) for s in np.cumsum([NA_W, NA_W, NA_W, POOL_W, FFT_W, MLA_Q_RANK, MLA_KV_RANK, MLA_ROPE]))
IN_COLS = IN_SPLITS[-1] + N_BRANCH * D_MODEL
N_EXPERTS = 16
EXPERT_FF = 2048
EC_CAPACITY = 2
QUERY_BLOCK = 128
DN_ALPHA = (2 * DEPTH) ** 0.25
DN_BETA = (8 * DEPTH) ** -0.25
LN_EPS = 1e-5
NEG = -1e30

kernel_name = "hybrid_na_pool_fourier_mla_ecmoe_dit"


def layer_norm(x, g, b):
    xf = x.astype(jnp.float32)
    mu = xf.mean(-1, keepdims=True)
    var = jnp.square(xf - mu).mean(-1, keepdims=True)
    y = (xf - mu) * lax.rsqrt(var + LN_EPS)
    return (y * g.astype(jnp.float32) + b.astype(jnp.float32)).astype(x.dtype)


def rms_norm(x, g):
    xf = x.astype(jnp.float32)
    y = xf * lax.rsqrt(jnp.mean(xf * xf, -1, keepdims=True) + LN_EPS)
    return (y * g.astype(jnp.float32)).astype(x.dtype)


def axial_rope(L):
    n_freq = MLA_ROPE // 4
    inv = ROPE_BASE ** (-jnp.arange(n_freq, dtype=jnp.float32) / n_freq)
    t = jnp.arange(L)
    row = (t // GRID_W).astype(jnp.float32)
    col = (t % GRID_W).astype(jnp.float32)
    ang = jnp.concatenate([row[:, None] * inv, col[:, None] * inv], axis=-1)
    return jnp.cos(ang), jnp.sin(ang)


def apply_rope(x, cos, sin):
    xf = x.astype(jnp.float32)
    x1, x2 = xf[..., 0::2], xf[..., 1::2]
    c, s = cos[None, :, None, :], sin[None, :, None, :]
    out = jnp.stack([x1 * c - x2 * s, x1 * s + x2 * c], axis=-1).reshape(x.shape)
    return out.astype(x.dtype)


def attend(q, k, v, scale):
    s = jnp.einsum('bqhd,bkhd->bhqk', q, k).astype(jnp.float32) * scale
    p = jax.nn.softmax(s, axis=-1).astype(v.dtype)
    return jnp.einsum('bhqk,bkhd->bqhd', p, v)


def attend_blocked(q, k, v, scale):
    B, L, H, dk = q.shape
    nb = L // QUERY_BLOCK
    qb = q.reshape(B, nb, QUERY_BLOCK, H, dk).transpose(1, 0, 2, 3, 4)
    out = lax.map(lambda qi: attend(qi, k, v, scale), qb)
    return out.transpose(1, 0, 2, 3, 4).reshape(B, L, H, v.shape[-1])


def neighborhood_attention(q, k, v, kc, vc, rpb):
    B, L, H, d = q.shape
    R = L // GRID_W
    kr = min(NA_WIN_ROWS, R)
    rows = jnp.arange(R)
    r0 = jnp.clip(rows - kr // 2, 0, R - kr)
    row_idx = r0[:, None] + jnp.arange(kr)[None, :]
    cols = jnp.arange(GRID_W)
    c0 = jnp.clip(cols - NA_WIN_COLS // 2, 0, GRID_W - NA_WIN_COLS)
    col_in = (cols[None, :] >= c0[:, None]) & (cols[None, :] < c0[:, None] + NA_WIN_COLS)
    row_off = row_idx - rows[:, None] + (NA_WIN_ROWS - 1)
    col_off = jnp.clip(cols[None, :] - cols[:, None], -(NA_WIN_COLS - 1), NA_WIN_COLS - 1) + (NA_WIN_COLS - 1)
    bias = rpb[:, row_off[:, None, :, None], col_off[None, :, None, :]].astype(jnp.float32)
    bias = jnp.where(col_in[None, None, :, None, :], bias, NEG)
    qg = q.reshape(B, R, GRID_W, H, d)
    kg = k.reshape(B, R, GRID_W, H, d)[:, row_idx]
    vg = v.reshape(B, R, GRID_W, H, d)[:, row_idx]
    s_win = jnp.einsum('brqhd,brkchd->bhrqkc', qg, kg).astype(jnp.float32) * NA_SCALE + bias[None]
    s_ctx = jnp.einsum('brqhd,bkhd->bhrqk', qg, kc).astype(jnp.float32) * NA_SCALE
    nwin = kr * GRID_W
    s = jnp.concatenate([s_win.reshape(B, H, R, GRID_W, nwin), s_ctx], axis=-1)
    p = jax.nn.softmax(s, axis=-1).astype(v.dtype)
    p_win = p[..., :nwin].reshape(B, H, R, GRID_W, kr, GRID_W)
    o = jnp.einsum('bhrqkc,brkchd->brqhd', p_win, vg) + jnp.einsum('bhrqk,bkhd->brqhd', p[..., nwin:], vc)
    return o.reshape(B, L, H, d)


def multiscale_pool(u, w_pool, pool_scale):
    B, L, _ = u.shape
    ug = u.reshape(B, L, POOL_GROUPS, POOL_CH).astype(jnp.float32)
    cs = jnp.concatenate([jnp.zeros_like(ug[:, :1]), jnp.cumsum(ug, axis=1)], axis=1)
    t = jnp.arange(L)[:, None]
    half = jnp.array(POOL_WINDOWS, dtype=jnp.int32)[None, :] // 2
    lo = jnp.clip(t - half, 0, L)
    hi = jnp.clip(t + half, 0, L)
    gi = jnp.arange(POOL_GROUPS)[None, :]
    mean = (cs[:, hi, gi] - cs[:, lo, gi]) / (hi - lo).astype(jnp.float32)[None, :, :, None]
    y = (mean - ug).astype(u.dtype)
    y = jnp.einsum('blgc,gcd->blgd', y, w_pool).reshape(B, L, POOL_W)
    return y * pool_scale


def fourier_mix(u):
    B, L, _ = u.shape
    ug = u.reshape(B, L, FFT_GROUPS, FFT_CH).astype(jnp.float32)
    y = jnp.fft.fft2(ug, axes=(1, 3), norm='ortho').real
    return y.reshape(B, L, FFT_W).astype(u.dtype)


def mla_qkv(cq, ckv, krope, q_norm, w_uq, kv_norm, w_ukv, rope):
    B, L, _ = cq.shape
    q = (rms_norm(cq, q_norm) @ w_uq).reshape(B, L, MLA_HEADS, MLA_NOPE + MLA_ROPE)
    kv = (rms_norm(ckv, kv_norm) @ w_ukv).reshape(B, L, MLA_HEADS, MLA_NOPE + MLA_V)
    q_nope, q_rope = q[..., :MLA_NOPE], q[..., MLA_NOPE:]
    k_nope, v = kv[..., :MLA_NOPE], kv[..., MLA_NOPE:]
    k_rope = krope[:, :, None, :]
    if rope is not None:
        q_rope = apply_rope(q_rope, *rope)
        k_rope = apply_rope(k_rope, *rope)
    q = jnp.concatenate([q_nope, q_rope], axis=-1)
    k = jnp.concatenate([k_nope, jnp.broadcast_to(k_rope, (B, L, MLA_HEADS, MLA_ROPE))], axis=-1)
    return q, k, v


def merge_branches(branches, gates, w_branch, w_out):
    B, L, _ = gates.shape
    y = jnp.stack(branches, axis=2)
    proj = jnp.einsum('blnw,nwd->blnd', y, w_branch)
    g = jax.nn.sigmoid(gates.astype(jnp.float32)).astype(proj.dtype).reshape(B, L, N_BRANCH, D_MODEL)
    return jnp.sum(g * proj, axis=2) @ w_out


def _heads(t):
    return t.reshape(t.shape[0], t.shape[1], NA_HEADS, HEAD_DIM)


def token_mixer(ux, uc, w_in, na_rpb, pool_w, pool_scale, q_norm, w_uq, kv_norm, w_ukv, w_branch, w_out, rope, with_ctx):
    B, L, _ = ux.shape
    Lc = uc.shape[1]
    qa_x, ka_x, va_x, up_x, uf_x, cq_x, ckv_x, kr_x, gt_x = jnp.split(ux @ w_in, IN_SPLITS, axis=-1)
    qa_c, ka_c, va_c, up_c, uf_c, cq_c, ckv_c, kr_c, gt_c = jnp.split(uc @ w_in, IN_SPLITS, axis=-1)
    ka_c, va_c = _heads(ka_c), _heads(va_c)
    qm_c, km_c, vm_c = mla_qkv(cq_c, ckv_c, kr_c, q_norm, w_uq, kv_norm, w_ukv, None)
    ya_x = neighborhood_attention(_heads(qa_x), _heads(ka_x), _heads(va_x), ka_c, va_c, na_rpb).reshape(B, L, NA_W)
    yb_x = multiscale_pool(up_x, pool_w, pool_scale)
    yc_x = fourier_mix(uf_x)
    qm_x, km_x, vm_x = mla_qkv(cq_x, ckv_x, kr_x, q_norm, w_uq, kv_norm, w_ukv, rope)
    yd_x = attend_blocked(qm_x, jnp.concatenate([km_x, km_c], axis=1),
                          jnp.concatenate([vm_x, vm_c], axis=1), MLA_SCALE).reshape(B, L, MLA_W)
    out_x = merge_branches((ya_x, yb_x, yc_x, yd_x), gt_x, w_branch, w_out)
    if not with_ctx:
        return out_x, None
    ya_c = attend(_heads(qa_c), ka_c, va_c, NA_SCALE).reshape(B, Lc, NA_W)
    yb_c = multiscale_pool(up_c, pool_w, pool_scale)
    yc_c = fourier_mix(uf_c)
    yd_c = attend(qm_c, km_c, vm_c, MLA_SCALE).reshape(B, Lc, MLA_W)
    out_c = merge_branches((ya_c, yb_c, yc_c, yd_c), gt_c, w_branch, w_out)
    return out_x, out_c


def expert_choice_ffn(h, w_router, w_gate, w_up, w_down):
    B, L, _ = h.shape
    cap = EC_CAPACITY * L // N_EXPERTS
    aff = jax.nn.softmax((h @ w_router).astype(jnp.float32), axis=-1)
    g, idx = lax.top_k(aff.transpose(0, 2, 1), cap)
    bidx = jnp.arange(B)[:, None, None]
    xe = h[bidx, idx]
    a = jnp.einsum('becd,edf->becf', xe, w_gate)
    u = jnp.einsum('becd,edf->becf', xe, w_up)
    ye = jnp.einsum('becf,efd->becd', jax.nn.silu(a) * u, w_down) * g[..., None].astype(h.dtype)
    return jnp.zeros_like(h).at[bidx, idx].add(ye)


def setup_inputs(seed: int = 0) -> dict:
    key = jax.random.key(seed)
    ks = jax.random.split(key, 26)
    f32 = jnp.float32

    def nrm(k, shape, s):
        return jax.random.normal(k, shape, f32) * s

    D = D_MODEL
    return {
        'x': nrm(ks[0], (BATCH, SEQ, D), 1.0),
        'c': nrm(ks[1], (BATCH, D), 1.0),
        'ctx': nrm(ks[2], (BATCH, CTX_LEN, D), 1.0),
        'c_ctx': nrm(ks[3], (D,), 1.0),
        'w_mod': nrm(ks[4], (DEPTH, D, 6 * D), 0.3 * D ** -0.5),
        'b_mod': nrm(ks[5], (DEPTH, 6 * D), 0.02),
        'w_in': nrm(ks[6], (DEPTH, D, IN_COLS), D ** -0.5),
        'na_rpb': nrm(ks[7], (DEPTH, NA_HEADS, 2 * NA_WIN_ROWS - 1, 2 * NA_WIN_COLS - 1), 0.1),
        'pool_w': nrm(ks[8], (DEPTH, POOL_GROUPS, POOL_CH, POOL_CH), POOL_CH ** -0.5),
        'pool_scale': 1.0 + nrm(ks[9], (DEPTH, POOL_W), 0.1),
        'mla_q_norm': 1.0 + nrm(ks[10], (DEPTH, MLA_Q_RANK), 0.01),
        'mla_w_uq': nrm(ks[11], (DEPTH, MLA_Q_RANK, MLA_HEADS * (MLA_NOPE + MLA_ROPE)), MLA_Q_RANK ** -0.5),
        'mla_kv_norm': 1.0 + nrm(ks[12], (DEPTH, MLA_KV_RANK), 0.01),
        'mla_w_ukv': nrm(ks[13], (DEPTH, MLA_KV_RANK, MLA_HEADS * (MLA_NOPE + MLA_V)), MLA_KV_RANK ** -0.5),
        'w_branch': nrm(ks[14], (DEPTH, N_BRANCH, BRANCH_W, D), BRANCH_W ** -0.5),
        'w_out': nrm(ks[15], (DEPTH, D, D), DN_BETA * D ** -0.5),
        'ln1_g': 1.0 + nrm(ks[16], (DEPTH, D), 0.01),
        'ln1_b': nrm(ks[17], (DEPTH, D), 0.01),
        'w_router': nrm(ks[18], (DEPTH, D, N_EXPERTS), D ** -0.5),
        'w_gate': nrm(ks[19], (DEPTH, N_EXPERTS, D, EXPERT_FF), D ** -0.5),
        'w_up': nrm(ks[20], (DEPTH, N_EXPERTS, D, EXPERT_FF), D ** -0.5),
        'w_down': nrm(ks[21], (DEPTH, N_EXPERTS, EXPERT_FF, D), DN_BETA * EXPERT_FF ** -0.5),
        'ln2_g': 1.0 + nrm(ks[22], (DEPTH, D), 0.01),
        'ln2_b': nrm(ks[23], (DEPTH, D), 0.01),
    }


def reference(x, c, ctx, c_ctx, w_mod, b_mod, w_in, na_rpb, pool_w, pool_scale, mla_q_norm, mla_w_uq,
              mla_kv_norm, mla_w_ukv, w_branch, w_out, ln1_g, ln1_b, w_router, w_gate, w_up, w_down,
              ln2_g, ln2_b):
    rope = axial_rope(x.shape[1])
    h, hc = x, ctx
    silu_c = jax.nn.silu(c)
    silu_cc = jax.nn.silu(c_ctx)
    for l in range(DEPTH):
        with_ctx = l < DEPTH - 1
        mod_x = (silu_c @ w_mod[l] + b_mod[l])[:, None, :]
        mod_c = silu_cc @ w_mod[l] + b_mod[l]
        sh1, sc1, g1, sh2, sc2, g2 = jnp.split(mod_x, 6, axis=-1)
        sh1c, sc1c, g1c, sh2c, sc2c, g2c = jnp.split(mod_c, 6, axis=-1)
        mx, mc = token_mixer(h * (1.0 + sc1) + sh1, hc * (1.0 + sc1c) + sh1c, w_in[l], na_rpb[l],
                             pool_w[l], pool_scale[l], mla_q_norm[l], mla_w_uq[l], mla_kv_norm[l],
                             mla_w_ukv[l], w_branch[l], w_out[l], rope, with_ctx)
        h = layer_norm(DN_ALPHA * h + g1 * mx, ln1_g[l], ln1_b[l])
        fx = expert_choice_ffn(h * (1.0 + sc2) + sh2, w_router[l], w_gate[l], w_up[l], w_down[l])
        h = layer_norm(DN_ALPHA * h + g2 * fx, ln2_g[l], ln2_b[l])
        if with_ctx:
            hc = layer_norm(DN_ALPHA * hc + g1c * mc, ln1_g[l], ln1_b[l])
            fc = expert_choice_ffn(hc * (1.0 + sc2c) + sh2c, w_router[l], w_gate[l], w_up[l], w_down[l])
            hc = layer_norm(DN_ALPHA * hc + g2c * fc, ln2_g[l], ln2_b[l])
    return h
```

```cpp
#include <hip/hip_runtime.h>
#include <cstdio>
#include <cstdint>

#ifndef ONE_LAUNCH
#define ONE_LAUNCH 1
#endif

#define GAS __attribute__((address_space(1)))
#define LAS __attribute__((address_space(3)))
typedef unsigned short bf16;
typedef short bf16x8 __attribute__((ext_vector_type(8)));
typedef short s16x4 __attribute__((ext_vector_type(4)));
typedef float f32x4 __attribute__((ext_vector_type(4)));
typedef float f32x16 __attribute__((ext_vector_type(16)));
typedef unsigned u32x4 __attribute__((ext_vector_type(4)));
typedef unsigned u32x2 __attribute__((ext_vector_type(2)));

constexpr int D = 1024, NB = 8, SEQ = 2048, CTX = 256, DEPTH = 4, GW = 64;
constexpr int TL = NB * SEQ, TC = NB * CTX, T = TL + TC;
constexpr int IN_COLS = 5792, NZ = 1792;
constexpr int ZQ = 0, ZK = 256, ZV = 512, ZP = 768, ZF = 1024, ZCQ = 1280, ZCKV = 1536, ZKR = 1664, ZEND = 1696;
constexpr int NE = 16, FF = 2048, CAPL = 256, CAPC = 32, ESLOT = NB * CAPL + NB * CAPC;
constexpr float LN_EPS = 1e-5f;
constexpr float DN_ALPHA = 1.681792830507429f;
constexpr float LOG2E = 1.4426950408889634f;
constexpr float NA_QS = 0.125f * LOG2E;
constexpr float MLA_QS = 0.10206207261596575f * LOG2E;

constexpr size_t al256(size_t x) { return (x + 255) & ~(size_t)255; }
constexpr size_t WS_CTL = 0, CTL_BYTES = 1u << 20;
constexpr size_t WS_MOD = WS_CTL + CTL_BYTES;
constexpr size_t WS_ROPE = al256(WS_MOD + (size_t)DEPTH * 9 * 6144 * 4);
constexpr size_t WS_T64 = al256(WS_ROPE + 2048 * 32 * 4);
constexpr size_t WS_AFFT = al256(WS_T64 + 128 * 64 * 2);
constexpr size_t WS_AFFTC = al256(WS_AFFT + (size_t)2048 * 4096 * 2);
constexpr size_t WS_WIN = al256(WS_AFFTC + 256 * 512 * 2);
constexpr size_t WS_WG = al256(WS_WIN + (size_t)DEPTH * NZ * D * 2);
constexpr size_t WS_WUQ = al256(WS_WG + (size_t)DEPTH * 4096 * D * 2);
constexpr size_t WS_WUKV = al256(WS_WUQ + (size_t)DEPTH * 384 * 256 * 2);
constexpr size_t WS_WB = al256(WS_WUKV + (size_t)DEPTH * 512 * 128 * 2);
constexpr size_t WS_WO = al256(WS_WB + (size_t)DEPTH * 4 * D * 256 * 2);
constexpr size_t WS_WGU = al256(WS_WO + (size_t)DEPTH * D * D * 2);
constexpr size_t WS_WD = al256(WS_WGU + (size_t)DEPTH * NE * 4096 * D * 2);
constexpr size_t WS_H = al256(WS_WD + (size_t)DEPTH * NE * D * FF * 2);
constexpr size_t WS_X1 = al256(WS_H + (size_t)T * D * 4);
constexpr size_t WS_U1 = al256(WS_X1 + (size_t)T * D * 4);
constexpr size_t WS_U2 = al256(WS_U1 + (size_t)T * D * 2);
constexpr size_t WS_Z = al256(WS_U2 + (size_t)T * D * 2);
constexpr size_t WS_QM = al256(WS_Z + (size_t)T * NZ * 2);
constexpr size_t WS_KM = al256(WS_QM + (size_t)T * 384 * 2);
constexpr size_t WS_VM = al256(WS_KM + (size_t)T * 384 * 2);
constexpr size_t WS_FB = al256(WS_VM + (size_t)T * 256 * 2);
constexpr size_t WS_FBC = al256(WS_FB + (size_t)2048 * 4096 * 2);
constexpr size_t WS_Y = al256(WS_FBC + (size_t)2048 * 512 * 2);
constexpr size_t WS_P = al256(WS_Y + (size_t)4 * T * 256 * 2);
constexpr size_t WS_AFF = al256(WS_P + (size_t)T * 4096 * 2);
constexpr size_t WS_SLOT = al256(WS_AFF + (size_t)T * 16 * 4);
constexpr size_t WS_GATEV = al256(WS_SLOT + (size_t)T * 16 * 4);
constexpr size_t WS_SROW = al256(WS_GATEV + (size_t)NE * ESLOT * 4);
constexpr size_t WS_XE = al256(WS_SROW + (size_t)NE * ESLOT * 4);
constexpr size_t WS_ACT = al256(WS_XE + (size_t)NE * ESLOT * D * 2);
constexpr size_t WS_YE = al256(WS_ACT + (size_t)NE * ESLOT * FF * 2);
constexpr size_t WS_S = al256(WS_YE + (size_t)NE * ESLOT * D * 2);
constexpr size_t WS_ST1 = al256(WS_S + (size_t)T * D * 2);
constexpr size_t WS_END = al256(WS_ST1 + (size_t)T * 2 * 4);
static_assert(WS_END <= (size_t)2047 * 1024 * 1024, "workspace map exceeds 2 GiB");

constexpr int LDS_BYTES = 147456;
constexpr int LDS_MISC = 140 * 1024;

typedef __bf16 bf16x2_t __attribute__((ext_vector_type(2)));
typedef float f32x2_t __attribute__((ext_vector_type(2)));
__device__ __forceinline__ unsigned cvt_pk_bf16(float lo, float hi) { f32x2_t v = {lo, hi}; bf16x2_t b = __builtin_convertvector(v, bf16x2_t); return __builtin_bit_cast(unsigned, b); }
__device__ __forceinline__ float bf2f(unsigned short b) { return __uint_as_float(((unsigned)b) << 16); }
__device__ __forceinline__ float bflo(unsigned w) { return __uint_as_float(w << 16); }
__device__ __forceinline__ float bfhi(unsigned w) { return __uint_as_float(w & 0xffff0000u); }
__device__ __forceinline__ float wave_sum(float v) {
    v += __builtin_bit_cast(float, __builtin_amdgcn_update_dpp(0, __builtin_bit_cast(int, v), 0xB1, 0xf, 0xf, true));
    v += __builtin_bit_cast(float, __builtin_amdgcn_update_dpp(0, __builtin_bit_cast(int, v), 0x4E, 0xf, 0xf, true));
    v += __builtin_bit_cast(float, __builtin_amdgcn_update_dpp(0, __builtin_bit_cast(int, v), 0x141, 0xf, 0xf, true));
    v += __builtin_bit_cast(float, __builtin_amdgcn_update_dpp(0, __builtin_bit_cast(int, v), 0x140, 0xf, 0xf, true));
    const int iv = __builtin_bit_cast(int, v);
    const float a = __builtin_bit_cast(float, __builtin_amdgcn_readlane(iv, 0)), b = __builtin_bit_cast(float, __builtin_amdgcn_readlane(iv, 16));
    const float c = __builtin_bit_cast(float, __builtin_amdgcn_readlane(iv, 32)), d = __builtin_bit_cast(float, __builtin_amdgcn_readlane(iv, 48));
    return (a + b) + (c + d);
}
__device__ __forceinline__ float row16_sum(float v) {
    v += __builtin_bit_cast(float, __builtin_amdgcn_update_dpp(0, __builtin_bit_cast(int, v), 0xB1, 0xf, 0xf, true));
    v += __builtin_bit_cast(float, __builtin_amdgcn_update_dpp(0, __builtin_bit_cast(int, v), 0x4E, 0xf, 0xf, true));
    v += __builtin_bit_cast(float, __builtin_amdgcn_update_dpp(0, __builtin_bit_cast(int, v), 0x141, 0xf, 0xf, true));
    v += __builtin_bit_cast(float, __builtin_amdgcn_update_dpp(0, __builtin_bit_cast(int, v), 0x140, 0xf, 0xf, true));
    return v;
}
__device__ __forceinline__ unsigned wave_sum_u(unsigned v) {
    v += (unsigned)__builtin_amdgcn_update_dpp(0, (int)v, 0xB1, 0xf, 0xf, true);
    v += (unsigned)__builtin_amdgcn_update_dpp(0, (int)v, 0x4E, 0xf, 0xf, true);
    v += (unsigned)__builtin_amdgcn_update_dpp(0, (int)v, 0x141, 0xf, 0xf, true);
    v += (unsigned)__builtin_amdgcn_update_dpp(0, (int)v, 0x140, 0xf, 0xf, true);
    return (unsigned)__builtin_amdgcn_readlane((int)v, 0) + (unsigned)__builtin_amdgcn_readlane((int)v, 16) + (unsigned)__builtin_amdgcn_readlane((int)v, 32) + (unsigned)__builtin_amdgcn_readlane((int)v, 48);
}
__device__ __forceinline__ void st_wt8(void* p, u32x2 v) { __hip_atomic_store((unsigned long long*)p, ((unsigned long long)v.y << 32) | v.x, __ATOMIC_RELAXED, __HIP_MEMORY_SCOPE_AGENT); }
__device__ __forceinline__ void st_wt16(void* p, u32x4 v) { __hip_atomic_store((unsigned long long*)p, ((unsigned long long)v.y << 32) | v.x, __ATOMIC_RELAXED, __HIP_MEMORY_SCOPE_AGENT); __hip_atomic_store((unsigned long long*)p + 1, ((unsigned long long)v.w << 32) | v.z, __ATOMIC_RELAXED, __HIP_MEMORY_SCOPE_AGENT); }
__device__ __forceinline__ float fast_exp2(float x) { return __builtin_amdgcn_exp2f(x); }
__device__ __forceinline__ float silu_f(float x) { return x / (1.0f + __expf(-x)); }

#define XB_TMO      128
#define XB_XCNT(j)  (256  + 64 * (j))
#define XB_XSUB(j)  (1280 + 64 * (j))
#define XB_XGEN(j)  (2304 + 64 * (j))
#define XB_TOP      3328
#define XB_TOPGEN   3392
#define XCD_BAR_WORDS 3456
#define XB_SPIN_CAP (1u << 18)
__device__ __forceinline__ unsigned xb_ld(unsigned* p)              { return __hip_atomic_load(p, __ATOMIC_RELAXED, __HIP_MEMORY_SCOPE_AGENT); }
__device__ __forceinline__ unsigned xb_add(unsigned* p, unsigned v) { return __hip_atomic_fetch_add(p, v, __ATOMIC_RELAXED, __HIP_MEMORY_SCOPE_AGENT); }
__device__ __forceinline__ unsigned xb_xcc_id() { return (unsigned)__builtin_amdgcn_s_getreg((3 << 11) | 20) & 0xFu; }
#define XB_SPIN(cond, bar) do { unsigned _sp = 0; while (cond) { __builtin_amdgcn_s_sleep(1); \
    if ((++_sp & 255u) == 0u) { if (xb_ld(&(bar)[XB_TMO])) break; if (_sp > XB_SPIN_CAP) { atomicAdd(&(bar)[XB_TMO], 1u); break; } } } } while (0)
struct XcdBarrier { unsigned* bar; unsigned x; volatile LAS unsigned* st; };
__device__ __forceinline__ XcdBarrier xcd_barrier_post(unsigned* bar, volatile LAS unsigned* st) {
    XcdBarrier b; b.bar = bar; b.x = xb_xcc_id(); b.st = st;
    if (threadIdx.x == 0) (void)xb_add(&bar[XB_XCNT(b.x)], 1u);
    return b;
}
__device__ __forceinline__ void xcd_barrier_complete(unsigned* bar, unsigned x, unsigned& nloc, unsigned& nx) {
    const unsigned G = gridDim.x * gridDim.y * gridDim.z;
    unsigned sum, cnt, mine, sp = 0u;
    for (;;) {
        sum = 0u; cnt = 0u; mine = 0u;
#pragma unroll
        for (unsigned j = 0; j < 16; ++j) { const unsigned c = xb_ld(&bar[XB_XCNT(j)]); sum += c; cnt += (c > 0u) ? 1u : 0u; mine = (j == x) ? c : mine; }
        if (sum == G) break;
        __builtin_amdgcn_s_sleep(1);
        if ((++sp & 255u) == 0u) { if (xb_ld(&bar[XB_TMO])) break; if (sp > XB_SPIN_CAP) { atomicAdd(&bar[XB_TMO], 1u); break; } }
    }
    nloc = mine > 0u ? mine : 1u; nx = cnt > 0u ? cnt : 1u;
}
__device__ __forceinline__ void xcd_barrier(const XcdBarrier& b) {
    asm volatile("s_waitcnt vmcnt(0)" ::: "memory");
    __syncthreads();
    if (threadIdx.x == 0) {
        unsigned* bar = b.bar;
        __builtin_amdgcn_s_waitcnt(0);
        unsigned nloc = b.st[0], nx = b.st[1];
        if (nloc == 0u) { xcd_barrier_complete(bar, b.x, nloc, nx); b.st[0] = nloc; b.st[1] = nx; }
        const unsigned old = xb_add(&bar[XB_XSUB(b.x)], 1u);
        const unsigned gen = old / nloc;
        if (old + 1u == (gen + 1u) * nloc) {
            __builtin_amdgcn_fence(__ATOMIC_RELEASE, "agent");
            asm volatile("s_waitcnt vmcnt(0)" ::: "memory");
            const unsigned og = xb_add(&bar[XB_TOP], 1u);
            const unsigned tg = og / nx;
            if (og + 1u == (tg + 1u) * nx) xb_add(&bar[XB_TOPGEN], 1u);
            else XB_SPIN(xb_ld(&bar[XB_TOPGEN]) == tg, bar);
            __builtin_amdgcn_fence(__ATOMIC_ACQUIRE, "agent");
            xb_add(&bar[XB_XGEN(b.x)], 1u);
            asm volatile("s_waitcnt vmcnt(0)" ::: "memory");
        } else {
            XB_SPIN(xb_ld(&bar[XB_XGEN(b.x)]) == gen, bar);
            __builtin_amdgcn_fence(__ATOMIC_ACQUIRE, "agent");
            asm volatile("s_waitcnt vmcnt(0)" ::: "memory");
        }
    }
    __syncthreads();
}

struct Args {
    const float* in[24];
    float* out;
    unsigned char* ws;
    int ph_lo, ph_hi;
};
enum { I_X = 0, I_C, I_CTX, I_CCTX, I_WMOD, I_BMOD, I_WIN, I_RPB, I_POOLW, I_POOLS, I_QNORM, I_WUQ, I_KVNORM, I_WUKV, I_WBR, I_WOUT,
       I_LN1G, I_LN1B, I_WROUTER, I_WGATE, I_WUP, I_WDOWN, I_LN2G, I_LN2B };

struct Ctx {
    LAS unsigned char* lds;
    GAS unsigned char* ws;
    const float* const* in;
    float* out;
    int tid, lane, wave, bid, G;
};
#define WSP(T_, off) ((T_*)(GAS T_*)(C.ws + (off)))

__device__ __forceinline__ int mod_row(int row) { return row < TL ? (row >> 11) : 8; }

constexpr int SG_TILE_B = 128 * 128;
constexpr int SG_LDS = 4 * SG_TILE_B;
template <class AF, class BF, class EPI>
__device__ __forceinline__ void sgemm_tile(const Ctx& C, AF arow, BF brow, int K, int kwrapB, EPI epi) {
    const int tid = C.tid, lane = C.lane, wid = C.wave, wr = wid >> 2, wc = wid & 3, fr = lane & 15, fq = lane >> 4;
    LAS unsigned char* lds = C.lds;
    const bf16* ap[2]; const bf16* bp[2]; int lo[2];
#pragma unroll
    for (int i = 0; i < 2; ++i) { const int c = tid + 512 * i, r = c >> 3, kc = c & 7; ap[i] = arow(r) + kc * 8; bp[i] = brow(r) + kc * 8; lo[i] = r * 128 + ((kc ^ ((r >> 1) & 7)) << 4); }
    f32x4 acc[4][2];
#pragma unroll
    for (int m = 0; m < 4; ++m)
#pragma unroll
        for (int n = 0; n < 2; ++n) acc[m][n] = (f32x4){0.f, 0.f, 0.f, 0.f};
    u32x4 ra0[2], rb0[2], ra1[2], rb1[2];
    const int nt = K >> 6;
    const int sw = (fr >> 1) & 7;
    const int ra_off = (wr * 64 + fr) * 128, rb_off = (wc * 32 + fr) * 128;
#define SG_GLOAD(RA, RB, t) do { const int ka_ = (t) * 64, kb_ = kwrapB ? (ka_ & (kwrapB - 1)) : ka_; _Pragma("unroll") for (int i = 0; i < 2; ++i) { RA[i] = *(const u32x4*)(ap[i] + ka_); RB[i] = *(const u32x4*)(bp[i] + kb_); } } while (0)
#define SG_LSTORE(RA, RB, buf) do { _Pragma("unroll") for (int i = 0; i < 2; ++i) { *(LAS u32x4*)(lds + (buf) * SG_TILE_B + lo[i]) = RA[i]; *(LAS u32x4*)(lds + (2 + (buf)) * SG_TILE_B + lo[i]) = RB[i]; } } while (0)
#define SG_COMPUTE(buf) do { const LAS unsigned char* la = lds + (buf) * SG_TILE_B + ra_off; const LAS unsigned char* lb = lds + (2 + (buf)) * SG_TILE_B + rb_off; \
        _Pragma("unroll") for (int kk = 0; kk < 2; ++kk) { bf16x8 af[4], bfr[2]; const int co = (((4 * kk + fq) ^ sw) << 4); \
            _Pragma("unroll") for (int m = 0; m < 4; ++m) af[m] = *(const LAS bf16x8*)(la + m * 2048 + co); \
            _Pragma("unroll") for (int n = 0; n < 2; ++n) bfr[n] = *(const LAS bf16x8*)(lb + n * 2048 + co); \
            _Pragma("unroll") for (int m = 0; m < 4; ++m) _Pragma("unroll") for (int n = 0; n < 2; ++n) acc[m][n] = __builtin_amdgcn_mfma_f32_16x16x32_bf16(bfr[n], af[m], acc[m][n], 0, 0, 0); } } while (0)
    SG_GLOAD(ra0, rb0, 0);
    if (nt > 1) SG_GLOAD(ra1, rb1, 1);
    SG_LSTORE(ra0, rb0, 0);
    __syncthreads();
    for (int t = 0; t < nt; t += 2) {
        if (t + 2 < nt) SG_GLOAD(ra0, rb0, t + 2);
        SG_COMPUTE(0);
        if (t + 1 < nt) SG_LSTORE(ra1, rb1, 1);
        __syncthreads();
        if (t + 1 >= nt) break;
        if (t + 3 < nt) SG_GLOAD(ra1, rb1, t + 3);
        SG_COMPUTE(1);
        if (t + 2 < nt) SG_LSTORE(ra0, rb0, 0);
        __syncthreads();
    }
#undef SG_GLOAD
#undef SG_LSTORE
#undef SG_COMPUTE
    epi(acc, wr, wc, fr, fq);
    __syncthreads();
}

namespace g8 {
constexpr int BM = 256, BK = 64, HALF = 128, HTB = HALF * BK * 2, STAGE_BYTES = 8 * HTB;
__device__ __forceinline__ int lds_byte(int r, int c) { const int st = (r >> 4) * 2 + (c >> 5), rr = r & 15, cc = c & 31, ob = rr * 64 + cc * 2; return st * 1024 + (ob ^ (((ob >> 9) & 1) << 5)); }
__device__ __forceinline__ void stage_rc(int b, int& R, int& C) { const int st = b / 1024, sb = b % 1024, swz = sb ^ (((sb >> 9) & 1) << 5); R = (st >> 1) * 16 + swz / 64; C = (st & 1) * 32 + (swz % 64) / 2; }
__device__ __forceinline__ int perm32(int rho) { const int n = rho >> 4, i = rho & 15; return 8 * (i >> 2) + 4 * n + (i & 3); }
struct Unit { const char* A; const char* B; int r0, c0, x; };
template <class Epi, class Sched, bool GATHER = false>
__device__ __forceinline__ void gemm_phase(LAS unsigned char* lds, const int K, const unsigned lda, const unsigned ldb, const Sched& S, const Epi& E, const int tid, const LAS int* srow = nullptr) {
    const int wid = __builtin_amdgcn_readfirstlane(tid >> 6), lane = tid & 63, wr = wid >> 2, wc = wid & 3, fr = lane & 15, fq = lane >> 4;
    const int nt = K / BK;
    unsigned voffA[2], voffB[2], vA1[2], nA0[2], nA1[2]; int gR[2]; unsigned gC[2];
#pragma unroll
    for (int i = 0; i < 2; ++i) { int R, Cc; stage_rc(tid * 16 + i * 8192, R, Cc); const int Rb = Epi::PERM ? ((R & ~31) + perm32(R & 31)) : R;
        voffA[i] = (unsigned)R * lda + (unsigned)Cc * 2u; voffB[i] = (unsigned)Rb * ldb + (unsigned)Cc * 2u; gR[i] = R; gC[i] = (unsigned)Cc * 2u; vA1[i] = voffA[i]; nA0[i] = voffA[i]; nA1[i] = voffA[i]; }
    if constexpr (GATHER) {
#pragma unroll
        for (int i = 0; i < 2; ++i) { voffA[i] = (unsigned)srow[gR[i]] * lda + gC[i]; vA1[i] = (unsigned)srow[128 + gR[i]] * lda + gC[i]; }
    }
    const size_t kstep = (size_t)(BK * 2);
    const size_t hstepA = GATHER ? (size_t)0 : (size_t)HALF * lda, hstepB = (size_t)HALF * ldb;
    const unsigned ldsw = (unsigned)wid * 1024u;
    const int aoff = lds_byte(wr * 64 + fr, fq * 8), boff = lds_byte(wc * 32 + fr, fq * 8);
#define PG8_SA(b, h) (((b) * 2 + (h)) * HTB)
#define PG8_SB(b, h) ((4 + (b) * 2 + (h)) * HTB)
#define PG8_STAGE(bufoff, gbase, voff) do { _Pragma("unroll") for (int _i = 0; _i < 2; ++_i) \
        __builtin_amdgcn_global_load_lds((const unsigned*)((const char*)(gbase) + (voff)[_i]), (LAS unsigned*)(lds + (bufoff) + ldsw + _i * 8192), 16, 0, 0); } while (0)
#define PG8_LDA(dst, b, h) do { _Pragma("unroll") for (int m = 0; m < 4; ++m) _Pragma("unroll") for (int k = 0; k < 2; ++k) dst[m][k] = *(const LAS bf16x8*)(lds + PG8_SA(b, h) + aoff + m * 2048 + k * 1024); } while (0)
#define PG8_LDB(dst, b, h) do { _Pragma("unroll") for (int n = 0; n < 2; ++n) _Pragma("unroll") for (int k = 0; k < 2; ++k) dst[n][k] = *(const LAS bf16x8*)(lds + PG8_SB(b, h) + boff + n * 2048 + k * 1024); } while (0)
#define PG8_MMA(ai, bj, At, Bt) do { __builtin_amdgcn_s_setprio(1); _Pragma("unroll") for (int m = 0; m < 4; ++m) _Pragma("unroll") for (int n = 0; n < 2; ++n) _Pragma("unroll") for (int k = 0; k < 2; ++k) \
        acc[ai][bj][m][n] = __builtin_amdgcn_mfma_f32_16x16x32_bf16(Bt[n][k], At[m][k], acc[ai][bj][m][n], 0, 0, 0); __builtin_amdgcn_s_setprio(0); } while (0)
#define PG8_WAIT_V(n) asm volatile("s_waitcnt vmcnt(" #n ")" ::: "memory")
#define PG8_WAIT_L(n) asm volatile("s_waitcnt lgkmcnt(" #n ")" ::: "memory")
#define PG8_BAR __builtin_amdgcn_s_barrier()
#define PG8_SCHED __builtin_amdgcn_sched_barrier(0)
    Unit cur, nxt; int ui = 0;
    if (!S.next(0, cur)) return;
    f32x4 acc[2][2][4][2];
#pragma unroll
    for (int a = 0; a < 2; ++a)
#pragma unroll
        for (int b = 0; b < 2; ++b)
#pragma unroll
            for (int m = 0; m < 4; ++m)
#pragma unroll
                for (int n = 0; n < 2; ++n) acc[a][b][m][n] = (f32x4){0.f, 0.f, 0.f, 0.f};
    bf16x8 At[4][2], B0[2][2], B1[2][2];
    const char* cA = cur.A; const char* cB = cur.B;
    PG8_STAGE(PG8_SB(0, 0), cB, voffB); PG8_STAGE(PG8_SB(0, 1), cB + hstepB, voffB); PG8_STAGE(PG8_SA(0, 0), cA, voffA); PG8_STAGE(PG8_SA(0, 1), cA + hstepA, vA1);
    if (wr == 1) PG8_BAR;
    PG8_WAIT_V(2); PG8_BAR;
    PG8_STAGE(PG8_SB(1, 0), cB + kstep, voffB); PG8_STAGE(PG8_SA(1, 0), cA + kstep, voffA); PG8_STAGE(PG8_SB(1, 1), cB + hstepB + kstep, voffB);
    PG8_WAIT_V(6); PG8_BAR;
    for (;;) {
        const bool has_next = S.next(ui + 1, nxt);
        const char* nA = has_next ? nxt.A : cA; const char* nB = has_next ? nxt.B : cB;
        if constexpr (GATHER) {
#pragma unroll
            for (int i = 0; i < 2; ++i) { nA0[i] = has_next ? (unsigned)srow[256 * (ui + 1) + gR[i]] * lda + gC[i] : voffA[i]; nA1[i] = has_next ? (unsigned)srow[256 * (ui + 1) + 128 + gR[i]] * lda + gC[i] : vA1[i]; }
        }
#pragma clang loop unroll(disable)
        for (int t = 0; t < nt; t += 2) {
            const bool last = (t == nt - 2);
            const char* a1 = cA + (size_t)(t + 1) * kstep;
            const char* a2 = last ? nA : cA + (size_t)(t + 2) * kstep; const char* b2 = last ? nB : cB + (size_t)(t + 2) * kstep;
            const char* a3 = a2 + kstep; const char* b3 = b2 + kstep;
            unsigned sA0[2], sA1[2];
#pragma unroll
            for (int i = 0; i < 2; ++i) { sA0[i] = (GATHER && last) ? nA0[i] : voffA[i]; sA1[i] = (GATHER && last) ? nA1[i] : vA1[i]; }
            PG8_LDB(B0, 0, 0); PG8_LDB(B1, 0, 1); PG8_SCHED; PG8_LDA(At, 0, 0); PG8_STAGE(PG8_SA(1, 1), a1 + hstepA, vA1);
            PG8_WAIT_V(8); PG8_WAIT_L(0); PG8_BAR; PG8_MMA(0, 0, At, B0); PG8_MMA(0, 1, At, B1); PG8_BAR; PG8_SCHED;
            PG8_LDA(At, 0, 1); PG8_STAGE(PG8_SB(0, 0), b2, voffB); PG8_STAGE(PG8_SB(0, 1), b2 + hstepB, voffB); PG8_STAGE(PG8_SA(0, 0), a2, sA0);
            PG8_WAIT_V(8); PG8_WAIT_L(0); PG8_BAR; PG8_MMA(1, 0, At, B0); PG8_MMA(1, 1, At, B1); PG8_BAR; PG8_SCHED;
            PG8_LDB(B0, 1, 0); PG8_LDB(B1, 1, 1); PG8_SCHED; PG8_LDA(At, 1, 0); PG8_STAGE(PG8_SA(0, 1), a2 + hstepA, sA1);
            PG8_WAIT_V(8); PG8_WAIT_L(0); PG8_BAR; PG8_MMA(0, 0, At, B0); PG8_MMA(0, 1, At, B1); PG8_BAR; PG8_SCHED;
            PG8_LDA(At, 1, 1); PG8_STAGE(PG8_SB(1, 0), b3, voffB); PG8_STAGE(PG8_SB(1, 1), b3 + hstepB, voffB); PG8_STAGE(PG8_SA(1, 0), a3, sA0);
            PG8_WAIT_V(8); PG8_WAIT_L(0); PG8_BAR; PG8_MMA(1, 0, At, B0); PG8_MMA(1, 1, At, B1); PG8_BAR; PG8_SCHED;
        }
        if (wr == 0) PG8_BAR;
        E(acc, cur, wr, wc, fr, fq);
        if (!has_next) break;
#pragma unroll
        for (int a = 0; a < 2; ++a)
#pragma unroll
            for (int b = 0; b < 2; ++b)
#pragma unroll
                for (int m = 0; m < 4; ++m)
#pragma unroll
                    for (int n = 0; n < 2; ++n) acc[a][b][m][n] = (f32x4){0.f, 0.f, 0.f, 0.f};
        cur = nxt; cA = nA; cB = nB; ++ui;
        if constexpr (GATHER) {
#pragma unroll
            for (int i = 0; i < 2; ++i) { voffA[i] = nA0[i]; vA1[i] = nA1[i]; }
        }
        if (wr == 1) PG8_BAR;
    }
    PG8_WAIT_V(0);
    PG8_BAR;
#undef PG8_SA
#undef PG8_SB
#undef PG8_STAGE
#undef PG8_LDA
#undef PG8_LDB
#undef PG8_MMA
#undef PG8_WAIT_V
#undef PG8_WAIT_L
#undef PG8_BAR
#undef PG8_SCHED
}
}

constexpr int AT_VS = 192;
template <int DK, bool WIN>
__device__ __forceinline__ void attn_unit(const Ctx& C,
        const bf16* qrow0, size_t ldq,
        const bf16* k0, const bf16* v0, int n0t,
        const bf16* k1, const bf16* v1, int n1t,
        size_t ldk, size_t ldv,
        bf16* orow0, size_t ldo,
        int w_lo, int w_hi, int dr0, int qc0, const LAS float* btab) {
    constexpr int KS = DK * 2 + 16;
    constexpr int KBUF = 64 * KS, VBUF = 64 * AT_VS;
    constexpr int KCH = DK / 8;
    constexpr int NS = DK / 16;
    const int tid = C.tid, lane = C.lane, l31 = lane & 31, h = lane >> 5;
    LAS unsigned char* lds = C.lds;
    LAS unsigned char* ldsK = lds; LAS unsigned char* ldsV = lds + 2 * KBUF;
    bf16x8 qf[NS];
#pragma unroll
    for (int s = 0; s < NS; ++s) qf[s] = *(const bf16x8*)(qrow0 + (size_t)l31 * ldq + 16 * s + 8 * h);
    f32x16 O0, O1;
#pragma unroll
    for (int i = 0; i < 16; ++i) { O0[i] = 0.f; O1[i] = 0.f; }
    float mrun = 0.f, lsum = 0.f;
    const int kc0 = tid, kr0 = kc0 / KCH, kk0 = kc0 % KCH;
    const int kc1 = tid + 512, kr1 = kc1 / KCH, kk1 = kc1 % KCH;
    constexpr bool HAS1 = (64 * KCH > 512);
    const bool has1 = HAS1 && (kc1 < 64 * KCH);
    const int vr = tid >> 3, vk = tid & 7;
    const int nt = n0t + n1t;
    u32x4 rk0, rk1, rv;
    auto gload = [&](int j, u32x4& a0, u32x4& a1, u32x4& av) {
        const bf16* kb = (j < n0t) ? k0 + (size_t)j * 64 * ldk : k1 + (size_t)(j - n0t) * 64 * ldk;
        const bf16* vb = (j < n0t) ? v0 + (size_t)j * 64 * ldv : v1 + (size_t)(j - n0t) * 64 * ldv;
        a0 = *(const u32x4*)(kb + (size_t)kr0 * ldk + kk0 * 8);
        if constexpr (HAS1) { if (has1) a1 = *(const u32x4*)(kb + (size_t)kr1 * ldk + kk1 * 8); }
        av = *(const u32x4*)(vb + (size_t)vr * ldv + vk * 8);
    };
    auto lstore = [&](int b, int vb3, const u32x4& a0, const u32x4& a1, const u32x4& av) {
        *(LAS u32x4*)(ldsK + b * KBUF + kr0 * KS + kk0 * 16) = a0;
        if constexpr (HAS1) { if (has1) *(LAS u32x4*)(ldsK + b * KBUF + kr1 * KS + kk1 * 16) = a1; }
        *(LAS u32x4*)(ldsV + vb3 * VBUF + vr * AT_VS + vk * 16) = av;
    };
    gload(0, rk0, rk1, rv);
    lstore(0, 0, rk0, rk1, rv);
    __syncthreads();
    const int trb = (4 * h + ((lane & 15) >> 2)) * AT_VS + (16 * ((lane >> 4) & 1) + 4 * (lane & 3)) * 2;
    int cq = qc0 + l31; asm volatile("" : "+v"(cq));
    int c0w = cq - 8; c0w = c0w < 0 ? 0 : (c0w > 48 ? 48 : c0w);
    const int mbase = 4 * h - c0w, bbase = 4 * h - cq + 15;
    const bool grpB = C.wave >= 4;
    union VF { bf16x8 v; s16x4 hlf[2]; };
    unsigned pfk[2][2][4];
#pragma unroll
    for (int a_ = 0; a_ < 2; ++a_)
#pragma unroll
        for (int b_ = 0; b_ < 2; ++b_)
#pragma unroll
            for (int c_ = 0; c_ < 4; ++c_) pfk[a_][b_][c_] = 0u;
    bool pend = false; int pend_vb = 0;
    auto vread = [&](int vbuf, VF (&vfr)[2][2][2]) {
        const LAS unsigned char* vb = ldsV + vbuf * VBUF + trb;
#pragma unroll
        for (int kb3 = 0; kb3 < 2; ++kb3)
#pragma unroll
            for (int s2 = 0; s2 < 2; ++s2)
#pragma unroll
                for (int db = 0; db < 2; ++db) { const int rowoff = (32 * kb3 + 16 * s2) * AT_VS;
                    vfr[kb3][s2][db].hlf[0] = __builtin_amdgcn_ds_read_tr16_b64_v4i16((LAS s16x4*)(vb + rowoff + db * 64));
                    vfr[kb3][s2][db].hlf[1] = __builtin_amdgcn_ds_read_tr16_b64_v4i16((LAS s16x4*)(vb + rowoff + 8 * AT_VS + db * 64)); }
    };
    auto pvmma = [&](const VF (&vfr)[2][2][2]) {
#pragma unroll
        for (int kb3 = 0; kb3 < 2; ++kb3)
#pragma unroll
            for (int s2 = 0; s2 < 2; ++s2) {
                union { bf16x8 v; unsigned u[4]; } pf;
#pragma unroll
                for (int q = 0; q < 4; ++q) pf.u[q] = pfk[kb3][s2][q];
                O0 = __builtin_amdgcn_mfma_f32_32x32x16_bf16(vfr[kb3][s2][0].v, pf.v, O0, 0, 0, 0);
                O1 = __builtin_amdgcn_mfma_f32_32x32x16_bf16(vfr[kb3][s2][1].v, pf.v, O1, 0, 0, 0);
            }
    };
    int vcur = 0;
    for (int j = 0; j < nt; ++j) {
        const int cur = j & 1; const int vnxt = (vcur == 2) ? 0 : vcur + 1;
        if (j + 1 < nt) gload(j + 1, rk0, rk1, rv);
        const bool act = !WIN || j < n0t || ((j - n0t) >= w_lo && (j - n0t) < w_hi);
        if (grpB && pend) { VF vfr[2][2][2]; vread(pend_vb, vfr); __builtin_amdgcn_sched_barrier(0); pvmma(vfr); pend = false; }
        if (act) {
            f32x16 S0, S1;
            const float nm = -mrun;
#pragma unroll
            for (int i = 0; i < 16; ++i) { S0[i] = nm; S1[i] = nm; }
            const LAS unsigned char* kb = ldsK + cur * KBUF + l31 * KS + 16 * h;
#pragma unroll
            for (int hs = 0; hs < 2; ++hs) {
                bf16x8 kfa[NS / 2], kfb[NS / 2];
#pragma unroll
                for (int s = 0; s < NS / 2; ++s) { kfa[s] = *(const LAS bf16x8*)(kb + 32 * (hs * (NS / 2) + s)); kfb[s] = *(const LAS bf16x8*)(kb + 32 * KS + 32 * (hs * (NS / 2) + s)); }
                __builtin_amdgcn_sched_barrier(0);
#pragma unroll
                for (int s = 0; s < NS / 2; ++s) {
                    S0 = __builtin_amdgcn_mfma_f32_32x32x16_bf16(kfa[s], qf[hs * (NS / 2) + s], S0, 0, 0, 0);
                    S1 = __builtin_amdgcn_mfma_f32_32x32x16_bf16(kfb[s], qf[hs * (NS / 2) + s], S1, 0, 0, 0);
                }
                __builtin_amdgcn_sched_barrier(0);
            }
            VF vfa[2][2][2];
            if (!grpB) { vread(vcur, vfa); __builtin_amdgcn_sched_barrier(0); }
            if (WIN && j >= n0t) {
                int mb = mbase; asm volatile("" : "+v"(mb));
                const LAS float* bt = btab + ((j - n0t) + dr0) * 31 + bbase;
#pragma unroll
                for (int i = 0; i < 16; ++i) {
                    const int kci = (i & 3) + 8 * (i >> 2);
                    S0[i] = ((unsigned)(kci + mb) < 16u) ? S0[i] + bt[kci] : -1e30f;
                    S1[i] = ((unsigned)(kci + 32 + mb) < 16u) ? S1[i] + bt[kci + 32] : -1e30f;
                }
            }
            float mx = fmaxf(S0[0], S1[0]);
#pragma unroll
            for (int i = 1; i < 16; ++i) mx = fmaxf(mx, fmaxf(S0[i], S1[i]));
            mx = fmaxf(mx, __shfl_xor(mx, 32));
            if (__any(mx > 8.0f)) {
                const float dl = fmaxf(mx, 0.f), alpha = fast_exp2(-dl);
                mrun += dl; lsum *= alpha;
#pragma unroll
                for (int i = 0; i < 16; ++i) { S0[i] -= dl; S1[i] -= dl; O0[i] *= alpha; O1[i] *= alpha; }
            }
            float ps = 0.f;
#pragma unroll
            for (int i = 0; i < 16; ++i) { S0[i] = fast_exp2(S0[i]); S1[i] = fast_exp2(S1[i]); ps += S0[i] + S1[i]; }
            lsum += ps;
#pragma unroll
            for (int s2 = 0; s2 < 2; ++s2)
#pragma unroll
                for (int q = 0; q < 4; ++q) { pfk[0][s2][q] = cvt_pk_bf16(S0[8 * s2 + 2 * q], S0[8 * s2 + 2 * q + 1]); pfk[1][s2][q] = cvt_pk_bf16(S1[8 * s2 + 2 * q], S1[8 * s2 + 2 * q + 1]); }
            if (!grpB) pvmma(vfa); else { pend = true; pend_vb = vcur; }
        }
        if (j + 1 < nt) lstore(cur ^ 1, vnxt, rk0, rk1, rv);
        __syncthreads();
        vcur = vnxt;
    }
    if (grpB && pend) { VF vfr[2][2][2]; vread(pend_vb, vfr); pvmma(vfr); }
    const float ltot = lsum + __shfl_xor(lsum, 32);
    const float inv = 1.0f / ltot;
    bf16* op = orow0 + (size_t)l31 * ldo + 4 * h;
#pragma unroll
    for (int g = 0; g < 4; ++g) {
        u32x2 w0, w1;
        w0.x = cvt_pk_bf16(O0[4 * g] * inv, O0[4 * g + 1] * inv); w0.y = cvt_pk_bf16(O0[4 * g + 2] * inv, O0[4 * g + 3] * inv);
        w1.x = cvt_pk_bf16(O1[4 * g] * inv, O1[4 * g + 1] * inv); w1.y = cvt_pk_bf16(O1[4 * g + 2] * inv, O1[4 * g + 3] * inv);
        *(u32x2*)(op + 8 * g) = w0;
        *(u32x2*)(op + 32 + 8 * g) = w1;
    }
}

template <class RM>
__device__ __forceinline__ void tconv64(const float* W, size_t ldw, int k0, int n0, int N, const float* kscale, RM rm, int lane) {
    const int q = lane >> 4, c = lane & 15, ncol = n0 + 4 * c;
    if (ncol >= N) return;
    const float* src = W + (size_t)(k0 + 16 * q) * ldw + ncol;
    f32x4 v[16];
#pragma unroll
    for (int i = 0; i < 16; ++i) v[i] = __builtin_nontemporal_load((const f32x4*)(src + (size_t)i * ldw));
    if (kscale) {
#pragma unroll
        for (int i = 0; i < 16; ++i) v[i] = v[i] * kscale[k0 + 16 * q + i];
    }
#pragma unroll
    for (int j = 0; j < 4; ++j) {
        float cs; bf16* dst = rm(ncol + j, cs);
        u32x4 o0, o1;
        o0.x = cvt_pk_bf16(v[0][j] * cs, v[1][j] * cs); o0.y = cvt_pk_bf16(v[2][j] * cs, v[3][j] * cs); o0.z = cvt_pk_bf16(v[4][j] * cs, v[5][j] * cs); o0.w = cvt_pk_bf16(v[6][j] * cs, v[7][j] * cs);
        o1.x = cvt_pk_bf16(v[8][j] * cs, v[9][j] * cs); o1.y = cvt_pk_bf16(v[10][j] * cs, v[11][j] * cs); o1.z = cvt_pk_bf16(v[12][j] * cs, v[13][j] * cs); o1.w = cvt_pk_bf16(v[14][j] * cs, v[15][j] * cs);
        *(u32x4*)(dst + k0 + 16 * q) = o0; *(u32x4*)(dst + k0 + 16 * q + 8) = o1;
    }
}
__device__ __forceinline__ void conv_gu_item(const Ctx& C, int L, int idx) {
    const int le = L * NE + (idx >> 9), t = idx & 511, kb = t >> 5, nb = t & 31;
    bf16* wgu = WSP(bf16, WS_WGU) + (size_t)le * 4096 * D;
    { auto rm = [=](int n, float& cs) -> bf16* { cs = 1.0f; return wgu + (size_t)(256 * (n >> 7) + (n & 127)) * D; };
      tconv64(C.in[I_WGATE] + (size_t)le * D * FF, FF, kb * 64, nb * 64, FF, nullptr, rm, C.lane); }
    { auto rm = [=](int n, float& cs) -> bf16* { cs = 1.0f; return wgu + (size_t)(256 * (n >> 7) + 128 + (n & 127)) * D; };
      tconv64(C.in[I_WUP] + (size_t)le * D * FF, FF, kb * 64, nb * 64, FF, nullptr, rm, C.lane); }
}
__device__ __forceinline__ void conv_dn_item(const Ctx& C, int L, int idx) {
    const int le = L * NE + (idx >> 9), t = idx & 511, kb = t >> 4, nb = t & 15;
    bf16* wd = WSP(bf16, WS_WD) + (size_t)le * D * FF;
    auto rm = [=](int n, float& cs) -> bf16* { cs = 1.0f; return wd + (size_t)n * FF; };
    tconv64(C.in[I_WDOWN] + (size_t)le * FF * D, D, kb * 64, nb * 64, D, nullptr, rm, C.lane);
}
constexpr int GU_C2_CNT = 3, GU_C2_FIRST = 0, GU_D_CNT = 1, GU_D_FIRST = 128 * 8 * GU_C2_CNT, GU_F_CNT = 1, GU_F_FIRST = GU_D_FIRST + 128 * 8 * GU_D_CNT, GU_SLOT_END = GU_F_FIRST + 128 * 8 * GU_F_CNT;
constexpr int DN_C1_CNT = 2, DN_C1_FIRST = 0, DN_E_CNT = 2, DN_E_FIRST = 128 * 8 * DN_C1_CNT, DN_I_CNT = 2, DN_I_FIRST = DN_E_FIRST + 192 * 8 * DN_E_CNT, DN_SLOT_END = DN_I_FIRST + 192 * 8 * DN_I_CNT;
static_assert(GU_SLOT_END <= 8192 && DN_SLOT_END <= 8192, "slot ranges");
__device__ __forceinline__ void slot_gu(const Ctx& C, int L, int pb, int first, int cnt) {
    for (int i = 0; i < cnt; ++i) { const int idx = first + (pb * 8 + C.wave) * cnt + i; if (idx < GU_SLOT_END) conv_gu_item(C, L, idx); }
}
__device__ __forceinline__ void slot_dn(const Ctx& C, int L, int pb, int first, int cnt) {
    for (int i = 0; i < cnt; ++i) { const int idx = first + (pb * 8 + C.wave) * cnt + i; if (idx < DN_SLOT_END) conv_dn_item(C, L, idx); }
}
__device__ __forceinline__ void phase_prep(const Ctx& C) {
    const int tid = C.tid, lane = C.lane;
    const size_t gtid = (size_t)C.bid * 512 + tid, gth = (size_t)C.G * 512;
    { bf16* afft = WSP(bf16, WS_AFFT); const float sc = 0.0027621358640099515f;
      for (size_t i = gtid; i < (size_t)2048 * 4096; i += gth) { const int k1 = (int)(i >> 12), k = (int)(i & 4095), n1 = k & 2047; const int m = (k1 * n1) & 2047;
          const float x = (float)m * (1.0f / 1024.0f); const float v = (k < 2048) ? cospif(x) : -sinpif(x); afft[i] = (bf16)(cvt_pk_bf16(v * sc, 0.f) & 0xffff); }
      bf16* afc = WSP(bf16, WS_AFFTC); const float scc = 0.0078125f;
      for (size_t i = gtid; i < (size_t)256 * 512; i += gth) { const int k1 = (int)(i >> 9), k = (int)(i & 511), n1 = k & 255; const int m = (k1 * n1) & 255;
          const float x = (float)m * (1.0f / 128.0f); const float v = (k < 256) ? cospif(x) : -sinpif(x); afc[i] = (bf16)(cvt_pk_bf16(v * scc, 0.f) & 0xffff); }
      bf16* t64 = WSP(bf16, WS_T64);
      for (size_t i = gtid; i < 128 * 64; i += gth) { const int mrow = (int)(i >> 6), n2 = (int)(i & 63), k2 = mrow & 63; const int m = (k2 * n2) & 63;
          const float x = (float)m * (1.0f / 32.0f); const float v = (mrow < 64) ? cospif(x) : sinpif(x); t64[i] = (bf16)(cvt_pk_bf16(v, 0.f) & 0xffff); }
      float* rope = WSP(float, WS_ROPE);
      for (size_t i = gtid; i < 2048 * 16; i += gth) { const int t = (int)(i >> 4), f = (int)(i & 15); const float pos = (f < 8) ? (float)(t >> 6) : (float)(t & 63);
          const float inv = powf(10000.0f, -(float)(f & 7) / 8.0f); const float ang = pos * inv; rope[2 * i] = cosf(ang); rope[2 * i + 1] = sinf(ang); }
      bf16* win = WSP(bf16, WS_WIN);
      for (size_t i = gtid; i < (size_t)DEPTH * 96 * 1024 / 8; i += gth) { const size_t l = i / (96 * 128), r = i % (96 * 128); *(u32x4*)(win + (l * NZ + ZEND) * D + r * 8) = (u32x4){0u, 0u, 0u, 0u}; }
    }
    {
        LAS float* sl = (LAS float*)(C.lds);
        LAS float* red = (LAS float*)(C.lds + 9 * 1024 * 4);
        for (int i = tid; i < 9 * 1024; i += 512) { const int r = i >> 10, k = i & 1023; const float v = (r < 8) ? C.in[I_C][r * 1024 + k] : C.in[I_CCTX][k]; sl[i] = silu_f(v); }
        __syncthreads();
        const int c32 = tid & 31, kg = tid >> 5;
        for (int it = C.bid; it < DEPTH * 192; it += C.G) {
            const int l = it / 192, n0 = (it % 192) * 32;
            const float* wm = C.in[I_WMOD] + (size_t)l * 1024 * 6144 + n0 + c32;
            float a[9];
#pragma unroll
            for (int r = 0; r < 9; ++r) a[r] = 0.f;
            for (int kk = 0; kk < 64; ++kk) { const int k = kg * 64 + kk; const float w = wm[(size_t)k * 6144];
#pragma unroll
                for (int r = 0; r < 9; ++r) a[r] += sl[r * 1024 + k] * w; }
#pragma unroll
            for (int r = 0; r < 9; ++r) red[(kg * 9 + r) * 32 + c32] = a[r];
            __syncthreads();
            if (tid < 288) { const int r = tid >> 5; float s = 0.f;
#pragma unroll
                for (int g = 0; g < 16; ++g) s += red[(g * 9 + r) * 32 + c32];
                WSP(float, WS_MOD)[((size_t)l * 9 + r) * 6144 + n0 + c32] = s + C.in[I_BMOD][l * 6144 + n0 + c32]; }
            __syncthreads();
        }
    }
    {
        for (size_t i = gtid; i < (size_t)DEPTH * 4 * 1024; i += gth) {
            const int l = (int)(i >> 12), g = (int)((i >> 10) & 3), d = (int)(i & 1023);
            const float* wb = C.in[I_WBR] + (((size_t)l * 4 + 1) * 256 + g * 64) * 1024 + d;
            const float* pw = C.in[I_POOLW] + ((size_t)l * 4 + g) * 64 * 64;
            const float* ps = C.in[I_POOLS] + l * 256 + g * 64;
            float wv[64];
#pragma unroll
            for (int c2 = 0; c2 < 64; ++c2) wv[c2] = wb[(size_t)c2 * 1024] * ps[c2];
            bf16* dst = WSP(bf16, WS_WB) + (((size_t)l * 4 + 1) * 1024 + d) * 256 + g * 64;
#pragma unroll 1
            for (int c8 = 0; c8 < 8; ++c8) {
                float o[8];
#pragma unroll
                for (int cc = 0; cc < 8; ++cc) { float s = 0.f; const float* pr = pw + (c8 * 8 + cc) * 64;
#pragma unroll
                    for (int c2 = 0; c2 < 64; ++c2) s += pr[c2] * wv[c2];
                    o[cc] = s; }
                u32x4 w; w.x = cvt_pk_bf16(o[0], o[1]); w.y = cvt_pk_bf16(o[2], o[3]); w.z = cvt_pk_bf16(o[4], o[5]); w.w = cvt_pk_bf16(o[6], o[7]);
                *(u32x4*)(dst + c8 * 8) = w;
            }
        }
    }
    {
        const int gw = C.bid * 8 + C.wave, NGW = C.G * 8;
        for (int it = gw; it < DEPTH * 16 * 91; it += NGW) {
            const int l = it / (16 * 91), t = it - l * (16 * 91), kb = t / 91, nb = t - kb * 91;
            bf16* win = WSP(bf16, WS_WIN) + (size_t)l * NZ * D; bf16* wg = WSP(bf16, WS_WG) + (size_t)l * 4096 * D;
            auto rm = [=](int n, float& cs) -> bf16* { cs = (n < 256) ? NA_QS : 1.0f; if (n < ZEND) return win + (size_t)n * D;
                const int g = n - ZEND, br = g >> 10, d = g & 1023, pn = d >> 6, ch = d & 63;
                const int row = 256 * pn + 128 * (br >> 1) + 32 * (ch >> 4) + 16 * (br & 1) + (ch & 15);
                return wg + (size_t)row * D; };
            tconv64(C.in[I_WIN] + (size_t)l * D * IN_COLS, IN_COLS, kb * 64, nb * 64, IN_COLS, nullptr, rm, C.lane);
        }
        for (int it = gw; it < DEPTH * 256; it += NGW) {
            const int l = it >> 8, t = it & 255, kb = t >> 4, nb = t & 15;
            bf16* w = WSP(bf16, WS_WO) + (size_t)l * D * D; auto rm = [=](int n, float& cs) -> bf16* { cs = 1.0f; return w + (size_t)n * D; };
            tconv64(C.in[I_WOUT] + (size_t)l * D * D, D, kb * 64, nb * 64, D, nullptr, rm, C.lane);
        }
        for (int it = gw; it < DEPTH * 4 * 64; it += NGW) {
            const int ln = it >> 6, t = it & 63, kb = t >> 4, nb = t & 15;
            if ((ln & 3) == 1) continue;
            bf16* w = WSP(bf16, WS_WB) + (size_t)ln * 1024 * 256; auto rm = [=](int n, float& cs) -> bf16* { cs = 1.0f; return w + (size_t)n * 256; };
            tconv64(C.in[I_WBR] + (size_t)ln * 256 * 1024, 1024, kb * 64, nb * 64, 1024, nullptr, rm, C.lane);
        }
        for (int it = gw; it < DEPTH * 24; it += NGW) {
            const int l = it / 24, t = it - l * 24, kb = t / 6, nb = t - kb * 6;
            bf16* w = WSP(bf16, WS_WUQ) + (size_t)l * 384 * 256; auto rm = [=](int n, float& cs) -> bf16* { cs = 1.0f; return w + (size_t)n * 256; };
            tconv64(C.in[I_WUQ] + (size_t)l * 256 * 384, 384, kb * 64, nb * 64, 384, C.in[I_QNORM] + l * 256, rm, C.lane);
        }
        for (int it = gw; it < DEPTH * 16; it += NGW) {
            const int l = it >> 4, t = it & 15, kb = t >> 3, nb = t & 7;
            bf16* w = WSP(bf16, WS_WUKV) + (size_t)l * 512 * 128; auto rm = [=](int n, float& cs) -> bf16* { cs = 1.0f; return w + (size_t)n * 128; };
            tconv64(C.in[I_WUKV] + (size_t)l * 128 * 512, 512, kb * 64, nb * 64, 512, C.in[I_KVNORM] + l * 128, rm, C.lane);
        }
    }
    {
        const int gw = C.bid * 8 + C.wave, NGW = C.G * 8;
        for (int it = gw; it < 8192; it += NGW) conv_gu_item(C, 0, it);
        for (int it = gw; it < 8192; it += NGW) conv_dn_item(C, 0, it);
        constexpr int GU_REST = 8192 - GU_SLOT_END, DN_REST = 8192 - DN_SLOT_END;
        for (int it = gw; it < 3 * GU_REST; it += NGW) conv_gu_item(C, 1 + it / GU_REST, GU_SLOT_END + it % GU_REST);
        if (DN_REST > 0) for (int it = gw; it < 3 * DN_REST; it += NGW) conv_dn_item(C, 1 + it / (DN_REST > 0 ? DN_REST : 1), DN_SLOT_END + it % (DN_REST > 0 ? DN_REST : 1));
    }
}

__device__ __forceinline__ void phase_init(const Ctx& C) {
    const int gw = C.bid * 8 + C.wave, NGW = C.G * 8, lane = C.lane;
    const float* mod = WSP(float, WS_MOD);
    for (int row = gw; row < T; row += NGW) {
        const float* src = (row < TL) ? C.in[I_X] + (size_t)row * D : C.in[I_CTX] + (size_t)(row - TL) * D;
        const float* mr = mod + (size_t)mod_row(row) * 6144;
        float* hd = WSP(float, WS_H) + (size_t)row * D; bf16* ud = WSP(bf16, WS_U1) + (size_t)row * D;
#pragma unroll
        for (int j = 0; j < 4; ++j) { const int c = 4 * lane + 256 * j; const f32x4 v = *(const f32x4*)(src + c); const f32x4 sh = *(const f32x4*)(mr + c), sc = *(const f32x4*)(mr + 1024 + c);
            *(f32x4*)(hd + c) = v; const f32x4 u = v * (sc + 1.0f) + sh; u32x2 w; w.x = cvt_pk_bf16(u[0], u[1]); w.y = cvt_pk_bf16(u[2], u[3]); *(u32x2*)(ud + c) = w; }
    }
}


__device__ __forceinline__ int unit_index(int i, int G, int c, int nunits) {
    const int full = nunits / G;
    if (i < full) return i * G + c;
    if (i > full) return -1;
    const int R = nunits - full * G; if (R == 0) return -1;
    const int cpx = G >> 3, per = (R + 7) >> 3, x = c / cpx, k = c - x * cpx, r = x * per + k;
    return (k < per && r < R) ? full * G + r : -1;
}
__device__ __forceinline__ int blk_x(const Ctx& C) { return C.bid / (C.G >> 3); }
__device__ __forceinline__ int blk_k(const Ctx& C) { return C.bid % (C.G >> 3); }
struct SchedDense {
    const char* A; const char* B; size_t lda, ldb; int nunits, G, c, nN;
    __device__ __forceinline__ bool next(int i, g8::Unit& u) const { const int L = unit_index(i, G, c, nunits); if (L < 0) return false; const int pm = L / nN, pn = L - pm * nN;
        u.A = A + (size_t)pm * 256 * lda; u.B = B + (size_t)pn * 256 * ldb; u.r0 = pm * 256; u.c0 = pn * 256; u.x = 0; return true; }
};
struct SchedGroup {
    const char* A; const char* B; size_t lda, ldb, bstride; int nunits, G, c, nN, per;
    __device__ __forceinline__ bool next(int i, g8::Unit& u) const { const int L = unit_index(i, G, c, nunits); if (L < 0) return false; const int e = L / per, r = L - e * per, pm = r / nN, pn = r - pm * nN;
        u.A = A + ((size_t)e * ESLOT + pm * 256) * lda; u.B = B + (size_t)e * bstride + (size_t)pn * 256 * ldb; u.r0 = e * ESLOT + pm * 256; u.c0 = pn * 256; u.x = e; return true; }
};
struct SchedC1 {
    const char* Y; const char* W; int nunits, G, c;
    __device__ __forceinline__ bool next(int i, g8::Unit& u) const { const int L = unit_index(i, G, c, nunits); if (L < 0) return false; const int pm = L >> 4, nb = (L >> 2) & 3, pn = L & 3;
        u.A = Y + ((size_t)nb * T + pm * 256) * 512; u.B = W + ((size_t)nb * 1024 + pn * 256) * 512; u.r0 = pm * 256; u.c0 = nb * 1024 + pn * 256; u.x = 0; return true; }
};
struct EpiStoreBf16 {
    static constexpr bool PERM = true; bf16* O; size_t ldc;
    __device__ __forceinline__ void operator()(const f32x4 (&acc)[2][2][4][2], const g8::Unit& u, int wr, int wc, int fr, int fq) const {
        bf16* base = O + (size_t)(u.r0 + wr * 64 + fr) * ldc + u.c0 + wc * 32 + 8 * fq;
#pragma unroll
        for (int ai = 0; ai < 2; ++ai)
#pragma unroll
            for (int m = 0; m < 4; ++m) { bf16* rowp = base + (size_t)(ai * 128 + m * 16) * ldc;
#pragma unroll
                for (int bj = 0; bj < 2; ++bj) { const f32x4 v0 = acc[ai][bj][m][0], v1 = acc[ai][bj][m][1];
                    u32x4 w; w.x = cvt_pk_bf16(v0[0], v0[1]); w.y = cvt_pk_bf16(v0[2], v0[3]); w.z = cvt_pk_bf16(v1[0], v1[1]); w.w = cvt_pk_bf16(v1[2], v1[3]); *(u32x4*)(rowp + bj * 128) = w; } }
    }
};
struct EpiSwiGLU {
    static constexpr bool PERM = true; bf16* O;
    __device__ __forceinline__ void operator()(const f32x4 (&acc)[2][2][4][2], const g8::Unit& u, int wr, int wc, int fr, int fq) const {
        bf16* base = O + (size_t)(u.r0 + wr * 64 + fr) * FF + (u.c0 >> 1) + wc * 32 + 8 * fq;
#pragma unroll
        for (int ai = 0; ai < 2; ++ai)
#pragma unroll
            for (int m = 0; m < 4; ++m) { float h[8];
#pragma unroll
                for (int n = 0; n < 2; ++n)
#pragma unroll
                    for (int j = 0; j < 4; ++j) { const float a = acc[ai][0][m][n][j], b = acc[ai][1][m][n][j]; h[4 * n + j] = a * __builtin_amdgcn_rcpf(1.0f + fast_exp2(-a * LOG2E)) * b; }
                u32x4 w; w.x = cvt_pk_bf16(h[0], h[1]); w.y = cvt_pk_bf16(h[2], h[3]); w.z = cvt_pk_bf16(h[4], h[5]); w.w = cvt_pk_bf16(h[6], h[7]);
                *(u32x4*)(base + (size_t)(ai * 128 + m * 16) * FF) = w; }
    }
};
struct EpiGateMerge {
    static constexpr bool PERM = false; const bf16* P; bf16* S;
    __device__ __forceinline__ void operator()(const f32x4 (&acc)[2][2][4][2], const g8::Unit& u, int wr, int wc, int fr, int fq) const {
        const int chb = (u.c0 >> 2) + wc * 16 + 4 * fq;
        const bf16* pr0 = P + (size_t)(u.r0 + wr * 64 + fr) * 4096 + chb;
        u32x2 pv[2][4][4];
#pragma unroll
        for (int ai = 0; ai < 2; ++ai)
#pragma unroll
            for (int m = 0; m < 4; ++m)
#pragma unroll
                for (int br = 0; br < 4; ++br) pv[ai][m][br] = *(const u32x2*)(pr0 + (size_t)(ai * 128 + m * 16) * 4096 + br * 1024);
#pragma unroll
        for (int ai = 0; ai < 2; ++ai)
#pragma unroll
            for (int m = 0; m < 4; ++m) { const size_t row = (size_t)(u.r0 + ai * 128 + wr * 64 + m * 16 + fr);
                f32x4 sum = (f32x4){0.f, 0.f, 0.f, 0.f};
#pragma unroll
                for (int bj = 0; bj < 2; ++bj)
#pragma unroll
                    for (int n = 0; n < 2; ++n) { const f32x4 a = acc[ai][bj][m][n]; const u32x2 p = pv[ai][m][2 * bj + n];
                        sum[0] += __builtin_amdgcn_rcpf(1.0f + fast_exp2(-a[0] * LOG2E)) * bflo(p.x); sum[1] += __builtin_amdgcn_rcpf(1.0f + fast_exp2(-a[1] * LOG2E)) * bfhi(p.x);
                        sum[2] += __builtin_amdgcn_rcpf(1.0f + fast_exp2(-a[2] * LOG2E)) * bflo(p.y); sum[3] += __builtin_amdgcn_rcpf(1.0f + fast_exp2(-a[3] * LOG2E)) * bfhi(p.y); }
                u32x2 w; w.x = cvt_pk_bf16(sum[0], sum[1]); w.y = cvt_pk_bf16(sum[2], sum[3]); *(u32x2*)(S + row * D + chb) = w; }
    }
};
struct EpiResid {
    static constexpr bool PERM = false; const float* H; float* X1; const float* mod;
    __device__ __forceinline__ void operator()(const f32x4 (&acc)[2][2][4][2], const g8::Unit& u, int wr, int wc, int fr, int fq) const {
        const int col0 = u.c0 + wc * 32 + 4 * fq;
#pragma unroll
        for (int ai = 0; ai < 2; ++ai)
#pragma unroll
            for (int m = 0; m < 4; ++m) { const int row = u.r0 + ai * 128 + wr * 64 + m * 16 + fr; const float* g1 = mod + (size_t)mod_row(row) * 6144 + 2048; const size_t off = (size_t)row * D;
#pragma unroll
                for (int bj = 0; bj < 2; ++bj)
#pragma unroll
                    for (int n = 0; n < 2; ++n) { const int c = col0 + bj * 128 + n * 16; *(f32x4*)(X1 + off + c) = *(const f32x4*)(H + off + c) * DN_ALPHA + *(const f32x4*)(g1 + c) * acc[ai][bj][m][n]; } }
    }
};
__device__ __forceinline__ void phase_inproj(const Ctx& C, int l) {
    SchedDense S{(const char*)WSP(bf16, WS_U1), (const char*)(WSP(bf16, WS_WIN) + (size_t)l * NZ * D), (size_t)D * 2, (size_t)D * 2, (T / 256) * (NZ / 256), C.G, C.bid, NZ / 256};
    EpiStoreBf16 E{WSP(bf16, WS_Z), (size_t)NZ};
    g8::gemm_phase(C.lds, D, D * 2, D * 2, S, E, C.tid);
}
__device__ __forceinline__ void phase_c1(const Ctx& C, int l, int nrows) {
    SchedC1 S{(const char*)WSP(bf16, WS_Y), (const char*)(WSP(bf16, WS_WB) + (size_t)l * 4 * 1024 * 256), (nrows / 256) * 16, C.G, C.bid};
    EpiStoreBf16 E{WSP(bf16, WS_P), (size_t)4096};
    g8::gemm_phase(C.lds, 256, 512, 512, S, E, C.tid);
}
__device__ __forceinline__ void phase_c2(const Ctx& C, int l, int nrows) {
    SchedDense S{(const char*)WSP(bf16, WS_U1), (const char*)(WSP(bf16, WS_WG) + (size_t)l * 4096 * D), (size_t)D * 2, (size_t)D * 2, (nrows / 256) * 16, C.G, C.bid, 16};
    EpiGateMerge E{WSP(bf16, WS_P), WSP(bf16, WS_S)};
    g8::gemm_phase(C.lds, D, D * 2, D * 2, S, E, C.tid);
}
struct SchedDctx {
    const char* A; const char* B; int G, c;
    __device__ __forceinline__ bool next(int i, g8::Unit& u) const { const int L = unit_index(i, G, c, 128); if (L < 0) return false; const int pm = L >> 4, pn = (L >> 2) & 3, ks = L & 3;
        u.A = A + ((size_t)TL + pm * 256) * (D * 2) + (size_t)ks * 512; u.B = B + (size_t)pn * 256 * (D * 2) + (size_t)ks * 512; u.r0 = ks * TC + pm * 256; u.c0 = pn * 256; u.x = ks; return true; }
};
struct EpiRawF32 {
    static constexpr bool PERM = false; float* O;
    __device__ __forceinline__ void operator()(const f32x4 (&acc)[2][2][4][2], const g8::Unit& u, int wr, int wc, int fr, int fq) const {
        float* base = O + (size_t)(u.r0 + wr * 64 + fr) * D + u.c0 + wc * 32 + 4 * fq;
#pragma unroll
        for (int ai = 0; ai < 2; ++ai)
#pragma unroll
            for (int m = 0; m < 4; ++m)
#pragma unroll
                for (int bj = 0; bj < 2; ++bj)
#pragma unroll
                    for (int n = 0; n < 2; ++n) *(f32x4*)(base + (size_t)(ai * 128 + m * 16) * D + bj * 128 + n * 16) = acc[ai][bj][m][n];
    }
};
__device__ __forceinline__ void phase_d(const Ctx& C, int l, int nrows) {
    {
        SchedDense S{(const char*)WSP(bf16, WS_S), (const char*)(WSP(bf16, WS_WO) + (size_t)l * D * D), (size_t)D * 2, (size_t)D * 2, (TL / 256) * 4, C.G, C.bid, 4};
        EpiResid E{WSP(float, WS_H), WSP(float, WS_X1), WSP(float, WS_MOD) + (size_t)l * 9 * 6144};
        g8::gemm_phase(C.lds, D, D * 2, D * 2, S, E, C.tid);
    }
    if (nrows > TL) {
        SchedDctx S{(const char*)WSP(bf16, WS_S), (const char*)(WSP(bf16, WS_WO) + (size_t)l * D * D), C.G, C.bid};
        EpiRawF32 E{(float*)(C.ws + WS_XE + (size_t)4 * NE * 256 * D * 2)};
        g8::gemm_phase(C.lds, 256, D * 2, D * 2, S, E, C.tid);
    }
}
__device__ __forceinline__ void phase_g(const Ctx& C, int l, int mt) {
    LAS int* srow = (LAS int*)(C.lds + g8::STAGE_BYTES);
    const int per = mt * 16, nunits = NE * per; const int* SROW = WSP(int, WS_SROW);
    for (int i = 0; i < 9; ++i) { const int L = unit_index(i, C.G, C.bid, nunits); if (L >= 0 && C.tid < 256) { const int e = L / per, r = L - e * per, pm = r >> 4; srow[i * 256 + C.tid] = SROW[e * ESLOT + pm * 256 + C.tid]; } }
    __syncthreads();
    SchedGroup S{(const char*)WSP(bf16, WS_U2), (const char*)(WSP(bf16, WS_WGU) + (size_t)l * NE * 4096 * D), (size_t)0, (size_t)D * 2, (size_t)4096 * D * 2, nunits, C.G, C.bid, 16, per};
    EpiSwiGLU E{WSP(bf16, WS_ACT)};
    g8::gemm_phase<EpiSwiGLU, SchedGroup, true>(C.lds, D, D * 2, D * 2, S, E, C.tid, srow);
    __syncthreads();
}
struct SchedHctx {
    const char* A; const char* B; int G, c;
    __device__ __forceinline__ bool next(int i, g8::Unit& u) const { const int L = unit_index(i, G, c, NE * 16); if (L < 0) return false; const int e = L >> 4, pn = (L >> 2) & 3, ks = L & 3;
        u.A = A + ((size_t)e * ESLOT + NB * CAPL) * (FF * 2) + (size_t)ks * 1024; u.B = B + ((size_t)e * D + pn * 256) * (FF * 2) + (size_t)ks * 1024; u.r0 = ks * (NE * 256) + e * 256; u.c0 = pn * 256; u.x = e; return true; }
};
__device__ __forceinline__ void phase_h(const Ctx& C, int l, int mt) {
    {
        SchedGroup S{(const char*)WSP(bf16, WS_ACT), (const char*)(WSP(bf16, WS_WD) + (size_t)l * NE * D * FF), (size_t)FF * 2, (size_t)FF * 2, (size_t)D * FF * 2, NE * 8 * 4, C.G, C.bid, 4, 8 * 4};
        EpiStoreBf16 E{WSP(bf16, WS_YE), (size_t)D};
        g8::gemm_phase(C.lds, FF, FF * 2, FF * 2, S, E, C.tid);
    }
    if (mt == 9) {
        SchedHctx S{(const char*)WSP(bf16, WS_ACT), (const char*)(WSP(bf16, WS_WD) + (size_t)l * NE * D * FF), C.G, C.bid};
        EpiStoreBf16 E{WSP(bf16, WS_XE), (size_t)D};
        g8::gemm_phase(C.lds, 512, FF * 2, FF * 2, S, E, C.tid);
    }
}

__device__ __forceinline__ void na_unit_latent(const Ctx& C, int l, int u) {
    const int b = u >> 5, hh = (u >> 3) & 3, rr = u & 7, w = C.wave;
    const bf16* Z = WSP(bf16, WS_Z);
    LAS float* btab = (LAS float*)(C.lds + 110 * 1024 + 256);
    for (int i = C.tid; i < 15 * 31; i += 512) btab[i] = C.in[I_RPB][((size_t)l * 4 + hh) * 465 + i] * LOG2E;
    __syncthreads();
    const int R = 4 * rr + (w >> 1), qc0 = 32 * (w & 1);
    int kr_lo = 4 * rr - 4; kr_lo = kr_lo < 0 ? 0 : (kr_lo > 24 ? 24 : kr_lo);
    int kr_hi = 4 * rr - 1; kr_hi = (kr_hi < 0 ? 0 : (kr_hi > 24 ? 24 : kr_hi)) + 8;
    int r0w = R - 4; r0w = r0w < 0 ? 0 : (r0w > 24 ? 24 : r0w);
    const size_t lat0 = (size_t)b * SEQ, ctx0 = (size_t)TL + (size_t)b * CTX;
    const bf16* q = Z + (lat0 + R * 64 + qc0) * NZ + ZQ + hh * 64;
    bf16* o = WSP(bf16, WS_Y) + (lat0 + R * 64 + qc0) * 256 + hh * 64;
    attn_unit<64, true>(C, q, NZ, Z + ctx0 * NZ + ZK + hh * 64, Z + ctx0 * NZ + ZV + hh * 64, 4,
                        Z + (lat0 + kr_lo * 64) * NZ + ZK + hh * 64, Z + (lat0 + kr_lo * 64) * NZ + ZV + hh * 64, kr_hi - kr_lo,
                        NZ, NZ, o, 256, r0w - kr_lo, r0w - kr_lo + 8, kr_lo - R + 7, qc0, btab);
    __syncthreads();
}
__device__ __forceinline__ void na_unit_ctx(const Ctx& C, int u) {
    const int b = u >> 2, hh = u & 3, w = C.wave;
    const bf16* Z = WSP(bf16, WS_Z);
    const size_t ctx0 = (size_t)TL + (size_t)b * CTX;
    const bf16* q = Z + (ctx0 + 32 * w) * NZ + ZQ + hh * 64;
    bf16* o = WSP(bf16, WS_Y) + (ctx0 + 32 * w) * 256 + hh * 64;
    attn_unit<64, false>(C, q, NZ, Z + ctx0 * NZ + ZK + hh * 64, Z + ctx0 * NZ + ZV + hh * 64, 4, nullptr, nullptr, 0, NZ, NZ, o, 256, 0, 0, 0, 0, nullptr);
    __syncthreads();
}
template <int NC>
__device__ __forceinline__ void row_rms(const Ctx& C, int tm, int zc, LAS float* rs) {
    const bf16* Z = WSP(bf16, WS_Z);
    const int r = C.tid >> 2, part = C.tid & 3;
    const bf16* p = Z + (size_t)(tm * 128 + r) * NZ + zc + part * (NC / 4);
    float s = 0.f;
#pragma unroll
    for (int i = 0; i < NC / 32; ++i) { const u32x4 v = *(const u32x4*)(p + 8 * i);
        const float a0 = bflo(v.x), a1 = bfhi(v.x), a2 = bflo(v.y), a3 = bfhi(v.y), a4 = bflo(v.z), a5 = bfhi(v.z), a6 = bflo(v.w), a7 = bfhi(v.w);
        s += a0 * a0 + a1 * a1 + a2 * a2 + a3 * a3 + a4 * a4 + a5 * a5 + a6 * a6 + a7 * a7; }
    s += __shfl_xor(s, 1); s += __shfl_xor(s, 2);
    if (part == 0) rs[r] = 1.0f / sqrtf(s * (1.0f / NC) + LN_EPS);
    __syncthreads();
}
__device__ __forceinline__ void mlaq_tile(const Ctx& C, int l, int u) {
    const int tm = u / 3, tn = u % 3;
    LAS float* rs = (LAS float*)(C.lds + 110 * 1024);
    row_rms<256>(C, tm, ZCQ, rs);
    const bf16* Z = WSP(bf16, WS_Z); const bf16* W = WSP(bf16, WS_WUQ) + (size_t)l * 384 * 256; bf16* QM = WSP(bf16, WS_QM);
    const float* rope = WSP(float, WS_ROPE);
    auto arow = [=](int r) { return Z + (size_t)(tm * 128 + r) * NZ + ZCQ; };
    auto brow = [=](int r) { return W + (size_t)(tn * 128 + r) * 256; };
    auto epi = [=](const f32x4 (&acc)[4][2], int wr, int wc, int fr, int fq) {
#pragma unroll
        for (int m = 0; m < 4; ++m)
#pragma unroll
            for (int n = 0; n < 2; ++n) { const int rl = wr * 64 + m * 16 + fr, row = tm * 128 + rl, col = tn * 128 + wc * 32 + n * 16 + 4 * fq;
                const float s = rs[rl] * MLA_QS; f32x4 v = acc[m][n] * s;
                const int cc = col % 96;
                if (cc >= 64 && row < TL) { const int pos = row & 2047, pi = (cc - 64) >> 1; const f32x4 cs = *(const f32x4*)(rope + (size_t)pos * 32 + 2 * pi);
                    const float x1 = v[0], x2 = v[1], y1 = v[2], y2 = v[3];
                    v[0] = x1 * cs[0] - x2 * cs[1]; v[1] = x1 * cs[1] + x2 * cs[0]; v[2] = y1 * cs[2] - y2 * cs[3]; v[3] = y1 * cs[3] + y2 * cs[2]; }
                u32x2 w; w.x = cvt_pk_bf16(v[0], v[1]); w.y = cvt_pk_bf16(v[2], v[3]); *(u32x2*)(QM + (size_t)row * 384 + col) = w; }
    };
    sgemm_tile(C, arow, brow, 256, 0, epi);
}
__device__ __forceinline__ void mlakv_tile(const Ctx& C, int l, int u) {
    const int tm = u >> 2, tn = u & 3;
    LAS float* rs = (LAS float*)(C.lds + 110 * 1024);
    row_rms<128>(C, tm, ZCKV, rs);
    const bf16* Z = WSP(bf16, WS_Z); const bf16* W = WSP(bf16, WS_WUKV) + (size_t)l * 512 * 128; bf16* KM = WSP(bf16, WS_KM); bf16* VM = WSP(bf16, WS_VM);
    const float* rope = WSP(float, WS_ROPE);
    auto arow = [=](int r) { return Z + (size_t)(tm * 128 + r) * NZ + ZCKV; };
    auto brow = [=](int r) { return W + (size_t)(tn * 128 + r) * 128; };
    auto epi = [=](const f32x4 (&acc)[4][2], int wr, int wc, int fr, int fq) {
#pragma unroll
        for (int m = 0; m < 4; ++m)
#pragma unroll
            for (int n = 0; n < 2; ++n) { const int rl = wr * 64 + m * 16 + fr, row = tm * 128 + rl, c = wc * 32 + n * 16 + 4 * fq;
                const f32x4 v = acc[m][n] * rs[rl]; u32x2 w; w.x = cvt_pk_bf16(v[0], v[1]); w.y = cvt_pk_bf16(v[2], v[3]);
                if (c < 64) *(u32x2*)(KM + (size_t)row * 384 + tn * 96 + c) = w; else *(u32x2*)(VM + (size_t)row * 256 + tn * 64 + (c - 64)) = w; }
    };
    sgemm_tile(C, arow, brow, 128, 0, epi);
    for (int i = C.tid; i < 128 * 8; i += 512) { const int rl = i >> 3, g4 = i & 7, row = tm * 128 + rl;
        const u32x2 w = *(const u32x2*)(Z + (size_t)row * NZ + ZKR + 4 * g4); float x1 = bflo(w.x), x2 = bfhi(w.x), y1 = bflo(w.y), y2 = bfhi(w.y);
        if (row < TL) { const int pos = row & 2047; const f32x4 cs = *(const f32x4*)(rope + (size_t)pos * 32 + 4 * g4);
            const float a = x1 * cs[0] - x2 * cs[1], b2 = x1 * cs[1] + x2 * cs[0], c2 = y1 * cs[2] - y2 * cs[3], d2 = y1 * cs[3] + y2 * cs[2]; x1 = a; x2 = b2; y1 = c2; y2 = d2; }
        u32x2 o; o.x = cvt_pk_bf16(x1, x2); o.y = cvt_pk_bf16(y1, y2); *(u32x2*)(KM + (size_t)row * 384 + tn * 96 + 64 + 4 * g4) = o; }
}
__device__ __forceinline__ void fft1_tile(const Ctx& C, int u) {
    const bf16* Z = WSP(bf16, WS_Z); const bf16* T64 = WSP(bf16, WS_T64);
    int b, g, ch; size_t tok0; bf16* dst; int ldd, half;
    if (u < 512) { b = u >> 6; g = (u >> 4) & 3; ch = u & 15; tok0 = (size_t)b * SEQ + ch * 128; dst = WSP(bf16, WS_FB) + (size_t)((b * 4 + g) * 64) * 4096 + ch * 128; ldd = 4096; half = 2048; }
    else { const int v = u - 512; b = v >> 3; g = (v >> 1) & 3; ch = v & 1; tok0 = (size_t)TL + (size_t)b * CTX + ch * 128; dst = WSP(bf16, WS_FBC) + (size_t)((b * 4 + g) * 64) * 512 + ch * 128; ldd = 512; half = 256; }
    auto arow = [=](int r) { return T64 + (size_t)r * 64; };
    auto brow = [=](int r) { return Z + (tok0 + r) * NZ + ZF + g * 64; };
    auto epi = [=](const f32x4 (&acc)[4][2], int wr, int wc, int fr, int fq) {
#pragma unroll
        for (int m = 0; m < 4; ++m)
#pragma unroll
            for (int n = 0; n < 2; ++n) { const int mrow = wr * 64 + m * 16 + fr, col = wc * 32 + n * 16 + 4 * fq;
                u32x2 w; w.x = cvt_pk_bf16(acc[m][n][0], acc[m][n][1]); w.y = cvt_pk_bf16(acc[m][n][2], acc[m][n][3]);
                *(u32x2*)(dst + (size_t)(mrow & 63) * ldd + (mrow >> 6) * half + col) = w; }
    };
    sgemm_tile(C, arow, brow, 64, 0, epi);
}
__device__ __forceinline__ void pool_all(const Ctx& C) {
    const bf16* Z = WSP(bf16, WS_Z); bf16* Y1 = WSP(bf16, WS_Y) + (size_t)T * 256;
    const size_t gtid = (size_t)C.bid * 512 + C.tid, gth = (size_t)C.G * 512;
    for (size_t i = gtid; i < (size_t)T * 32; i += gth) {
        const int row = (int)(i >> 5), c8 = (int)(i & 31), g = c8 >> 3;
        const int L = row < TL ? SEQ : CTX, s0 = row < TL ? (row & ~2047) : TL + ((row - TL) & ~255), t = row - s0, half = 1 << g;
        int lo = t - half; lo = lo < 0 ? 0 : lo; int hi = t + half; hi = hi > L ? L : hi;
        float a[8];
#pragma unroll
        for (int q = 0; q < 8; ++q) a[q] = 0.f;
        for (int tt = lo; tt < hi; ++tt) { const u32x4 v = *(const u32x4*)(Z + (size_t)(s0 + tt) * NZ + ZP + c8 * 8);
            a[0] += bflo(v.x); a[1] += bfhi(v.x); a[2] += bflo(v.y); a[3] += bfhi(v.y); a[4] += bflo(v.z); a[5] += bfhi(v.z); a[6] += bflo(v.w); a[7] += bfhi(v.w); }
        const float inv = 1.0f / (float)(hi - lo);
        const u32x4 me = *(const u32x4*)(Z + (size_t)row * NZ + ZP + c8 * 8);
        u32x4 o; o.x = cvt_pk_bf16(a[0] * inv - bflo(me.x), a[1] * inv - bfhi(me.x)); o.y = cvt_pk_bf16(a[2] * inv - bflo(me.y), a[3] * inv - bfhi(me.y));
        o.z = cvt_pk_bf16(a[4] * inv - bflo(me.z), a[5] * inv - bfhi(me.z)); o.w = cvt_pk_bf16(a[6] * inv - bflo(me.w), a[7] * inv - bfhi(me.w));
        *(u32x4*)(Y1 + (size_t)row * 256 + c8 * 8) = o;
    }
}
__device__ __forceinline__ void phase_b0(const Ctx& C, int l) {
    const bool wc = l < DEPTH - 1;
    const int n_na = 256, n_nac = wc ? 32 : 0, n_q = (T / 128) * 3, n_kv = (T / 128) * 4, n_f = 576;
    const int total = n_na + n_nac + n_q + n_kv + n_f;
    for (int u = C.bid; u < total; u += C.G) {
        int v = u;
        if (v < n_na) { na_unit_latent(C, l, v); continue; } v -= n_na;
        if (v < n_nac) { na_unit_ctx(C, v); continue; } v -= n_nac;
        if (v < n_q) { mlaq_tile(C, l, v); continue; } v -= n_q;
        if (v < n_kv) { mlakv_tile(C, l, v); continue; } v -= n_kv;
        fft1_tile(C, v);
    }
    pool_all(C);
}

__device__ __forceinline__ void mla_unit(const Ctx& C, int u, bool ctxq) {
    const bf16* QM = WSP(bf16, WS_QM); const bf16* KM = WSP(bf16, WS_KM); const bf16* VM = WSP(bf16, WS_VM);
    bf16* Y3 = WSP(bf16, WS_Y) + (size_t)3 * T * 256;
    const int w = C.wave;
    if (!ctxq) {
        const int b = u >> 5, hh = (u >> 3) & 3, qb = u & 7;
        const size_t lat0 = (size_t)b * SEQ, ctx0 = (size_t)TL + (size_t)b * CTX, q0 = lat0 + qb * 256 + w * 32;
        attn_unit<96, false>(C, QM + q0 * 384 + hh * 96, 384, KM + lat0 * 384 + hh * 96, VM + lat0 * 256 + hh * 64, 32,
                             KM + ctx0 * 384 + hh * 96, VM + ctx0 * 256 + hh * 64, 4, 384, 256, Y3 + q0 * 256 + hh * 64, 256, 0, 0, 0, 0, nullptr);
    } else {
        const int b = u >> 2, hh = u & 3;
        const size_t ctx0 = (size_t)TL + (size_t)b * CTX, q0 = ctx0 + w * 32;
        attn_unit<96, false>(C, QM + q0 * 384 + hh * 96, 384, KM + ctx0 * 384 + hh * 96, VM + ctx0 * 256 + hh * 64, 4,
                             nullptr, nullptr, 0, 384, 256, Y3 + q0 * 256 + hh * 64, 256, 0, 0, 0, 0, nullptr);
    }
    __syncthreads();
}
__device__ __forceinline__ void fft2_tile(const Ctx& C, int u, bool ctxq) {
    bf16* Y2 = WSP(bf16, WS_Y) + (size_t)2 * T * 256;
    if (!ctxq) {
        const int tm = u >> 4, tn = u & 15, b = tn >> 1;
        const bf16* A = WSP(bf16, WS_AFFT); const bf16* Bt = WSP(bf16, WS_FB);
        auto arow = [=](int r) { return A + (size_t)(tm * 128 + r) * 4096; };
        auto brow = [=](int r) { return Bt + (size_t)(tn * 128 + r) * 4096; };
        auto epi = [=](const f32x4 (&acc)[4][2], int wr, int wc, int fr, int fq) {
#pragma unroll
            for (int m = 0; m < 4; ++m)
#pragma unroll
                for (int n = 0; n < 2; ++n) { const int k1 = tm * 128 + wr * 64 + m * 16 + fr, chn = (tn & 1) * 128 + wc * 32 + n * 16 + 4 * fq;
                    u32x2 w; w.x = cvt_pk_bf16(acc[m][n][0], acc[m][n][1]); w.y = cvt_pk_bf16(acc[m][n][2], acc[m][n][3]);
                    *(u32x2*)(Y2 + ((size_t)b * SEQ + k1) * 256 + chn) = w; }
        };
        sgemm_tile(C, arow, brow, 4096, 0, epi);
    } else {
        const int tm = u >> 4, tn = u & 15, b = tn >> 1;
        const bf16* A = WSP(bf16, WS_AFFTC); const bf16* Bt = WSP(bf16, WS_FBC);
        auto arow = [=](int r) { return A + (size_t)(tm * 128 + r) * 512; };
        auto brow = [=](int r) { return Bt + (size_t)(tn * 128 + r) * 512; };
        auto epi = [=](const f32x4 (&acc)[4][2], int wr, int wc, int fr, int fq) {
#pragma unroll
            for (int m = 0; m < 4; ++m)
#pragma unroll
                for (int n = 0; n < 2; ++n) { const int k1 = tm * 128 + wr * 64 + m * 16 + fr, chn = (tn & 1) * 128 + wc * 32 + n * 16 + 4 * fq;
                    u32x2 w; w.x = cvt_pk_bf16(acc[m][n][0], acc[m][n][1]); w.y = cvt_pk_bf16(acc[m][n][2], acc[m][n][3]);
                    *(u32x2*)(Y2 + ((size_t)TL + (size_t)b * CTX + k1) * 256 + chn) = w; }
        };
        sgemm_tile(C, arow, brow, 512, 0, epi);
    }
}
__device__ __forceinline__ void phase_b1(const Ctx& C, int l) {
    const bool wc = l < DEPTH - 1;
    const int n_m = 256, n_f = 256, n_mc = wc ? 32 : 0, n_fc = wc ? 32 : 0;
    const int total = n_m + n_f + n_mc + n_fc;
    for (int u = C.bid; u < total; u += C.G) {
        int v = u;
        if (v < n_m) { mla_unit(C, v, false); continue; } v -= n_m;
        if (v < n_f) { fft2_tile(C, v, false); continue; } v -= n_f;
        if (v < n_mc) { mla_unit(C, v, true); continue; } v -= n_mc;
        fft2_tile(C, v, true);
    }
}

__device__ __forceinline__ void phase_e(const Ctx& C, int l, int nrows) {
    LAS float* wr = (LAS float*)C.lds;
    LAS float* lgl = (LAS float*)(C.lds + 65536);
    LAS float* lbl = lgl + 1024;
    LAS float* mdl = lbl + 1024;
    const int tid = C.tid, lane = C.lane, rg = lane >> 4, li = lane & 15;
    {   f32x4 wv[8];
#pragma unroll
        for (int q = 0; q < 8; ++q) wv[q] = *(const f32x4*)(C.in[I_WROUTER] + (size_t)l * 16384 + 4 * (tid + 512 * q));
        const f32x4 gv = *(const f32x4*)(C.in[(tid < 256) ? I_LN1G : I_LN1B] + l * D + 4 * (tid & 255));
#pragma unroll
        for (int q = 0; q < 8; ++q) { const int i4 = tid + 512 * q, d = i4 >> 2, e4 = (i4 & 3) * 4; wr[(e4 + 0) * 1024 + d] = wv[q][0]; wr[(e4 + 1) * 1024 + d] = wv[q][1]; wr[(e4 + 2) * 1024 + d] = wv[q][2]; wr[(e4 + 3) * 1024 + d] = wv[q][3]; }
        *(LAS f32x4*)(((tid < 256) ? lgl : lbl) + 4 * (tid & 255)) = gv; }
    const int bkk = blk_k(C), bxx = blk_x(C), bp = (bkk < 8) ? bxx * 8 + bkk : 64 + bxx * 24 + (bkk - 8);
    const int gw = bp * 8 + C.wave, NGW = C.G * 8, ngroups = nrows >> 2;
    const float* mod = WSP(float, WS_MOD) + (size_t)l * 9 * 6144;
    const float* X1 = WSP(float, WS_X1);
    float* AFFT = WSP(float, WS_AFF);
    f32x4 nx[16]; f32x4 nmd;
    const int mdv = tid >> 8, mdc = (tid & 255) * 4;
    if (gw < ngroups) {
        const int row = 4 * gw + rg; const float* mr = mod + (size_t)mod_row(4 * gw) * 6144;
#pragma unroll
        for (int j = 0; j < 16; ++j) nx[j] = *(const f32x4*)(X1 + (size_t)row * D + 4 * li + 64 * j);
        nmd = *(const f32x4*)(mr + (mdv ? 3072 : 4096) + mdc);
    }
    for (int g = gw, it = 0; g < ngroups; g += NGW, ++it) {
        {   f32x4 w = nmd; if (mdv == 0) w = w + 1.0f; *(LAS f32x4*)(mdl + (it & 1) * 2048 + mdv * 1024 + mdc) = w; }
        __syncthreads();
        const LAS float* scl = mdl + (it & 1) * 2048; const LAS float* shl = scl + 1024;
        f32x4 v[16]; float s = 0.f;
        const int row = 4 * g + rg;
        if (4 * g < TL) {
#pragma unroll
            for (int j = 0; j < 16; ++j) v[j] = nx[j];
        } else {
            const float* hr = WSP(float, WS_H) + (size_t)row * D + 4 * li; const float* g1 = mod + (size_t)8 * 6144 + 2048 + 4 * li;
            const float* pc = (const float*)(C.ws + WS_XE + (size_t)4 * NE * 256 * D * 2) + (size_t)(row - TL) * D + 4 * li;
#pragma unroll
            for (int j = 0; j < 16; ++j) { const f32x4 p0 = *(const f32x4*)(pc + 64 * j), p1 = *(const f32x4*)(pc + (size_t)TC * D + 64 * j), p2 = *(const f32x4*)(pc + (size_t)2 * TC * D + 64 * j), p3 = *(const f32x4*)(pc + (size_t)3 * TC * D + 64 * j);
                v[j] = *(const f32x4*)(hr + 64 * j) * DN_ALPHA + *(const f32x4*)(g1 + 64 * j) * ((p0 + p1) + (p2 + p3));
                *(f32x4*)(WSP(float, WS_X1) + (size_t)row * D + 4 * li + 64 * j) = v[j]; }
        }
#pragma unroll
        for (int j = 0; j < 16; ++j) s += (v[j][0] + v[j][1]) + (v[j][2] + v[j][3]);
        if (g + NGW < ngroups) { const int gn = g + NGW, rn = 4 * gn + rg; const float* mr = mod + (size_t)mod_row(4 * gn) * 6144;
            if (4 * gn < TL) {
#pragma unroll
                for (int j = 0; j < 16; ++j) nx[j] = *(const f32x4*)(X1 + (size_t)rn * D + 4 * li + 64 * j);
            }
            nmd = *(const f32x4*)(mr + (mdv ? 3072 : 4096) + mdc); }
        const float mean = row16_sum(s) * (1.0f / D); float q = 0.f;
#pragma unroll
        for (int j = 0; j < 16; ++j) { v[j] = v[j] - mean; q += (v[j][0] * v[j][0] + v[j][1] * v[j][1]) + (v[j][2] * v[j][2] + v[j][3] * v[j][3]); }
        const float rstd = 1.0f / sqrtf(row16_sum(q) * (1.0f / D) + LN_EPS);
        float lgt[16];
#pragma unroll
        for (int e = 0; e < 16; ++e) lgt[e] = 0.f;
        bf16* ud = WSP(bf16, WS_U2) + (size_t)row * D + 4 * li;
        if (li == 0) { typedef float f32x2v __attribute__((ext_vector_type(2))); *(f32x2v*)(WSP(float, WS_ST1) + (size_t)row * 2) = (f32x2v){mean, rstd}; }
#pragma unroll
        for (int j = 0; j < 16; ++j) { const int c = 4 * li + 64 * j;
            const f32x4 y = v[j] * rstd * *(const LAS f32x4*)(lgl + c) + *(const LAS f32x4*)(lbl + c);
            const f32x4 uu = y * *(const LAS f32x4*)(scl + c) + *(const LAS f32x4*)(shl + c);
            u32x2 w; w.x = cvt_pk_bf16(uu[0], uu[1]); w.y = cvt_pk_bf16(uu[2], uu[3]); st_wt8(ud + 64 * j, w);
#pragma unroll
            for (int eh = 0; eh < 4; ++eh) {
                f32x4 ww[4];
#pragma unroll
                for (int e = 0; e < 4; ++e) ww[e] = *(const LAS f32x4*)(wr + (4 * eh + e) * 1024 + c);
                __builtin_amdgcn_sched_barrier(0);
#pragma unroll
                for (int e = 0; e < 4; ++e) lgt[4 * eh + e] += (uu[0] * ww[e][0] + uu[1] * ww[e][1]) + (uu[2] * ww[e][2] + uu[3] * ww[e][3]);
                __builtin_amdgcn_sched_barrier(0);
            }
        }
        float mx = -1e30f;
#pragma unroll
        for (int e = 0; e < 16; ++e) { lgt[e] = row16_sum(lgt[e]); mx = fmaxf(mx, lgt[e]); }
        float den = 0.f;
#pragma unroll
        for (int e = 0; e < 16; ++e) { lgt[e] = __expf(lgt[e] - mx); den += lgt[e]; }
        const float inv = 1.0f / den; float mine = 0.f;
#pragma unroll
        for (int e = 0; e < 16; ++e) mine = (li == e) ? lgt[e] * inv : mine;
        AFFT[(size_t)li * T + row] = mine;
    }
    __syncthreads();
}
__device__ __forceinline__ void phase_f(const Ctx& C, int l) {
    const bool wc = l < DEPTH - 1;
    const int nunits = 128 + (wc ? 128 : 0);
    LAS unsigned* hist = (LAS unsigned*)(C.lds);
    LAS unsigned* wsum = (LAS unsigned*)(C.lds + 256);
    const int tid = C.tid, lane = C.lane, wave = C.wave;
    const float* AFF = WSP(float, WS_AFF); int* SLOT = WSP(int, WS_SLOT); float* GATEV = WSP(float, WS_GATEV); int* SROW = WSP(int, WS_SROW);
    {
        const int bx = blk_x(C), bk = blk_k(C); const int u = (bk < 16) ? bx * 16 + bk : 128 + bx * 16 + (bk - 16);
        if (u < nunits) {
        const bool isc = u >= 128; const int v = isc ? u - 128 : u, b = v >> 4, e = v & 15;
        const int cap = isc ? CAPC : CAPL, vpt = isc ? 1 : 4;
        const int row0 = isc ? TL + b * CTX : b * SEQ;
        const int sbase = e * ESLOT + (isc ? NB * CAPL + b * CAPC : b * CAPL);
        const bool have = isc ? (tid < 256) : true;
        unsigned key[4];
#pragma unroll
        for (int i = 0; i < 4; ++i) { key[i] = 0u; if (have && i < vpt) key[i] = __float_as_uint(AFF[(size_t)e * T + row0 + tid * vpt + i]); }
        if (tid < 48) hist[tid] = 0u;
        __syncthreads();
        unsigned prefix = 0u; int kth = cap;
#pragma unroll 1
        for (int it = 0; it < 8; ++it) {
            const int shift = 28 - 4 * it; LAS unsigned* hb = hist + 16 * (it % 3);
            if (tid < 16) hist[16 * ((it + 1) % 3) + tid] = 0u;
            unsigned mycnt = 0u;
#pragma unroll
            for (int i = 0; i < 4; ++i) {
                const bool in = have && i < vpt && (it == 0 || (key[i] >> (shift + 4)) == (prefix >> (shift + 4)));
                const unsigned dg = (key[i] >> shift) & 15u;
#pragma unroll
                for (int d = 0; d < 16; ++d) { const unsigned c = (unsigned)__popcll(__ballot(in && dg == (unsigned)d)); mycnt = (lane == d) ? mycnt + c : mycnt; }
            }
            if (lane < 16 && mycnt) atomicAdd((unsigned*)(hb + lane), mycnt);
            __syncthreads();
            unsigned cum = 0u; int dsel = 0; int kn = kth;
#pragma unroll
            for (int d = 15; d >= 0; --d) { const unsigned h = hb[d]; const bool hit = (cum < (unsigned)kth) && (cum + h >= (unsigned)kth); if (hit) { dsel = d; kn = kth - (int)cum; } cum += h; }
            prefix |= ((unsigned)dsel << shift); kth = kn;
        }
        const unsigned thr = prefix;
        unsigned neq = 0;
#pragma unroll
        for (int i = 0; i < 4; ++i) if (have && i < vpt) neq += (key[i] == thr);
        unsigned incl = neq;
#pragma unroll
        for (int o = 1; o < 64; o <<= 1) { const unsigned t2 = __shfl_up(incl, o); if (lane >= o) incl += t2; }
        if (lane == 63) wsum[wave] = incl;
        __syncthreads();
        unsigned woff = 0;
        for (int w2 = 0; w2 < wave; ++w2) woff += wsum[w2];
        unsigned eqrank = woff + incl - neq;
        unsigned sel[4]; unsigned nsel = 0;
#pragma unroll
        for (int i = 0; i < 4; ++i) { sel[i] = 0u; if (have && i < vpt) { if (key[i] > thr) sel[i] = 1u; else if (key[i] == thr) { sel[i] = ((int)eqrank < kth) ? 1u : 0u; ++eqrank; } nsel += sel[i]; } }
        incl = nsel;
#pragma unroll
        for (int o = 1; o < 64; o <<= 1) { const unsigned t2 = __shfl_up(incl, o); if (lane >= o) incl += t2; }
        if (lane == 63) wsum[8 + wave] = incl;
        __syncthreads();
        woff = 0;
        for (int w2 = 0; w2 < wave; ++w2) woff += wsum[8 + w2];
        unsigned pos = woff + incl - nsel;
#pragma unroll
        for (int i = 0; i < 4; ++i) if (have && i < vpt) { const int t = tid * vpt + i; int slot = -1;
            if (sel[i]) { slot = sbase + (int)pos; SROW[slot] = row0 + t; GATEV[slot] = __uint_as_float(key[i]); ++pos; }
            SLOT[(size_t)(row0 + t) * 16 + e] = slot; }
        __syncthreads();
    }
    }
}
__device__ __forceinline__ void phase_i(const Ctx& C, int l, int nrows) {
    LAS float* lgl = (LAS float*)C.lds;
    LAS float* lbl = lgl + 1024;
    LAS float* mdl = lbl + 1024;
    const int tid = C.tid, lane = C.lane, rg = lane >> 4, li = lane & 15;
    LAS float* l1g = mdl + 6144;
    LAS float* l1b = l1g + 1024;
    for (int i = tid; i < 1024; i += 512) { lgl[i] = C.in[I_LN2G][l * D + i]; lbl[i] = C.in[I_LN2B][l * D + i]; l1g[i] = C.in[I_LN1G][l * D + i]; l1b[i] = C.in[I_LN1B][l * D + i]; }
    const int bkk = blk_k(C), bxx = blk_x(C), bp = (bkk < 8) ? bxx * 8 + bkk : 64 + bxx * 24 + (bkk - 8);
    const int gw = bp * 8 + C.wave, NGW = C.G * 8, ngroups = nrows >> 2;
    const float* mod = WSP(float, WS_MOD) + (size_t)l * 9 * 6144;
    const float* modn = WSP(float, WS_MOD) + (size_t)(l + 1 < DEPTH ? l + 1 : l) * 9 * 6144;
    const int* SLOT = WSP(int, WS_SLOT); const float* GATEV = WSP(float, WS_GATEV); const bf16* YE = WSP(bf16, WS_YE); const bf16* YEC = WSP(bf16, WS_XE);
    float* Hb = WSP(float, WS_H); bf16* U1b = WSP(bf16, WS_U1); const float* X1b = WSP(float, WS_X1);
    const int mdv = tid >> 8, mdc = (tid & 255) * 4;
    auto mdload = [&](int g4row) -> f32x4 { const int r = mod_row(g4row); const float* p = (mdv == 0) ? mod + (size_t)r * 6144 + 5120 + mdc : modn + (size_t)r * 6144 + (mdv == 1 ? 1024 : 0) + mdc; return *(const f32x4*)p; };
    f32x4 nmd0 = (f32x4){0.f, 0.f, 0.f, 0.f}, nmd1 = nmd0;
    if (gw < ngroups) { nmd0 = mdload(4 * gw); if (tid < 256) { const int r = mod_row(4 * gw); nmd1 = *(const f32x4*)(modn + (size_t)r * 6144 + mdc); } }
    for (int g = gw, it = 0; g < ngroups; g += NGW, ++it) {
        {   LAS float* buf = mdl + (it & 1) * 3072;
            if (mdv < 2) { f32x4 w = nmd0; if (mdv == 1) w = w + 1.0f; *(LAS f32x4*)(buf + mdv * 1024 + mdc) = w; }
            if (tid < 256) *(LAS f32x4*)(buf + 2048 + mdc) = nmd1; }
        __syncthreads();
        const LAS float* g2l = mdl + (it & 1) * 3072; const LAS float* scl = g2l + 1024; const LAS float* shl = g2l + 2048;
        const int row = 4 * g + rg;
        const int myslot = SLOT[(size_t)row * 16 + li];
        f32x4 hv[16];
        typedef float f32x2v __attribute__((ext_vector_type(2))); const f32x2v st1 = *(const f32x2v*)(WSP(float, WS_ST1) + (size_t)row * 2);
#pragma unroll
        for (int j = 0; j < 16; ++j) hv[j] = *(const f32x4*)(X1b + (size_t)row * D + 4 * li + 64 * j);
        if (g + NGW < ngroups) { const int gn = g + NGW; nmd0 = mdload(4 * gn); if (tid < 256) { const int r = mod_row(4 * gn); nmd1 = *(const f32x4*)(modn + (size_t)r * 6144 + mdc); } }
        const unsigned long long bal = __ballot(myslot >= 0);
        unsigned m = (unsigned)(bal >> (16 * rg)) & 0xffffu;
#pragma unroll
        for (int j = 0; j < 16; ++j) { const int c = 4 * li + 64 * j; hv[j] = ((hv[j] - st1.x) * st1.y * *(const LAS f32x4*)(l1g + c) + *(const LAS f32x4*)(l1b + c)) * DN_ALPHA;
            if ((j & 3) == 3) __builtin_amdgcn_sched_barrier(0); }
        const bool isctx = (4 * g) >= TL;
        int ph = 0;
        while (__any(m != 0u)) {
            const bf16* p[2]; float gt[2];
            if (!isctx) {
#pragma unroll
                for (int k = 0; k < 2; ++k) { const bool ok = m != 0u; const int e = ok ? (int)__builtin_ctz(m) : 0; m = ok ? (m & (m - 1u)) : 0u;
                    const int sv = __shfl(myslot, (rg << 4) + e); const int se = ok ? sv : 0; gt[k] = ok ? GATEV[se] : 0.f; p[k] = YE + (size_t)se * D + 4 * li; }
            } else {
                const bool ok = m != 0u; const int e = ok ? (int)__builtin_ctz(m) : 0; if (ph) m = ok ? (m & (m - 1u)) : 0u;
                const int sv = __shfl(myslot, (rg << 4) + e); const int se = ok ? sv : NB * CAPL; const float gv = ok ? GATEV[se] : 0.f;
                const int ex = se / ESLOT, cr = se - ex * ESLOT - NB * CAPL; const bf16* base = YEC + ((size_t)ex * 256 + cr) * D + 4 * li + (size_t)(2 * ph) * (NE * 256) * D;
                p[0] = base; p[1] = base + (size_t)(NE * 256) * D; gt[0] = gv; gt[1] = gv; ph ^= 1;
            }
            const LAS float* g2p = g2l + 4 * li; asm volatile("" : "+v"(g2p));
            u32x2 w[2][16];
#pragma unroll
            for (int k = 0; k < 2; ++k)
#pragma unroll
                for (int j = 0; j < 16; ++j) w[k][j] = *(const u32x2*)(p[k] + 64 * j);
#pragma unroll
            for (int j = 0; j < 16; ++j) { const f32x4 g2v = *(const LAS f32x4*)(g2p + 64 * j);
#pragma unroll
                for (int k = 0; k < 2; ++k) { const f32x4 t = g2v * gt[k];
                    hv[j][0] += t[0] * bflo(w[k][j].x); hv[j][1] += t[1] * bfhi(w[k][j].x); hv[j][2] += t[2] * bflo(w[k][j].y); hv[j][3] += t[3] * bfhi(w[k][j].y); }
                if ((j & 3) == 3) __builtin_amdgcn_sched_barrier(0); }
        }
        float s = 0.f;
#pragma unroll
        for (int j = 0; j < 16; ++j) s += (hv[j][0] + hv[j][1]) + (hv[j][2] + hv[j][3]);
        const float mean = row16_sum(s) * (1.0f / D); float q = 0.f;
#pragma unroll
        for (int j = 0; j < 16; ++j) { hv[j] = hv[j] - mean; q += (hv[j][0] * hv[j][0] + hv[j][1] * hv[j][1]) + (hv[j][2] * hv[j][2] + hv[j][3] * hv[j][3]); }
        const float rstd = 1.0f / sqrtf(row16_sum(q) * (1.0f / D) + LN_EPS);
#pragma unroll
        for (int j = 0; j < 16; ++j) { const int c = 4 * li + 64 * j;
            const f32x4 y = hv[j] * rstd * *(const LAS f32x4*)(lgl + c) + *(const LAS f32x4*)(lbl + c);
            if (l + 1 < DEPTH) { *(f32x4*)(Hb + (size_t)row * D + c) = y; const f32x4 uu = y * *(const LAS f32x4*)(scl + c) + *(const LAS f32x4*)(shl + c);
                u32x2 w; w.x = cvt_pk_bf16(uu[0], uu[1]); w.y = cvt_pk_bf16(uu[2], uu[3]); *(u32x2*)(U1b + (size_t)row * D + c) = w; }
            else *(f32x4*)(C.out + (size_t)row * D + c) = y;
            if ((j & 3) == 3) __builtin_amdgcn_sched_barrier(0);
        }
    }
    __syncthreads();
}

constexpr int PH_PER_LAYER = 11, N_PHASES = 2 + DEPTH * PH_PER_LAYER;
__global__ void __launch_bounds__(512, 2) mega(Args args) {
    extern __shared__ __attribute__((aligned(16))) unsigned char lds_raw[];
#define MKCTX() Ctx C; { GAS unsigned char* w_ = (GAS unsigned char*)args.ws; asm volatile("" : "+s"(w_)); int t_ = threadIdx.x; asm volatile("" : "+v"(t_)); \
        C.lds = (LAS unsigned char*)lds_raw; C.ws = w_; C.in = args.in; C.out = args.out; C.tid = t_; C.lane = t_ & 63; C.wave = __builtin_amdgcn_readfirstlane(t_ >> 6); C.bid = (gridDim.x & 7u) ? blockIdx.x : (blockIdx.x & 7u) * (gridDim.x >> 3) + (blockIdx.x >> 3); C.G = gridDim.x; }
    LAS unsigned char* lds0 = (LAS unsigned char*)lds_raw;
    volatile LAS unsigned* misc = (volatile LAS unsigned*)(lds0 + LDS_MISC);
    if (threadIdx.x < 4) misc[threadIdx.x] = 0u;
    __syncthreads();
    const int lo = args.ph_lo, hi = args.ph_hi;
    const bool multi = (hi - lo) > 1;
    XcdBarrier bar; bar.bar = (unsigned*)(args.ws + WS_CTL) + 4096; bar.x = 0; bar.st = misc;
    if (multi) bar = xcd_barrier_post((unsigned*)(args.ws + WS_CTL) + 4096, misc);
#ifndef PHASE_MASK
#define PHASE_MASK 0xFFFFu
#endif
#define PM(i) (((PHASE_MASK) >> (i)) & 1u)
#define IN(k) (lo <= (k) && (k) < hi)
#define SEAM(k) do { if (IN((k) + 1)) xcd_barrier(bar); } while (0)
    if (PM(0) && IN(0)) { MKCTX(); phase_prep(C); SEAM(0); }
    if (PM(1) && IN(1)) { MKCTX(); phase_init(C); SEAM(1); }
    for (int l = 0; l < DEPTH; ++l) {
        const int p0 = 2 + l * PH_PER_LAYER;
        const int nrows = (l < DEPTH - 1) ? T : TL, mt = (l < DEPTH - 1) ? 9 : 8;
        if (PM(2) && IN(p0 + 0)) { MKCTX(); phase_inproj(C, l); SEAM(p0 + 0); }
        if (PM(3) && IN(p0 + 1)) { MKCTX(); phase_b0(C, l); SEAM(p0 + 1); }
        if (PM(4) && IN(p0 + 2)) { MKCTX(); phase_b1(C, l); SEAM(p0 + 2); }
        if (PM(5) && IN(p0 + 3)) { MKCTX(); phase_c1(C, l, nrows); if (l < DEPTH - 1 && blk_k(C) >= 16) slot_dn(C, l + 1, blk_x(C) * 16 + blk_k(C) - 16, DN_C1_FIRST, DN_C1_CNT); SEAM(p0 + 3); }
        if (PM(6) && IN(p0 + 4)) { MKCTX(); phase_c2(C, l, nrows); if (l < DEPTH - 1 && blk_k(C) >= 16) slot_gu(C, l + 1, blk_x(C) * 16 + blk_k(C) - 16, GU_C2_FIRST, GU_C2_CNT); SEAM(p0 + 4); }
        if (PM(7) && IN(p0 + 5)) { MKCTX(); phase_d(C, l, nrows); if (l < DEPTH - 1 && blk_k(C) >= 16) slot_gu(C, l + 1, blk_x(C) * 16 + blk_k(C) - 16, GU_D_FIRST, GU_D_CNT); SEAM(p0 + 5); }
        if (PM(8) && IN(p0 + 6)) { MKCTX(); phase_e(C, l, nrows); if (l < DEPTH - 1 && blk_k(C) >= 8) slot_dn(C, l + 1, blk_x(C) * 24 + blk_k(C) - 8, DN_E_FIRST, DN_E_CNT); SEAM(p0 + 6); }
        if (PM(9) && IN(p0 + 7)) { MKCTX(); phase_f(C, l); if (l < DEPTH - 1 && blk_k(C) >= 16) slot_gu(C, l + 1, blk_x(C) * 16 + blk_k(C) - 16, GU_F_FIRST, GU_F_CNT); SEAM(p0 + 7); }
        if (PM(10) && IN(p0 + 8)) { MKCTX(); phase_g(C, l, mt); SEAM(p0 + 8); }
        if (PM(11) && IN(p0 + 9)) { MKCTX(); phase_h(C, l, mt); SEAM(p0 + 9); }
        if (PM(12) && IN(p0 + 10)) { MKCTX(); phase_i(C, l, nrows); if (l < DEPTH - 1 && blk_k(C) >= 8) slot_dn(C, l + 1, blk_x(C) * 24 + blk_k(C) - 8, DN_I_FIRST, DN_I_CNT); SEAM(p0 + 10); }
    }
#undef IN
#undef SEAM
}

#ifdef DBG_STOP
__global__ void dbg_dump(const unsigned char* src, int mode, float* out, size_t n) {
    for (size_t i = (size_t)blockIdx.x * blockDim.x + threadIdx.x; i < n; i += (size_t)gridDim.x * blockDim.x) {
        if (mode == 0) out[i] = (float)((const unsigned short*)src)[i];
        else out[i] = (float)(((const unsigned*)src)[i] >> 8);
    }
}
__global__ void dbg_scan(const unsigned char* src, size_t n, int mode, float mark, float* out) {
    const size_t t = (size_t)blockIdx.x * blockDim.x + threadIdx.x, NT = (size_t)gridDim.x * blockDim.x;
    bool bad = false;
    for (size_t i = t; i < n; i += NT) { const float v = mode == 0 ? __uint_as_float(((unsigned)((const unsigned short*)src)[i]) << 16) : ((const float*)src)[i]; if (!(fabsf(v) < 1e6f)) bad = true; }
    out[t] = bad ? mark : 0.0f;
}
__global__ void dbg_check(const float* const* dummy, const float* x, const float* c, const float* cctx, const float* wmod, const float* bmod, const float* win, const unsigned char* ws, float* out) {
    const size_t t = (size_t)blockIdx.x * blockDim.x + threadIdx.x;
    const float* MOD = (const float*)(ws + WS_MOD); const bf16* WIN = (const bf16*)(ws + WS_WIN); const bf16* U1 = (const bf16*)(ws + WS_U1); const bf16* Z = (const bf16*)(ws + WS_Z);
    if ((DBG_SEG & 1) && t < 9 * 6144) { const int r = (int)(t / 6144), n = (int)(t % 6144); double s = 0; for (int k = 0; k < 1024; ++k) { const float v = r < 8 ? c[r * 1024 + k] : cctx[k]; s += (double)(v / (1.0f + expf(-v))) * wmod[(size_t)k * 6144 + n]; }
        s += bmod[n]; const float got = MOD[(size_t)r * 6144 + n]; out[t] = (fabs(got - s) > 1e-3 * fabs(s) + 1e-4) ? 1e6f : 0.f; }
    if (DBG_SEG & 2) { const size_t idx = (t * 6661) % ((size_t)1696 * 1024); const int n = (int)(idx / 1024), k = (int)(idx % 1024); const float ref = win[(size_t)k * IN_COLS + n] * (n < 256 ? NA_QS : 1.0f);
      const float got = __uint_as_float(((unsigned)WIN[(size_t)n * 1024 + k]) << 16); out[262144 + t] = (fabsf(got - ref) > 0.01f * fabsf(ref) + 1e-6f) ? 1e5f : 0.f; }
    if (DBG_SEG & 4) { const size_t idx = (t * 7919) % ((size_t)TL * 1024); const int row = (int)(idx / 1024), k = (int)(idx % 1024), r = row >> 11; const float ref = x[idx] * (1.0f + MOD[(size_t)r * 6144 + 1024 + k]) + MOD[(size_t)r * 6144 + k];
      const float got = __uint_as_float(((unsigned)U1[idx]) << 16); out[2 * 262144 + t] = (fabsf(got - ref) > 0.01f * fabsf(ref) + 1e-3f) ? 1e4f : 0.f; }
    if (DBG_SEG & 8) { const size_t idx = (t * 104729) % ((size_t)T * 1696); const int row = (int)(idx / 1696), col = (int)(idx % 1696); float sref = 0.f;
      for (int k = 0; k < 1024; ++k) sref += __uint_as_float(((unsigned)U1[(size_t)row * 1024 + k]) << 16) * __uint_as_float(((unsigned)WIN[(size_t)col * 1024 + k]) << 16);
      const float got = __uint_as_float(((unsigned)Z[(size_t)row * NZ + col]) << 16); out[3 * 262144 + t] = (fabsf(got - sref) > 0.02f * fabsf(sref) + 0.05f) ? 1e3f : 0.f; }
}
#endif
extern "C" void kernel_launch(void* const* d_in, const int* in_sizes, int n_in, void* d_out, int out_size, void* d_ws, size_t ws_size, hipStream_t stream) {
    static int grid = 0;
    if (grid == 0) {
        if (n_in != 24 || ws_size < WS_END) { fprintf(stderr, "kernel_launch: unexpected inputs (n_in %d, ws %zu, need %zu)\n", n_in, ws_size, (size_t)WS_END); grid = -1; return; }
        int dev = 0, cus = 0, per_cu = 0;
        if (hipGetDevice(&dev) != hipSuccess || hipDeviceGetAttribute(&cus, hipDeviceAttributeMultiprocessorCount, dev) != hipSuccess) { grid = -1; return; }
        if (hipFuncSetAttribute((const void*)mega, hipFuncAttributeMaxDynamicSharedMemorySize, LDS_BYTES) != hipSuccess) { fprintf(stderr, "kernel_launch: hipFuncSetAttribute failed\n"); grid = -1; return; }
        if (hipOccupancyMaxActiveBlocksPerMultiprocessor(&per_cu, (const void*)mega, 512, LDS_BYTES) != hipSuccess || per_cu < 1) fprintf(stderr, "kernel_launch: occupancy query says %d\n", per_cu);
        (void)hipGetLastError();
        grid = cus;
    }
    if (grid < 0) return;
#ifdef POISON_WS
    (void)hipMemsetAsync((char*)d_ws, 0x00, WS_END, stream);
#endif
    (void)hipMemsetAsync((char*)d_ws + WS_CTL, 0, CTL_BYTES, stream);
    Args a{};
    for (int i = 0; i < 24; ++i) a.in[i] = (const float*)d_in[i];
    a.out = (float*)d_out; a.ws = (unsigned char*)d_ws;
#if ONE_LAUNCH
    a.ph_lo = 0; a.ph_hi = N_PHASES;
    hipLaunchKernelGGL(mega, dim3(grid), dim3(512), LDS_BYTES, stream, a);
#else
#ifdef DBG_STOP
    for (int p = 0; p <= DBG_STOP; ++p) { a.ph_lo = p; a.ph_hi = p + 1; hipLaunchKernelGGL(mega, dim3(grid), dim3(512), LDS_BYTES, stream, a); }
    (void)hipMemsetAsync(d_out, 0, (size_t)out_size * 4, stream);
    hipLaunchKernelGGL(dbg_check, dim3(1024), dim3(256), 0, stream, (const float* const*)nullptr, (const float*)d_in[I_X], (const float*)d_in[I_C], (const float*)d_in[I_CCTX], (const float*)d_in[I_WMOD], (const float*)d_in[I_BMOD], (const float*)d_in[I_WIN], (const unsigned char*)d_ws, (float*)d_out);
#else
    for (int p = 0; p < N_PHASES; ++p) { a.ph_lo = p; a.ph_hi = p + 1; hipLaunchKernelGGL(mega, dim3(grid), dim3(512), LDS_BYTES, stream, a); }
#endif
#endif
}
```

```cpp
#include <hip/hip_runtime.h>
#include <cstdio>
#include <cstdint>

#ifndef ONE_LAUNCH
#define ONE_LAUNCH 1
#endif

#define GAS __attribute__((address_space(1)))
#define LAS __attribute__((address_space(3)))
typedef unsigned short bf16;
typedef short bf16x8 __attribute__((ext_vector_type(8)));
typedef short s16x4 __attribute__((ext_vector_type(4)));
typedef float f32x4 __attribute__((ext_vector_type(4)));
typedef float f32x16 __attribute__((ext_vector_type(16)));
typedef unsigned u32x4 __attribute__((ext_vector_type(4)));
typedef unsigned u32x2 __attribute__((ext_vector_type(2)));

constexpr int D = 1024, NB = 8, SEQ = 2048, CTX = 256, DEPTH = 4, GW = 64;
constexpr int TL = NB * SEQ, TC = NB * CTX, T = TL + TC;
constexpr int IN_COLS = 5792, NZ = 1792;
constexpr int ZQ = 0, ZK = 256, ZV = 512, ZP = 768, ZF = 1024, ZCQ = 1280, ZCKV = 1536, ZKR = 1664, ZEND = 1696;
constexpr int NE = 16, FF = 2048, CAPL = 256, CAPC = 32, ESLOT = NB * CAPL + NB * CAPC;
constexpr float LN_EPS = 1e-5f;
constexpr float DN_ALPHA = 1.681792830507429f;
constexpr float LOG2E = 1.4426950408889634f;
constexpr float NA_QS = 0.125f * LOG2E;
constexpr float MLA_QS = 0.10206207261596575f * LOG2E;

constexpr size_t al256(size_t x) { return (x + 255) & ~(size_t)255; }
constexpr size_t WS_CTL = 0, CTL_BYTES = 1u << 20;
constexpr size_t WS_MOD = WS_CTL + CTL_BYTES;
constexpr size_t WS_ROPE = al256(WS_MOD + (size_t)DEPTH * 9 * 6144 * 4);
constexpr size_t WS_T64 = al256(WS_ROPE + 2048 * 32 * 4);
constexpr size_t WS_AFFT = al256(WS_T64 + 128 * 128 * 2);
constexpr size_t WS_AFFTC = al256(WS_AFFT + (size_t)2048 * 2048 * 2);
constexpr size_t WS_WIN = al256(WS_AFFTC + 256 * 256 * 2);
constexpr size_t WS_WG = al256(WS_WIN + (size_t)DEPTH * NZ * D * 2);
constexpr size_t WS_WUQ = al256(WS_WG + (size_t)DEPTH * 4096 * D * 2);
constexpr size_t WS_WUKV = al256(WS_WUQ + (size_t)DEPTH * 384 * 256 * 2);
constexpr size_t WS_WB = al256(WS_WUKV + (size_t)DEPTH * 512 * 128 * 2);
constexpr size_t WS_WO = al256(WS_WB + (size_t)DEPTH * 4 * D * 256 * 2);
constexpr size_t WS_WGU = al256(WS_WO + (size_t)DEPTH * D * D * 2);
constexpr size_t WS_WD = al256(WS_WGU + (size_t)DEPTH * NE * 4096 * D * 2);
constexpr size_t WS_H = al256(WS_WD + (size_t)DEPTH * NE * D * FF * 2);
constexpr size_t WS_X1 = al256(WS_H + (size_t)T * D * 4);
constexpr size_t WS_U1 = al256(WS_X1 + (size_t)T * D * 4);
constexpr size_t WS_U2 = al256(WS_U1 + (size_t)T * D * 2);
constexpr size_t WS_Z = al256(WS_U2 + (size_t)T * D * 2);
constexpr size_t WS_QM = al256(WS_Z + (size_t)T * NZ * 2);
constexpr size_t WS_KM = al256(WS_QM + (size_t)T * 384 * 2);
constexpr size_t WS_VM = al256(WS_KM + (size_t)T * 384 * 2);
constexpr size_t WS_FB = al256(WS_VM + (size_t)T * 256 * 2);
constexpr size_t WS_FBC = al256(WS_FB + (size_t)2048 * 2048 * 2);
constexpr size_t WS_Y = al256(WS_FBC + (size_t)2048 * 256 * 2);
constexpr size_t WS_P = al256(WS_Y + (size_t)4 * T * 256 * 2);
constexpr size_t WS_AFF = al256(WS_P + (size_t)T * 4096 * 2);
constexpr size_t WS_SLOT = al256(WS_AFF + (size_t)T * 16 * 4);
constexpr size_t WS_GATEV = al256(WS_SLOT + (size_t)T * 16 * 4);
constexpr size_t WS_SROW = al256(WS_GATEV + (size_t)NE * ESLOT * 4);
constexpr size_t WS_XE = al256(WS_SROW + (size_t)NE * ESLOT * 4);
constexpr size_t WS_ACT = al256(WS_XE + (size_t)NE * ESLOT * D * 2);
constexpr size_t WS_YE = al256(WS_ACT + (size_t)NE * ESLOT * FF * 2);
constexpr size_t WS_S = al256(WS_YE + (size_t)NE * ESLOT * D * 2);
constexpr size_t WS_ST1 = al256(WS_S + (size_t)T * D * 2);
constexpr size_t WS_END = al256(WS_ST1 + (size_t)T * 2 * 4);
static_assert(WS_END <= (size_t)2047 * 1024 * 1024, "workspace map exceeds 2 GiB");

constexpr int LDS_BYTES = 147456;
constexpr int LDS_MISC = 140 * 1024;

typedef __bf16 bf16x2_t __attribute__((ext_vector_type(2)));
typedef float f32x2_t __attribute__((ext_vector_type(2)));
__device__ __forceinline__ unsigned cvt_pk_bf16(float lo, float hi) { f32x2_t v = {lo, hi}; bf16x2_t b = __builtin_convertvector(v, bf16x2_t); return __builtin_bit_cast(unsigned, b); }
__device__ __forceinline__ float bf2f(unsigned short b) { return __uint_as_float(((unsigned)b) << 16); }
__device__ __forceinline__ float bflo(unsigned w) { return __uint_as_float(w << 16); }
__device__ __forceinline__ float bfhi(unsigned w) { return __uint_as_float(w & 0xffff0000u); }
__device__ __forceinline__ float wave_sum(float v) {
    v += __builtin_bit_cast(float, __builtin_amdgcn_update_dpp(0, __builtin_bit_cast(int, v), 0xB1, 0xf, 0xf, true));
    v += __builtin_bit_cast(float, __builtin_amdgcn_update_dpp(0, __builtin_bit_cast(int, v), 0x4E, 0xf, 0xf, true));
    v += __builtin_bit_cast(float, __builtin_amdgcn_update_dpp(0, __builtin_bit_cast(int, v), 0x141, 0xf, 0xf, true));
    v += __builtin_bit_cast(float, __builtin_amdgcn_update_dpp(0, __builtin_bit_cast(int, v), 0x140, 0xf, 0xf, true));
    const int iv = __builtin_bit_cast(int, v);
    const float a = __builtin_bit_cast(float, __builtin_amdgcn_readlane(iv, 0)), b = __builtin_bit_cast(float, __builtin_amdgcn_readlane(iv, 16));
    const float c = __builtin_bit_cast(float, __builtin_amdgcn_readlane(iv, 32)), d = __builtin_bit_cast(float, __builtin_amdgcn_readlane(iv, 48));
    return (a + b) + (c + d);
}
__device__ __forceinline__ float row16_sum(float v) {
    v += __builtin_bit_cast(float, __builtin_amdgcn_update_dpp(0, __builtin_bit_cast(int, v), 0xB1, 0xf, 0xf, true));
    v += __builtin_bit_cast(float, __builtin_amdgcn_update_dpp(0, __builtin_bit_cast(int, v), 0x4E, 0xf, 0xf, true));
    v += __builtin_bit_cast(float, __builtin_amdgcn_update_dpp(0, __builtin_bit_cast(int, v), 0x141, 0xf, 0xf, true));
    v += __builtin_bit_cast(float, __builtin_amdgcn_update_dpp(0, __builtin_bit_cast(int, v), 0x140, 0xf, 0xf, true));
    return v;
}
__device__ __forceinline__ unsigned wave_sum_u(unsigned v) {
    v += (unsigned)__builtin_amdgcn_update_dpp(0, (int)v, 0xB1, 0xf, 0xf, true);
    v += (unsigned)__builtin_amdgcn_update_dpp(0, (int)v, 0x4E, 0xf, 0xf, true);
    v += (unsigned)__builtin_amdgcn_update_dpp(0, (int)v, 0x141, 0xf, 0xf, true);
    v += (unsigned)__builtin_amdgcn_update_dpp(0, (int)v, 0x140, 0xf, 0xf, true);
    return (unsigned)__builtin_amdgcn_readlane((int)v, 0) + (unsigned)__builtin_amdgcn_readlane((int)v, 16) + (unsigned)__builtin_amdgcn_readlane((int)v, 32) + (unsigned)__builtin_amdgcn_readlane((int)v, 48);
}
__device__ __forceinline__ void st_wt8(void* p, u32x2 v) { __hip_atomic_store((unsigned long long*)p, ((unsigned long long)v.y << 32) | v.x, __ATOMIC_RELAXED, __HIP_MEMORY_SCOPE_AGENT); }
__device__ __forceinline__ void st_wt16(void* p, u32x4 v) { __hip_atomic_store((unsigned long long*)p, ((unsigned long long)v.y << 32) | v.x, __ATOMIC_RELAXED, __HIP_MEMORY_SCOPE_AGENT); __hip_atomic_store((unsigned long long*)p + 1, ((unsigned long long)v.w << 32) | v.z, __ATOMIC_RELAXED, __HIP_MEMORY_SCOPE_AGENT); }
__device__ __forceinline__ float fast_exp2(float x) { return __builtin_amdgcn_exp2f(x); }
__device__ __forceinline__ float silu_f(float x) { return x / (1.0f + __expf(-x)); }

#define XB_TMO      128
#define XB_XCNT(j)  (256  + 64 * (j))
#define XB_XSUB(j)  (1280 + 64 * (j))
#define XB_XGEN(j)  (2304 + 64 * (j))
#define XB_TOP      3328
#define XB_TOPGEN   3392
#define XCD_BAR_WORDS 3456
#define XB_SPIN_CAP (1u << 18)
__device__ __forceinline__ unsigned xb_ld(unsigned* p)              { return __hip_atomic_load(p, __ATOMIC_RELAXED, __HIP_MEMORY_SCOPE_AGENT); }
__device__ __forceinline__ unsigned xb_add(unsigned* p, unsigned v) { return __hip_atomic_fetch_add(p, v, __ATOMIC_RELAXED, __HIP_MEMORY_SCOPE_AGENT); }
__device__ __forceinline__ unsigned xb_xcc_id() { return (unsigned)__builtin_amdgcn_s_getreg((3 << 11) | 20) & 0xFu; }
#define XB_SPIN(cond, bar) do { unsigned _sp = 0; while (cond) { __builtin_amdgcn_s_sleep(1); \
    if ((++_sp & 255u) == 0u) { if (xb_ld(&(bar)[XB_TMO])) break; if (_sp > XB_SPIN_CAP) { atomicAdd(&(bar)[XB_TMO], 1u); break; } } } } while (0)
struct XcdBarrier { unsigned* bar; unsigned x; volatile LAS unsigned* st; };
__device__ __forceinline__ XcdBarrier xcd_barrier_post(unsigned* bar, volatile LAS unsigned* st) {
    XcdBarrier b; b.bar = bar; b.x = xb_xcc_id(); b.st = st;
    if (threadIdx.x == 0) (void)xb_add(&bar[XB_XCNT(b.x)], 1u);
    return b;
}
__device__ __forceinline__ void xcd_barrier_complete(unsigned* bar, unsigned x, unsigned& nloc, unsigned& nx) {
    const unsigned G = gridDim.x * gridDim.y * gridDim.z;
    unsigned sum, cnt, mine, sp = 0u;
    for (;;) {
        sum = 0u; cnt = 0u; mine = 0u;
#pragma unroll
        for (unsigned j = 0; j < 16; ++j) { const unsigned c = xb_ld(&bar[XB_XCNT(j)]); sum += c; cnt += (c > 0u) ? 1u : 0u; mine = (j == x) ? c : mine; }
        if (sum == G) break;
        __builtin_amdgcn_s_sleep(1);
        if ((++sp & 255u) == 0u) { if (xb_ld(&bar[XB_TMO])) break; if (sp > XB_SPIN_CAP) { atomicAdd(&bar[XB_TMO], 1u); break; } }
    }
    nloc = mine > 0u ? mine : 1u; nx = cnt > 0u ? cnt : 1u;
}
__device__ __forceinline__ void xcd_barrier(const XcdBarrier& b) {
    asm volatile("s_waitcnt vmcnt(0)" ::: "memory");
    __syncthreads();
    if (threadIdx.x == 0) {
        unsigned* bar = b.bar;
        __builtin_amdgcn_s_waitcnt(0);
        unsigned nloc = b.st[0], nx = b.st[1];
        if (nloc == 0u) { xcd_barrier_complete(bar, b.x, nloc, nx); b.st[0] = nloc; b.st[1] = nx; }
        const unsigned old = xb_add(&bar[XB_XSUB(b.x)], 1u);
        const unsigned gen = old / nloc;
        if (old + 1u == (gen + 1u) * nloc) {
            __builtin_amdgcn_fence(__ATOMIC_RELEASE, "agent");
            asm volatile("s_waitcnt vmcnt(0)" ::: "memory");
            const unsigned og = xb_add(&bar[XB_TOP], 1u);
            const unsigned tg = og / nx;
            if (og + 1u == (tg + 1u) * nx) xb_add(&bar[XB_TOPGEN], 1u);
            else XB_SPIN(xb_ld(&bar[XB_TOPGEN]) == tg, bar);
            __builtin_amdgcn_fence(__ATOMIC_ACQUIRE, "agent");
            xb_add(&bar[XB_XGEN(b.x)], 1u);
            asm volatile("s_waitcnt vmcnt(0)" ::: "memory");
        } else {
            XB_SPIN(xb_ld(&bar[XB_XGEN(b.x)]) == gen, bar);
            __builtin_amdgcn_fence(__ATOMIC_ACQUIRE, "agent");
            asm volatile("s_waitcnt vmcnt(0)" ::: "memory");
        }
    }
    __syncthreads();
}

struct Args {
    const float* in[24];
    float* out;
    unsigned char* ws;
    int ph_lo, ph_hi;
};
enum { I_X = 0, I_C, I_CTX, I_CCTX, I_WMOD, I_BMOD, I_WIN, I_RPB, I_POOLW, I_POOLS, I_QNORM, I_WUQ, I_KVNORM, I_WUKV, I_WBR, I_WOUT,
       I_LN1G, I_LN1B, I_WROUTER, I_WGATE, I_WUP, I_WDOWN, I_LN2G, I_LN2B };

struct Ctx {
    LAS unsigned char* lds;
    GAS unsigned char* ws;
    const float* const* in;
    float* out;
    int tid, lane, wave, bid, G;
};
#define WSP(T_, off) ((T_*)(GAS T_*)(C.ws + (off)))

__device__ __forceinline__ int mod_row(int row) { return row < TL ? (row >> 11) : 8; }

constexpr int SG_TILE_B = 128 * 128;
constexpr int SG_LDS = 4 * SG_TILE_B;
template <class AF, class BF, class BS, class EPI>
__device__ __forceinline__ void sgemm_tile_s(const Ctx& C, AF arow, BF brow, BS bstep, int K, EPI epi) {
    const int tid = C.tid, lane = C.lane, wid = C.wave, wr = wid >> 2, wc = wid & 3, fr = lane & 15, fq = lane >> 4;
    LAS unsigned char* lds = C.lds;
    const bf16* ap[2]; const bf16* bp[2]; int lo[2]; long bst[2];
#pragma unroll
    for (int i = 0; i < 2; ++i) { const int c = tid + 512 * i, r = c >> 3, kc = c & 7; ap[i] = arow(r) + kc * 8; bp[i] = brow(r) + kc * 8; bst[i] = bstep(r); lo[i] = r * 128 + ((kc ^ ((r >> 1) & 7)) << 4); }
    f32x4 acc[4][2];
#pragma unroll
    for (int m = 0; m < 4; ++m)
#pragma unroll
        for (int n = 0; n < 2; ++n) acc[m][n] = (f32x4){0.f, 0.f, 0.f, 0.f};
    u32x4 ra0[2], rb0[2], ra1[2], rb1[2];
    const int nt = K >> 6;
    const int sw = (fr >> 1) & 7;
    const int ra_off = (wr * 64 + fr) * 128, rb_off = (wc * 32 + fr) * 128;
#define SG_GLOAD(RA, RB, t) do { const int ka_ = (t) * 64; _Pragma("unroll") for (int i = 0; i < 2; ++i) { RA[i] = *(const u32x4*)(ap[i] + ka_); RB[i] = *(const u32x4*)(bp[i] + (long)(t) * bst[i]); } } while (0)
#define SG_LSTORE(RA, RB, buf) do { _Pragma("unroll") for (int i = 0; i < 2; ++i) { *(LAS u32x4*)(lds + (buf) * SG_TILE_B + lo[i]) = RA[i]; *(LAS u32x4*)(lds + (2 + (buf)) * SG_TILE_B + lo[i]) = RB[i]; } } while (0)
#define SG_COMPUTE(buf) do { const LAS unsigned char* la = lds + (buf) * SG_TILE_B + ra_off; const LAS unsigned char* lb = lds + (2 + (buf)) * SG_TILE_B + rb_off; \
        _Pragma("unroll") for (int kk = 0; kk < 2; ++kk) { bf16x8 af[4], bfr[2]; const int co = (((4 * kk + fq) ^ sw) << 4); \
            _Pragma("unroll") for (int m = 0; m < 4; ++m) af[m] = *(const LAS bf16x8*)(la + m * 2048 + co); \
            _Pragma("unroll") for (int n = 0; n < 2; ++n) bfr[n] = *(const LAS bf16x8*)(lb + n * 2048 + co); \
            _Pragma("unroll") for (int m = 0; m < 4; ++m) _Pragma("unroll") for (int n = 0; n < 2; ++n) acc[m][n] = __builtin_amdgcn_mfma_f32_16x16x32_bf16(bfr[n], af[m], acc[m][n], 0, 0, 0); } } while (0)
    SG_GLOAD(ra0, rb0, 0);
    if (nt > 1) SG_GLOAD(ra1, rb1, 1);
    SG_LSTORE(ra0, rb0, 0);
    __syncthreads();
    for (int t = 0; t < nt; t += 2) {
        if (t + 2 < nt) SG_GLOAD(ra0, rb0, t + 2);
        SG_COMPUTE(0);
        if (t + 1 < nt) SG_LSTORE(ra1, rb1, 1);
        __syncthreads();
        if (t + 1 >= nt) break;
        if (t + 3 < nt) SG_GLOAD(ra1, rb1, t + 3);
        SG_COMPUTE(1);
        if (t + 2 < nt) SG_LSTORE(ra0, rb0, 0);
        __syncthreads();
    }
#undef SG_GLOAD
#undef SG_LSTORE
#undef SG_COMPUTE
    epi(acc, wr, wc, fr, fq);
    __syncthreads();
}
template <class AF, class BF, class EPI>
__device__ __forceinline__ void sgemm_tile(const Ctx& C, AF arow, BF brow, int K, int, EPI epi) { sgemm_tile_s(C, arow, brow, [](int) { return 64L; }, K, epi); }

namespace g8 {
constexpr int BM = 256, BK = 64, HALF = 128, HTB = HALF * BK * 2, STAGE_BYTES = 8 * HTB;
__device__ __forceinline__ int lds_byte(int r, int c) { const int st = (r >> 4) * 2 + (c >> 5), rr = r & 15, cc = c & 31, ob = rr * 64 + cc * 2; return st * 1024 + (ob ^ (((ob >> 9) & 1) << 5)); }
__device__ __forceinline__ void stage_rc(int b, int& R, int& C) { const int st = b / 1024, sb = b % 1024, swz = sb ^ (((sb >> 9) & 1) << 5); R = (st >> 1) * 16 + swz / 64; C = (st & 1) * 32 + (swz % 64) / 2; }
__device__ __forceinline__ int perm32(int rho) { const int n = rho >> 4, i = rho & 15; return 8 * (i >> 2) + 4 * n + (i & 3); }
struct Unit { const char* A; const char* B; int r0, c0, x; };
template <class Epi, class Sched, bool GATHER = false>
__device__ __forceinline__ void gemm_phase(LAS unsigned char* lds, const int K, const unsigned lda, const unsigned ldb, const Sched& S, const Epi& E, const int tid, const LAS int* srow = nullptr) {
    const int wid = __builtin_amdgcn_readfirstlane(tid >> 6), lane = tid & 63, wr = wid >> 2, wc = wid & 3, fr = lane & 15, fq = lane >> 4;
    const int nt = K / BK;
    unsigned voffA[2], voffB[2], vA1[2], nA0[2], nA1[2]; int gR[2]; unsigned gC[2];
#pragma unroll
    for (int i = 0; i < 2; ++i) { int R, Cc; stage_rc(tid * 16 + i * 8192, R, Cc); const int Rb = Epi::PERM ? ((R & ~31) + perm32(R & 31)) : R;
        voffA[i] = (unsigned)R * lda + (unsigned)Cc * 2u; voffB[i] = (unsigned)Rb * ldb + (unsigned)Cc * 2u; gR[i] = R; gC[i] = (unsigned)Cc * 2u; vA1[i] = voffA[i]; nA0[i] = voffA[i]; nA1[i] = voffA[i]; }
    if constexpr (GATHER) {
#pragma unroll
        for (int i = 0; i < 2; ++i) { voffA[i] = (unsigned)srow[gR[i]] * lda + gC[i]; vA1[i] = (unsigned)srow[128 + gR[i]] * lda + gC[i]; }
    }
    const size_t kstep = (size_t)(BK * 2);
    const size_t hstepA = GATHER ? (size_t)0 : (size_t)HALF * lda, hstepB = (size_t)HALF * ldb;
    const unsigned ldsw = (unsigned)wid * 1024u;
    const int aoff = lds_byte(wr * 64 + fr, fq * 8), boff = lds_byte(wc * 32 + fr, fq * 8);
#define PG8_SA(b, h) (((b) * 2 + (h)) * HTB)
#define PG8_SB(b, h) ((4 + (b) * 2 + (h)) * HTB)
#define PG8_STAGE(bufoff, gbase, voff) do { _Pragma("unroll") for (int _i = 0; _i < 2; ++_i) \
        __builtin_amdgcn_global_load_lds((const unsigned*)((const char*)(gbase) + (voff)[_i]), (LAS unsigned*)(lds + (bufoff) + ldsw + _i * 8192), 16, 0, 0); } while (0)
#define PG8_LDA(dst, b, h) do { _Pragma("unroll") for (int m = 0; m < 4; ++m) _Pragma("unroll") for (int k = 0; k < 2; ++k) dst[m][k] = *(const LAS bf16x8*)(lds + PG8_SA(b, h) + aoff + m * 2048 + k * 1024); } while (0)
#define PG8_LDB(dst, b, h) do { _Pragma("unroll") for (int n = 0; n < 2; ++n) _Pragma("unroll") for (int k = 0; k < 2; ++k) dst[n][k] = *(const LAS bf16x8*)(lds + PG8_SB(b, h) + boff + n * 2048 + k * 1024); } while (0)
#define PG8_MMA(ai, bj, At, Bt) do { __builtin_amdgcn_s_setprio(1); _Pragma("unroll") for (int m = 0; m < 4; ++m) _Pragma("unroll") for (int n = 0; n < 2; ++n) _Pragma("unroll") for (int k = 0; k < 2; ++k) \
        acc[ai][bj][m][n] = __builtin_amdgcn_mfma_f32_16x16x32_bf16(Bt[n][k], At[m][k], acc[ai][bj][m][n], 0, 0, 0); __builtin_amdgcn_s_setprio(0); } while (0)
#define PG8_WAIT_V(n) asm volatile("s_waitcnt vmcnt(" #n ")" ::: "memory")
#define PG8_WAIT_L(n) asm volatile("s_waitcnt lgkmcnt(" #n ")" ::: "memory")
#define PG8_BAR __builtin_amdgcn_s_barrier()
#define PG8_SCHED __builtin_amdgcn_sched_barrier(0)
    Unit cur, nxt; int ui = 0;
    if (!S.next(0, cur)) return;
    f32x4 acc[2][2][4][2];
#pragma unroll
    for (int a = 0; a < 2; ++a)
#pragma unroll
        for (int b = 0; b < 2; ++b)
#pragma unroll
            for (int m = 0; m < 4; ++m)
#pragma unroll
                for (int n = 0; n < 2; ++n) acc[a][b][m][n] = (f32x4){0.f, 0.f, 0.f, 0.f};
    bf16x8 At[4][2], B0[2][2], B1[2][2];
    const char* cA = cur.A; const char* cB = cur.B;
    PG8_STAGE(PG8_SB(0, 0), cB, voffB); PG8_STAGE(PG8_SB(0, 1), cB + hstepB, voffB); PG8_STAGE(PG8_SA(0, 0), cA, voffA); PG8_STAGE(PG8_SA(0, 1), cA + hstepA, vA1);
    if (wr == 1) PG8_BAR;
    PG8_WAIT_V(2); PG8_BAR;
    PG8_STAGE(PG8_SB(1, 0), cB + kstep, voffB); PG8_STAGE(PG8_SA(1, 0), cA + kstep, voffA); PG8_STAGE(PG8_SB(1, 1), cB + hstepB + kstep, voffB);
    PG8_WAIT_V(6); PG8_BAR;
    for (;;) {
        const bool has_next = S.next(ui + 1, nxt);
        const char* nA = has_next ? nxt.A : cA; const char* nB = has_next ? nxt.B : cB;
        if constexpr (GATHER) {
#pragma unroll
            for (int i = 0; i < 2; ++i) { nA0[i] = has_next ? (unsigned)srow[256 * (ui + 1) + gR[i]] * lda + gC[i] : voffA[i]; nA1[i] = has_next ? (unsigned)srow[256 * (ui + 1) + 128 + gR[i]] * lda + gC[i] : vA1[i]; }
        }
#pragma clang loop unroll(disable)
        for (int t = 0; t < nt; t += 2) {
            const bool last = (t == nt - 2);
            const char* a1 = cA + (size_t)(t + 1) * kstep;
            const char* a2 = last ? nA : cA + (size_t)(t + 2) * kstep; const char* b2 = last ? nB : cB + (size_t)(t + 2) * kstep;
            const char* a3 = a2 + kstep; const char* b3 = b2 + kstep;
            unsigned sA0[2], sA1[2];
#pragma unroll
            for (int i = 0; i < 2; ++i) { sA0[i] = (GATHER && last) ? nA0[i] : voffA[i]; sA1[i] = (GATHER && last) ? nA1[i] : vA1[i]; }
            PG8_LDB(B0, 0, 0); PG8_LDB(B1, 0, 1); PG8_SCHED; PG8_LDA(At, 0, 0); PG8_STAGE(PG8_SA(1, 1), a1 + hstepA, vA1);
            PG8_WAIT_V(8); PG8_WAIT_L(0); PG8_BAR; PG8_MMA(0, 0, At, B0); PG8_MMA(0, 1, At, B1); PG8_BAR; PG8_SCHED;
            PG8_LDA(At, 0, 1); PG8_STAGE(PG8_SB(0, 0), b2, voffB); PG8_STAGE(PG8_SB(0, 1), b2 + hstepB, voffB); PG8_STAGE(PG8_SA(0, 0), a2, sA0);
            PG8_WAIT_V(8); PG8_WAIT_L(0); PG8_BAR; PG8_MMA(1, 0, At, B0); PG8_MMA(1, 1, At, B1); PG8_BAR; PG8_SCHED;
            PG8_LDB(B0, 1, 0); PG8_LDB(B1, 1, 1); PG8_SCHED; PG8_LDA(At, 1, 0); PG8_STAGE(PG8_SA(0, 1), a2 + hstepA, sA1);
            PG8_WAIT_V(8); PG8_WAIT_L(0); PG8_BAR; PG8_MMA(0, 0, At, B0); PG8_MMA(0, 1, At, B1); PG8_BAR; PG8_SCHED;
            PG8_LDA(At, 1, 1); PG8_STAGE(PG8_SB(1, 0), b3, voffB); PG8_STAGE(PG8_SB(1, 1), b3 + hstepB, voffB); PG8_STAGE(PG8_SA(1, 0), a3, sA0);
            PG8_WAIT_V(8); PG8_WAIT_L(0); PG8_BAR; PG8_MMA(1, 0, At, B0); PG8_MMA(1, 1, At, B1); PG8_BAR; PG8_SCHED;
        }
        if (wr == 0) PG8_BAR;
        E(acc, cur, wr, wc, fr, fq);
        if (!has_next) break;
#pragma unroll
        for (int a = 0; a < 2; ++a)
#pragma unroll
            for (int b = 0; b < 2; ++b)
#pragma unroll
                for (int m = 0; m < 4; ++m)
#pragma unroll
                    for (int n = 0; n < 2; ++n) acc[a][b][m][n] = (f32x4){0.f, 0.f, 0.f, 0.f};
        cur = nxt; cA = nA; cB = nB; ++ui;
        if constexpr (GATHER) {
#pragma unroll
            for (int i = 0; i < 2; ++i) { voffA[i] = nA0[i]; vA1[i] = nA1[i]; }
        }
        if (wr == 1) PG8_BAR;
    }
    PG8_WAIT_V(0);
    PG8_BAR;
#undef PG8_SA
#undef PG8_SB
#undef PG8_STAGE
#undef PG8_LDA
#undef PG8_LDB
#undef PG8_MMA
#undef PG8_WAIT_V
#undef PG8_WAIT_L
#undef PG8_BAR
#undef PG8_SCHED
}
}

constexpr int AT_VS = 192;
template <int DK, bool WIN>
__device__ __forceinline__ void attn_unit(const Ctx& C,
        const bf16* qrow0, size_t ldq,
        const bf16* k0, const bf16* v0, int n0t,
        const bf16* k1, const bf16* v1, int n1t,
        size_t ldk, size_t ldv,
        bf16* orow0, size_t ldo,
        int w_lo, int w_hi, int dr0, int qc0, const LAS float* btab) {
    constexpr int KS = DK * 2 + 16;
    constexpr int KBUF = 64 * KS, VBUF = 64 * AT_VS;
    constexpr int KCH = DK / 8;
    constexpr int NS = DK / 16;
    const int tid = C.tid, lane = C.lane, l31 = lane & 31, h = lane >> 5;
    LAS unsigned char* lds = C.lds;
    LAS unsigned char* ldsK = lds; LAS unsigned char* ldsV = lds + 2 * KBUF;
    bf16x8 qf[NS];
#pragma unroll
    for (int s = 0; s < NS; ++s) qf[s] = *(const bf16x8*)(qrow0 + (size_t)l31 * ldq + 16 * s + 8 * h);
    f32x16 O0, O1;
#pragma unroll
    for (int i = 0; i < 16; ++i) { O0[i] = 0.f; O1[i] = 0.f; }
    float mrun = 0.f, lsum = 0.f;
    const int kc0 = tid, kr0 = kc0 / KCH, kk0 = kc0 % KCH;
    const int kc1 = tid + 512, kr1 = kc1 / KCH, kk1 = kc1 % KCH;
    constexpr bool HAS1 = (64 * KCH > 512);
    const bool has1 = HAS1 && (kc1 < 64 * KCH);
    const int vr = tid >> 3, vk = tid & 7;
    const int nt = n0t + n1t;
    u32x4 rk0, rk1, rv;
    auto gload = [&](int j, u32x4& a0, u32x4& a1, u32x4& av) {
        const bf16* kb = (j < n0t) ? k0 + (size_t)j * 64 * ldk : k1 + (size_t)(j - n0t) * 64 * ldk;
        const bf16* vb = (j < n0t) ? v0 + (size_t)j * 64 * ldv : v1 + (size_t)(j - n0t) * 64 * ldv;
        a0 = *(const u32x4*)(kb + (size_t)kr0 * ldk + kk0 * 8);
        if constexpr (HAS1) { if (has1) a1 = *(const u32x4*)(kb + (size_t)kr1 * ldk + kk1 * 8); }
        av = *(const u32x4*)(vb + (size_t)vr * ldv + vk * 8);
    };
    auto lstore = [&](int b, int vb3, const u32x4& a0, const u32x4& a1, const u32x4& av) {
        *(LAS u32x4*)(ldsK + b * KBUF + kr0 * KS + kk0 * 16) = a0;
        if constexpr (HAS1) { if (has1) *(LAS u32x4*)(ldsK + b * KBUF + kr1 * KS + kk1 * 16) = a1; }
        *(LAS u32x4*)(ldsV + vb3 * VBUF + vr * AT_VS + vk * 16) = av;
    };
    gload(0, rk0, rk1, rv);
    lstore(0, 0, rk0, rk1, rv);
    __syncthreads();
    const int trb = (4 * h + ((lane & 15) >> 2)) * AT_VS + (16 * ((lane >> 4) & 1) + 4 * (lane & 3)) * 2;
    int cq = qc0 + l31; asm volatile("" : "+v"(cq));
    int c0w = cq - 8; c0w = c0w < 0 ? 0 : (c0w > 48 ? 48 : c0w);
    const int mbase = 4 * h - c0w, bbase = 4 * h - cq + 15;
    const bool grpB = C.wave >= 4;
    union VF { bf16x8 v; s16x4 hlf[2]; };
    unsigned pfk[2][2][4];
#pragma unroll
    for (int a_ = 0; a_ < 2; ++a_)
#pragma unroll
        for (int b_ = 0; b_ < 2; ++b_)
#pragma unroll
            for (int c_ = 0; c_ < 4; ++c_) pfk[a_][b_][c_] = 0u;
    bool pend = false; int pend_vb = 0;
    auto vread = [&](int vbuf, VF (&vfr)[2][2][2]) {
        const LAS unsigned char* vb = ldsV + vbuf * VBUF + trb;
#pragma unroll
        for (int kb3 = 0; kb3 < 2; ++kb3)
#pragma unroll
            for (int s2 = 0; s2 < 2; ++s2)
#pragma unroll
                for (int db = 0; db < 2; ++db) { const int rowoff = (32 * kb3 + 16 * s2) * AT_VS;
                    vfr[kb3][s2][db].hlf[0] = __builtin_amdgcn_ds_read_tr16_b64_v4i16((LAS s16x4*)(vb + rowoff + db * 64));
                    vfr[kb3][s2][db].hlf[1] = __builtin_amdgcn_ds_read_tr16_b64_v4i16((LAS s16x4*)(vb + rowoff + 8 * AT_VS + db * 64)); }
    };
    auto pvmma = [&](const VF (&vfr)[2][2][2]) {
#pragma unroll
        for (int kb3 = 0; kb3 < 2; ++kb3)
#pragma unroll
            for (int s2 = 0; s2 < 2; ++s2) {
                union { bf16x8 v; unsigned u[4]; } pf;
#pragma unroll
                for (int q = 0; q < 4; ++q) pf.u[q] = pfk[kb3][s2][q];
                O0 = __builtin_amdgcn_mfma_f32_32x32x16_bf16(vfr[kb3][s2][0].v, pf.v, O0, 0, 0, 0);
                O1 = __builtin_amdgcn_mfma_f32_32x32x16_bf16(vfr[kb3][s2][1].v, pf.v, O1, 0, 0, 0);
            }
    };
    int vcur = 0;
    for (int j = 0; j < nt; ++j) {
        const int cur = j & 1; const int vnxt = (vcur == 2) ? 0 : vcur + 1;
        if (j + 1 < nt) gload(j + 1, rk0, rk1, rv);
        const bool act = !WIN || j < n0t || ((j - n0t) >= w_lo && (j - n0t) < w_hi);
        if (grpB && pend) { VF vfr[2][2][2]; vread(pend_vb, vfr); __builtin_amdgcn_sched_barrier(0); pvmma(vfr); pend = false; }
        if (act) {
            f32x16 S0, S1;
            const float nm = -mrun;
#pragma unroll
            for (int i = 0; i < 16; ++i) { S0[i] = nm; S1[i] = nm; }
            const LAS unsigned char* kb = ldsK + cur * KBUF + l31 * KS + 16 * h;
#pragma unroll
            for (int hs = 0; hs < 2; ++hs) {
                bf16x8 kfa[NS / 2], kfb[NS / 2];
#pragma unroll
                for (int s = 0; s < NS / 2; ++s) { kfa[s] = *(const LAS bf16x8*)(kb + 32 * (hs * (NS / 2) + s)); kfb[s] = *(const LAS bf16x8*)(kb + 32 * KS + 32 * (hs * (NS / 2) + s)); }
                __builtin_amdgcn_sched_barrier(0);
#pragma unroll
                for (int s = 0; s < NS / 2; ++s) {
                    S0 = __builtin_amdgcn_mfma_f32_32x32x16_bf16(kfa[s], qf[hs * (NS / 2) + s], S0, 0, 0, 0);
                    S1 = __builtin_amdgcn_mfma_f32_32x32x16_bf16(kfb[s], qf[hs * (NS / 2) + s], S1, 0, 0, 0);
                }
                __builtin_amdgcn_sched_barrier(0);
            }
            VF vfa[2][2][2];
            if (!grpB) { vread(vcur, vfa); __builtin_amdgcn_sched_barrier(0); }
            if (WIN && j >= n0t) {
                int mb = mbase; asm volatile("" : "+v"(mb));
                const LAS float* bt = btab + ((j - n0t) + dr0) * 31 + bbase;
#pragma unroll
                for (int i = 0; i < 16; ++i) {
                    const int kci = (i & 3) + 8 * (i >> 2);
                    S0[i] = ((unsigned)(kci + mb) < 16u) ? S0[i] + bt[kci] : -1e30f;
                    S1[i] = ((unsigned)(kci + 32 + mb) < 16u) ? S1[i] + bt[kci + 32] : -1e30f;
                }
            }
            float mx = fmaxf(S0[0], S1[0]);
#pragma unroll
            for (int i = 1; i < 16; ++i) mx = fmaxf(mx, fmaxf(S0[i], S1[i]));
            mx = fmaxf(mx, __shfl_xor(mx, 32));
            if (__any(mx > 8.0f)) {
                const float dl = fmaxf(mx, 0.f), alpha = fast_exp2(-dl);
                mrun += dl; lsum *= alpha;
#pragma unroll
                for (int i = 0; i < 16; ++i) { S0[i] -= dl; S1[i] -= dl; O0[i] *= alpha; O1[i] *= alpha; }
            }
            float ps = 0.f;
#pragma unroll
            for (int i = 0; i < 16; ++i) { S0[i] = fast_exp2(S0[i]); S1[i] = fast_exp2(S1[i]); ps += S0[i] + S1[i]; }
            lsum += ps;
#pragma unroll
            for (int s2 = 0; s2 < 2; ++s2)
#pragma unroll
                for (int q = 0; q < 4; ++q) { pfk[0][s2][q] = cvt_pk_bf16(S0[8 * s2 + 2 * q], S0[8 * s2 + 2 * q + 1]); pfk[1][s2][q] = cvt_pk_bf16(S1[8 * s2 + 2 * q], S1[8 * s2 + 2 * q + 1]); }
            if (!grpB) pvmma(vfa); else { pend = true; pend_vb = vcur; }
        }
        if (j + 1 < nt) lstore(cur ^ 1, vnxt, rk0, rk1, rv);
        __syncthreads();
        vcur = vnxt;
    }
    if (grpB && pend) { VF vfr[2][2][2]; vread(pend_vb, vfr); pvmma(vfr); }
    const float ltot = lsum + __shfl_xor(lsum, 32);
    const float inv = 1.0f / ltot;
    bf16* op = orow0 + (size_t)l31 * ldo + 4 * h;
#pragma unroll
    for (int g = 0; g < 4; ++g) {
        u32x2 w0, w1;
        w0.x = cvt_pk_bf16(O0[4 * g] * inv, O0[4 * g + 1] * inv); w0.y = cvt_pk_bf16(O0[4 * g + 2] * inv, O0[4 * g + 3] * inv);
        w1.x = cvt_pk_bf16(O1[4 * g] * inv, O1[4 * g + 1] * inv); w1.y = cvt_pk_bf16(O1[4 * g + 2] * inv, O1[4 * g + 3] * inv);
        *(u32x2*)(op + 8 * g) = w0;
        *(u32x2*)(op + 32 + 8 * g) = w1;
    }
}

template <class RM>
__device__ __forceinline__ void tconv64(const float* W, size_t ldw, int k0, int n0, int N, const float* kscale, RM rm, int lane) {
    const int q = lane >> 4, c = lane & 15, ncol = n0 + 4 * c;
    if (ncol >= N) return;
    const float* src = W + (size_t)(k0 + 16 * q) * ldw + ncol;
    f32x4 v[16];
#pragma unroll
    for (int i = 0; i < 16; ++i) v[i] = __builtin_nontemporal_load((const f32x4*)(src + (size_t)i * ldw));
    if (kscale) {
#pragma unroll
        for (int i = 0; i < 16; ++i) v[i] = v[i] * kscale[k0 + 16 * q + i];
    }
#pragma unroll
    for (int j = 0; j < 4; ++j) {
        float cs; bf16* dst = rm(ncol + j, cs);
        u32x4 o0, o1;
        o0.x = cvt_pk_bf16(v[0][j] * cs, v[1][j] * cs); o0.y = cvt_pk_bf16(v[2][j] * cs, v[3][j] * cs); o0.z = cvt_pk_bf16(v[4][j] * cs, v[5][j] * cs); o0.w = cvt_pk_bf16(v[6][j] * cs, v[7][j] * cs);
        o1.x = cvt_pk_bf16(v[8][j] * cs, v[9][j] * cs); o1.y = cvt_pk_bf16(v[10][j] * cs, v[11][j] * cs); o1.z = cvt_pk_bf16(v[12][j] * cs, v[13][j] * cs); o1.w = cvt_pk_bf16(v[14][j] * cs, v[15][j] * cs);
        *(u32x4*)(dst + k0 + 16 * q) = o0; *(u32x4*)(dst + k0 + 16 * q + 8) = o1;
    }
}
__device__ __forceinline__ void conv_gu_item(const Ctx& C, int L, int idx) {
    const int le = L * NE + (idx >> 9), t = idx & 511, kb = t >> 5, nb = t & 31;
    bf16* wgu = WSP(bf16, WS_WGU) + (size_t)le * 4096 * D;
    { auto rm = [=](int n, float& cs) -> bf16* { cs = 1.0f; return wgu + (size_t)(256 * (n >> 7) + (n & 127)) * D; };
      tconv64(C.in[I_WGATE] + (size_t)le * D * FF, FF, kb * 64, nb * 64, FF, nullptr, rm, C.lane); }
    { auto rm = [=](int n, float& cs) -> bf16* { cs = 1.0f; return wgu + (size_t)(256 * (n >> 7) + 128 + (n & 127)) * D; };
      tconv64(C.in[I_WUP] + (size_t)le * D * FF, FF, kb * 64, nb * 64, FF, nullptr, rm, C.lane); }
}
__device__ __forceinline__ void conv_dn_item(const Ctx& C, int L, int idx) {
    const int le = L * NE + (idx >> 9), t = idx & 511, kb = t >> 4, nb = t & 15;
    bf16* wd = WSP(bf16, WS_WD) + (size_t)le * D * FF;
    auto rm = [=](int n, float& cs) -> bf16* { cs = 1.0f; return wd + (size_t)n * FF; };
    tconv64(C.in[I_WDOWN] + (size_t)le * FF * D, D, kb * 64, nb * 64, D, nullptr, rm, C.lane);
}
constexpr int GU_C2_CNT = 3, GU_C2_FIRST = 0, GU_D_CNT = 1, GU_D_FIRST = 128 * 8 * GU_C2_CNT, GU_F_CNT = 1, GU_F_FIRST = GU_D_FIRST + 128 * 8 * GU_D_CNT, GU_SLOT_END = GU_F_FIRST + 128 * 8 * GU_F_CNT;
constexpr int DN_C1_CNT = 2, DN_C1_FIRST = 0, DN_E_CNT = 2, DN_E_FIRST = 128 * 8 * DN_C1_CNT, DN_I_CNT = 2, DN_I_FIRST = DN_E_FIRST + 192 * 8 * DN_E_CNT, DN_SLOT_END = DN_I_FIRST + 192 * 8 * DN_I_CNT;
static_assert(GU_SLOT_END <= 8192 && DN_SLOT_END <= 8192, "slot ranges");
__device__ __forceinline__ void slot_gu(const Ctx& C, int L, int pb, int first, int cnt) {
    for (int i = 0; i < cnt; ++i) { const int idx = first + (pb * 8 + C.wave) * cnt + i; if (idx < GU_SLOT_END) conv_gu_item(C, L, idx); }
}
__device__ __forceinline__ void slot_dn(const Ctx& C, int L, int pb, int first, int cnt) {
    for (int i = 0; i < cnt; ++i) { const int idx = first + (pb * 8 + C.wave) * cnt + i; if (idx < DN_SLOT_END) conv_dn_item(C, L, idx); }
}
__device__ __forceinline__ void phase_prep(const Ctx& C) {
    const int tid = C.tid, lane = C.lane;
    const size_t gtid = (size_t)C.bid * 512 + tid, gth = (size_t)C.G * 512;
    { bf16* afft = WSP(bf16, WS_AFFT); const float sc = 0.0027621358640099515f;
      for (size_t i = gtid; i < (size_t)2048 * 2048; i += gth) { const int k1 = (int)(i >> 11), j = (int)(i & 2047), n1 = j & 1023; const int m = (k1 * n1) & 2047;
          const float x = (float)m * (1.0f / 1024.0f); float v = (j < 1024) ? cospif(x) : -sinpif(x); if (j == 0) v = 0.5f; if (j == 1024) v = (k1 & 1) ? -1.0f : 1.0f;
          afft[i] = (bf16)(cvt_pk_bf16(v * sc, 0.f) & 0xffff); }
      bf16* afc = WSP(bf16, WS_AFFTC); const float scc = 0.0078125f;
      for (size_t i = gtid; i < (size_t)256 * 256; i += gth) { const int k1 = (int)(i >> 8), j = (int)(i & 255), n1 = j & 127; const int m = (k1 * n1) & 255;
          const float x = (float)m * (1.0f / 128.0f); float v = (j < 128) ? cospif(x) : -sinpif(x); if (j == 0) v = 0.5f; if (j == 128) v = (k1 & 1) ? -1.0f : 1.0f;
          afc[i] = (bf16)(cvt_pk_bf16(v * scc, 0.f) & 0xffff); }
      bf16* t64 = WSP(bf16, WS_T64);
      for (size_t i = gtid; i < 128 * 128; i += gth) { const int mrow = (int)(i >> 7), kk = (int)(i & 127), n2 = kk & 63, k2 = mrow & 63; const int m = (k2 * n2) & 63;
          const float x = (float)m * (1.0f / 32.0f); const float v = (mrow < 64) ? cospif(x) : ((kk < 64) ? sinpif(x) : -sinpif(x)); t64[i] = (bf16)(cvt_pk_bf16(v, 0.f) & 0xffff); }
      float* rope = WSP(float, WS_ROPE);
      for (size_t i = gtid; i < 2048 * 16; i += gth) { const int t = (int)(i >> 4), f = (int)(i & 15); const float pos = (f < 8) ? (float)(t >> 6) : (float)(t & 63);
          const float inv = powf(10000.0f, -(float)(f & 7) / 8.0f); const float ang = pos * inv; rope[2 * i] = cosf(ang); rope[2 * i + 1] = sinf(ang); }
      bf16* win = WSP(bf16, WS_WIN);
      for (size_t i = gtid; i < (size_t)DEPTH * 96 * 1024 / 8; i += gth) { const size_t l = i / (96 * 128), r = i % (96 * 128); *(u32x4*)(win + (l * NZ + ZEND) * D + r * 8) = (u32x4){0u, 0u, 0u, 0u}; }
    }
    {
        LAS float* sl = (LAS float*)(C.lds);
        LAS float* red = (LAS float*)(C.lds + 9 * 1024 * 4);
        for (int i = tid; i < 9 * 1024; i += 512) { const int r = i >> 10, k = i & 1023; const float v = (r < 8) ? C.in[I_C][r * 1024 + k] : C.in[I_CCTX][k]; sl[i] = silu_f(v); }
        __syncthreads();
        const int c32 = tid & 31, kg = tid >> 5;
        for (int it = C.bid; it < DEPTH * 192; it += C.G) {
            const int l = it / 192, n0 = (it % 192) * 32;
            const float* wm = C.in[I_WMOD] + (size_t)l * 1024 * 6144 + n0 + c32;
            float a[9];
#pragma unroll
            for (int r = 0; r < 9; ++r) a[r] = 0.f;
            for (int kk = 0; kk < 64; ++kk) { const int k = kg * 64 + kk; const float w = wm[(size_t)k * 6144];
#pragma unroll
                for (int r = 0; r < 9; ++r) a[r] += sl[r * 1024 + k] * w; }
#pragma unroll
            for (int r = 0; r < 9; ++r) red[(kg * 9 + r) * 32 + c32] = a[r];
            __syncthreads();
            if (tid < 288) { const int r = tid >> 5; float s = 0.f;
#pragma unroll
                for (int g = 0; g < 16; ++g) s += red[(g * 9 + r) * 32 + c32];
                WSP(float, WS_MOD)[((size_t)l * 9 + r) * 6144 + n0 + c32] = s + C.in[I_BMOD][l * 6144 + n0 + c32]; }
            __syncthreads();
        }
    }
    {
        for (size_t i = gtid; i < (size_t)DEPTH * 4 * 1024; i += gth) {
            const int l = (int)(i >> 12), g = (int)((i >> 10) & 3), d = (int)(i & 1023);
            const float* wb = C.in[I_WBR] + (((size_t)l * 4 + 1) * 256 + g * 64) * 1024 + d;
            const float* pw = C.in[I_POOLW] + ((size_t)l * 4 + g) * 64 * 64;
            const float* ps = C.in[I_POOLS] + l * 256 + g * 64;
            float wv[64];
#pragma unroll
            for (int c2 = 0; c2 < 64; ++c2) wv[c2] = wb[(size_t)c2 * 1024] * ps[c2];
            bf16* dst = WSP(bf16, WS_WB) + (((size_t)l * 4 + 1) * 1024 + d) * 256 + g * 64;
#pragma unroll 1
            for (int c8 = 0; c8 < 8; ++c8) {
                float o[8];
#pragma unroll
                for (int cc = 0; cc < 8; ++cc) { float s = 0.f; const float* pr = pw + (c8 * 8 + cc) * 64;
#pragma unroll
                    for (int c2 = 0; c2 < 64; ++c2) s += pr[c2] * wv[c2];
                    o[cc] = s; }
                u32x4 w; w.x = cvt_pk_bf16(o[0], o[1]); w.y = cvt_pk_bf16(o[2], o[3]); w.z = cvt_pk_bf16(o[4], o[5]); w.w = cvt_pk_bf16(o[6], o[7]);
                *(u32x4*)(dst + c8 * 8) = w;
            }
        }
    }
    {
        const int gw = C.bid * 8 + C.wave, NGW = C.G * 8;
        for (int it = gw; it < DEPTH * 16 * 91; it += NGW) {
            const int l = it / (16 * 91), t = it - l * (16 * 91), kb = t / 91, nb = t - kb * 91;
            bf16* win = WSP(bf16, WS_WIN) + (size_t)l * NZ * D; bf16* wg = WSP(bf16, WS_WG) + (size_t)l * 4096 * D;
            auto rm = [=](int n, float& cs) -> bf16* { cs = (n < 256) ? NA_QS : 1.0f; if (n < ZEND) return win + (size_t)n * D;
                const int g = n - ZEND, br = g >> 10, d = g & 1023, pn = d >> 6, ch = d & 63;
                const int row = 256 * pn + 128 * (br >> 1) + 32 * (ch >> 4) + 16 * (br & 1) + (ch & 15);
                return wg + (size_t)row * D; };
            tconv64(C.in[I_WIN] + (size_t)l * D * IN_COLS, IN_COLS, kb * 64, nb * 64, IN_COLS, nullptr, rm, C.lane);
        }
        for (int it = gw; it < DEPTH * 256; it += NGW) {
            const int l = it >> 8, t = it & 255, kb = t >> 4, nb = t & 15;
            bf16* w = WSP(bf16, WS_WO) + (size_t)l * D * D; auto rm = [=](int n, float& cs) -> bf16* { cs = 1.0f; return w + (size_t)n * D; };
            tconv64(C.in[I_WOUT] + (size_t)l * D * D, D, kb * 64, nb * 64, D, nullptr, rm, C.lane);
        }
        for (int it = gw; it < DEPTH * 4 * 64; it += NGW) {
            const int ln = it >> 6, t = it & 63, kb = t >> 4, nb = t & 15;
            if ((ln & 3) == 1) continue;
            bf16* w = WSP(bf16, WS_WB) + (size_t)ln * 1024 * 256; auto rm = [=](int n, float& cs) -> bf16* { cs = 1.0f; return w + (size_t)n * 256; };
            tconv64(C.in[I_WBR] + (size_t)ln * 256 * 1024, 1024, kb * 64, nb * 64, 1024, nullptr, rm, C.lane);
        }
        for (int it = gw; it < DEPTH * 24; it += NGW) {
            const int l = it / 24, t = it - l * 24, kb = t / 6, nb = t - kb * 6;
            bf16* w = WSP(bf16, WS_WUQ) + (size_t)l * 384 * 256; auto rm = [=](int n, float& cs) -> bf16* { cs = 1.0f; return w + (size_t)n * 256; };
            tconv64(C.in[I_WUQ] + (size_t)l * 256 * 384, 384, kb * 64, nb * 64, 384, C.in[I_QNORM] + l * 256, rm, C.lane);
        }
        for (int it = gw; it < DEPTH * 16; it += NGW) {
            const int l = it >> 4, t = it & 15, kb = t >> 3, nb = t & 7;
            bf16* w = WSP(bf16, WS_WUKV) + (size_t)l * 512 * 128; auto rm = [=](int n, float& cs) -> bf16* { cs = 1.0f; return w + (size_t)n * 128; };
            tconv64(C.in[I_WUKV] + (size_t)l * 128 * 512, 512, kb * 64, nb * 64, 512, C.in[I_KVNORM] + l * 128, rm, C.lane);
        }
    }
    {
        const int gw = C.bid * 8 + C.wave, NGW = C.G * 8;
        for (int it = gw; it < 8192; it += NGW) conv_gu_item(C, 0, it);
        for (int it = gw; it < 8192; it += NGW) conv_dn_item(C, 0, it);
        constexpr int GU_REST = 8192 - GU_SLOT_END, DN_REST = 8192 - DN_SLOT_END;
        for (int it = gw; it < 3 * GU_REST; it += NGW) conv_gu_item(C, 1 + it / GU_REST, GU_SLOT_END + it % GU_REST);
        if (DN_REST > 0) for (int it = gw; it < 3 * DN_REST; it += NGW) conv_dn_item(C, 1 + it / (DN_REST > 0 ? DN_REST : 1), DN_SLOT_END + it % (DN_REST > 0 ? DN_REST : 1));
    }
}

__device__ __forceinline__ void phase_init(const Ctx& C) {
    const int gw = C.bid * 8 + C.wave, NGW = C.G * 8, lane = C.lane;
    const float* mod = WSP(float, WS_MOD);
    for (int row = gw; row < T; row += NGW) {
        const float* src = (row < TL) ? C.in[I_X] + (size_t)row * D : C.in[I_CTX] + (size_t)(row - TL) * D;
        const float* mr = mod + (size_t)mod_row(row) * 6144;
        float* hd = WSP(float, WS_H) + (size_t)row * D; bf16* ud = WSP(bf16, WS_U1) + (size_t)row * D;
#pragma unroll
        for (int j = 0; j < 4; ++j) { const int c = 4 * lane + 256 * j; const f32x4 v = *(const f32x4*)(src + c); const f32x4 sh = *(const f32x4*)(mr + c), sc = *(const f32x4*)(mr + 1024 + c);
            *(f32x4*)(hd + c) = v; const f32x4 u = v * (sc + 1.0f) + sh; u32x2 w; w.x = cvt_pk_bf16(u[0], u[1]); w.y = cvt_pk_bf16(u[2], u[3]); *(u32x2*)(ud + c) = w; }
    }
}


__device__ __forceinline__ int unit_index(int i, int G, int c, int nunits) {
    const int full = nunits / G;
    if (i < full) return i * G + c;
    if (i > full) return -1;
    const int R = nunits - full * G; if (R == 0) return -1;
    const int cpx = G >> 3, per = (R + 7) >> 3, x = c / cpx, k = c - x * cpx, r = x * per + k;
    return (k < per && r < R) ? full * G + r : -1;
}
__device__ __forceinline__ int blk_x(const Ctx& C) { return C.bid / (C.G >> 3); }
__device__ __forceinline__ int blk_k(const Ctx& C) { return C.bid % (C.G >> 3); }
struct SchedDense {
    const char* A; const char* B; size_t lda, ldb; int nunits, G, c, nN;
    __device__ __forceinline__ bool next(int i, g8::Unit& u) const { const int L = unit_index(i, G, c, nunits); if (L < 0) return false; const int pm = L / nN, pn = L - pm * nN;
        u.A = A + (size_t)pm * 256 * lda; u.B = B + (size_t)pn * 256 * ldb; u.r0 = pm * 256; u.c0 = pn * 256; u.x = 0; return true; }
};
struct SchedGroup {
    const char* A; const char* B; size_t lda, ldb, bstride; int nunits, G, c, nN, per;
    __device__ __forceinline__ bool next(int i, g8::Unit& u) const { const int L = unit_index(i, G, c, nunits); if (L < 0) return false; const int e = L / per, r = L - e * per, pm = r / nN, pn = r - pm * nN;
        u.A = A + ((size_t)e * ESLOT + pm * 256) * lda; u.B = B + (size_t)e * bstride + (size_t)pn * 256 * ldb; u.r0 = e * ESLOT + pm * 256; u.c0 = pn * 256; u.x = e; return true; }
};
struct SchedC1 {
    const char* Y; const char* W; int nunits, G, c;
    __device__ __forceinline__ bool next(int i, g8::Unit& u) const { const int L = unit_index(i, G, c, nunits); if (L < 0) return false; const int pm = L >> 4, nb = (L >> 2) & 3, pn = L & 3;
        u.A = Y + ((size_t)nb * T + pm * 256) * 512; u.B = W + ((size_t)nb * 1024 + pn * 256) * 512; u.r0 = pm * 256; u.c0 = nb * 1024 + pn * 256; u.x = 0; return true; }
};
struct EpiStoreBf16 {
    static constexpr bool PERM = true; bf16* O; size_t ldc;
    __device__ __forceinline__ void operator()(const f32x4 (&acc)[2][2][4][2], const g8::Unit& u, int wr, int wc, int fr, int fq) const {
        bf16* base = O + (size_t)(u.r0 + wr * 64 + fr) * ldc + u.c0 + wc * 32 + 8 * fq;
#pragma unroll
        for (int ai = 0; ai < 2; ++ai)
#pragma unroll
            for (int m = 0; m < 4; ++m) { bf16* rowp = base + (size_t)(ai * 128 + m * 16) * ldc;
#pragma unroll
                for (int bj = 0; bj < 2; ++bj) { const f32x4 v0 = acc[ai][bj][m][0], v1 = acc[ai][bj][m][1];
                    u32x4 w; w.x = cvt_pk_bf16(v0[0], v0[1]); w.y = cvt_pk_bf16(v0[2], v0[3]); w.z = cvt_pk_bf16(v1[0], v1[1]); w.w = cvt_pk_bf16(v1[2], v1[3]); *(u32x4*)(rowp + bj * 128) = w; } }
    }
};
struct EpiSwiGLU {
    static constexpr bool PERM = true; bf16* O;
    __device__ __forceinline__ void operator()(const f32x4 (&acc)[2][2][4][2], const g8::Unit& u, int wr, int wc, int fr, int fq) const {
        bf16* base = O + (size_t)(u.r0 + wr * 64 + fr) * FF + (u.c0 >> 1) + wc * 32 + 8 * fq;
#pragma unroll
        for (int ai = 0; ai < 2; ++ai)
#pragma unroll
            for (int m = 0; m < 4; ++m) { float h[8];
#pragma unroll
                for (int n = 0; n < 2; ++n)
#pragma unroll
                    for (int j = 0; j < 4; ++j) { const float a = acc[ai][0][m][n][j], b = acc[ai][1][m][n][j]; h[4 * n + j] = a * __builtin_amdgcn_rcpf(1.0f + fast_exp2(-a * LOG2E)) * b; }
                u32x4 w; w.x = cvt_pk_bf16(h[0], h[1]); w.y = cvt_pk_bf16(h[2], h[3]); w.z = cvt_pk_bf16(h[4], h[5]); w.w = cvt_pk_bf16(h[6], h[7]);
                *(u32x4*)(base + (size_t)(ai * 128 + m * 16) * FF) = w; }
    }
};
struct EpiGateMerge {
    static constexpr bool PERM = false; const bf16* P; bf16* S;
    __device__ __forceinline__ void operator()(const f32x4 (&acc)[2][2][4][2], const g8::Unit& u, int wr, int wc, int fr, int fq) const {
        const int chb = (u.c0 >> 2) + wc * 16 + 4 * fq;
        const bf16* pr0 = P + (size_t)(u.r0 + wr * 64 + fr) * 4096 + chb;
        u32x2 pv[2][4][4];
#pragma unroll
        for (int ai = 0; ai < 2; ++ai)
#pragma unroll
            for (int m = 0; m < 4; ++m)
#pragma unroll
                for (int br = 0; br < 4; ++br) pv[ai][m][br] = *(const u32x2*)(pr0 + (size_t)(ai * 128 + m * 16) * 4096 + br * 1024);
#pragma unroll
        for (int ai = 0; ai < 2; ++ai)
#pragma unroll
            for (int m = 0; m < 4; ++m) { const size_t row = (size_t)(u.r0 + ai * 128 + wr * 64 + m * 16 + fr);
                f32x4 sum = (f32x4){0.f, 0.f, 0.f, 0.f};
#pragma unroll
                for (int bj = 0; bj < 2; ++bj)
#pragma unroll
                    for (int n = 0; n < 2; ++n) { const f32x4 a = acc[ai][bj][m][n]; const u32x2 p = pv[ai][m][2 * bj + n];
                        sum[0] += __builtin_amdgcn_rcpf(1.0f + fast_exp2(-a[0] * LOG2E)) * bflo(p.x); sum[1] += __builtin_amdgcn_rcpf(1.0f + fast_exp2(-a[1] * LOG2E)) * bfhi(p.x);
                        sum[2] += __builtin_amdgcn_rcpf(1.0f + fast_exp2(-a[2] * LOG2E)) * bflo(p.y); sum[3] += __builtin_amdgcn_rcpf(1.0f + fast_exp2(-a[3] * LOG2E)) * bfhi(p.y); }
                u32x2 w; w.x = cvt_pk_bf16(sum[0], sum[1]); w.y = cvt_pk_bf16(sum[2], sum[3]); *(u32x2*)(S + row * D + chb) = w; }
    }
};
struct EpiResid {
    static constexpr bool PERM = false; const float* H; float* X1; const float* mod;
    __device__ __forceinline__ void operator()(const f32x4 (&acc)[2][2][4][2], const g8::Unit& u, int wr, int wc, int fr, int fq) const {
        const int col0 = u.c0 + wc * 32 + 4 * fq;
#pragma unroll
        for (int ai = 0; ai < 2; ++ai)
#pragma unroll
            for (int m = 0; m < 4; ++m) { const int row = u.r0 + ai * 128 + wr * 64 + m * 16 + fr; const float* g1 = mod + (size_t)mod_row(row) * 6144 + 2048; const size_t off = (size_t)row * D;
#pragma unroll
                for (int bj = 0; bj < 2; ++bj)
#pragma unroll
                    for (int n = 0; n < 2; ++n) { const int c = col0 + bj * 128 + n * 16; *(f32x4*)(X1 + off + c) = *(const f32x4*)(H + off + c) * DN_ALPHA + *(const f32x4*)(g1 + c) * acc[ai][bj][m][n]; } }
    }
};
__device__ __forceinline__ void phase_inproj(const Ctx& C, int l) {
    SchedDense S{(const char*)WSP(bf16, WS_U1), (const char*)(WSP(bf16, WS_WIN) + (size_t)l * NZ * D), (size_t)D * 2, (size_t)D * 2, (T / 256) * (NZ / 256), C.G, C.bid, NZ / 256};
    EpiStoreBf16 E{WSP(bf16, WS_Z), (size_t)NZ};
    g8::gemm_phase(C.lds, D, D * 2, D * 2, S, E, C.tid);
}
__device__ __forceinline__ void phase_c1(const Ctx& C, int l, int nrows) {
    SchedC1 S{(const char*)WSP(bf16, WS_Y), (const char*)(WSP(bf16, WS_WB) + (size_t)l * 4 * 1024 * 256), (nrows / 256) * 16, C.G, C.bid};
    EpiStoreBf16 E{WSP(bf16, WS_P), (size_t)4096};
    g8::gemm_phase(C.lds, 256, 512, 512, S, E, C.tid);
}
__device__ __forceinline__ void phase_c2(const Ctx& C, int l, int nrows) {
    SchedDense S{(const char*)WSP(bf16, WS_U1), (const char*)(WSP(bf16, WS_WG) + (size_t)l * 4096 * D), (size_t)D * 2, (size_t)D * 2, (nrows / 256) * 16, C.G, C.bid, 16};
    EpiGateMerge E{WSP(bf16, WS_P), WSP(bf16, WS_S)};
    g8::gemm_phase(C.lds, D, D * 2, D * 2, S, E, C.tid);
}
struct SchedDctx {
    const char* A; const char* B; int G, c;
    __device__ __forceinline__ bool next(int i, g8::Unit& u) const { const int L = unit_index(i, G, c, 128); if (L < 0) return false; const int pm = L >> 4, pn = (L >> 2) & 3, ks = L & 3;
        u.A = A + ((size_t)TL + pm * 256) * (D * 2) + (size_t)ks * 512; u.B = B + (size_t)pn * 256 * (D * 2) + (size_t)ks * 512; u.r0 = ks * TC + pm * 256; u.c0 = pn * 256; u.x = ks; return true; }
};
struct EpiRawF32 {
    static constexpr bool PERM = false; float* O;
    __device__ __forceinline__ void operator()(const f32x4 (&acc)[2][2][4][2], const g8::Unit& u, int wr, int wc, int fr, int fq) const {
        float* base = O + (size_t)(u.r0 + wr * 64 + fr) * D + u.c0 + wc * 32 + 4 * fq;
#pragma unroll
        for (int ai = 0; ai < 2; ++ai)
#pragma unroll
            for (int m = 0; m < 4; ++m)
#pragma unroll
                for (int bj = 0; bj < 2; ++bj)
#pragma unroll
                    for (int n = 0; n < 2; ++n) *(f32x4*)(base + (size_t)(ai * 128 + m * 16) * D + bj * 128 + n * 16) = acc[ai][bj][m][n];
    }
};
__device__ __forceinline__ void phase_d(const Ctx& C, int l, int nrows) {
    {
        SchedDense S{(const char*)WSP(bf16, WS_S), (const char*)(WSP(bf16, WS_WO) + (size_t)l * D * D), (size_t)D * 2, (size_t)D * 2, (TL / 256) * 4, C.G, C.bid, 4};
        EpiResid E{WSP(float, WS_H), WSP(float, WS_X1), WSP(float, WS_MOD) + (size_t)l * 9 * 6144};
        g8::gemm_phase(C.lds, D, D * 2, D * 2, S, E, C.tid);
    }
    if (nrows > TL) {
        SchedDctx S{(const char*)WSP(bf16, WS_S), (const char*)(WSP(bf16, WS_WO) + (size_t)l * D * D), C.G, C.bid};
        EpiRawF32 E{(float*)(C.ws + WS_XE + (size_t)4 * NE * 256 * D * 2)};
        g8::gemm_phase(C.lds, 256, D * 2, D * 2, S, E, C.tid);
    }
}
__device__ __forceinline__ void phase_g(const Ctx& C, int l, int mt) {
    LAS int* srow = (LAS int*)(C.lds + g8::STAGE_BYTES);
    const int per = mt * 16, nunits = NE * per; const int* SROW = WSP(int, WS_SROW);
    for (int i = 0; i < 9; ++i) { const int L = unit_index(i, C.G, C.bid, nunits); if (L >= 0 && C.tid < 256) { const int e = L / per, r = L - e * per, pm = r >> 4; srow[i * 256 + C.tid] = SROW[e * ESLOT + pm * 256 + C.tid]; } }
    __syncthreads();
    SchedGroup S{(const char*)WSP(bf16, WS_U2), (const char*)(WSP(bf16, WS_WGU) + (size_t)l * NE * 4096 * D), (size_t)0, (size_t)D * 2, (size_t)4096 * D * 2, nunits, C.G, C.bid, 16, per};
    EpiSwiGLU E{WSP(bf16, WS_ACT)};
    g8::gemm_phase<EpiSwiGLU, SchedGroup, true>(C.lds, D, D * 2, D * 2, S, E, C.tid, srow);
    __syncthreads();
}
struct SchedHctx {
    const char* A; const char* B; int G, c;
    __device__ __forceinline__ bool next(int i, g8::Unit& u) const { const int L = unit_index(i, G, c, NE * 16); if (L < 0) return false; const int e = L >> 4, pn = (L >> 2) & 3, ks = L & 3;
        u.A = A + ((size_t)e * ESLOT + NB * CAPL) * (FF * 2) + (size_t)ks * 1024; u.B = B + ((size_t)e * D + pn * 256) * (FF * 2) + (size_t)ks * 1024; u.r0 = ks * (NE * 256) + e * 256; u.c0 = pn * 256; u.x = e; return true; }
};
__device__ __forceinline__ void phase_h(const Ctx& C, int l, int mt) {
    {
        SchedGroup S{(const char*)WSP(bf16, WS_ACT), (const char*)(WSP(bf16, WS_WD) + (size_t)l * NE * D * FF), (size_t)FF * 2, (size_t)FF * 2, (size_t)D * FF * 2, NE * 8 * 4, C.G, C.bid, 4, 8 * 4};
        EpiStoreBf16 E{WSP(bf16, WS_YE), (size_t)D};
        g8::gemm_phase(C.lds, FF, FF * 2, FF * 2, S, E, C.tid);
    }
    if (mt == 9) {
        SchedHctx S{(const char*)WSP(bf16, WS_ACT), (const char*)(WSP(bf16, WS_WD) + (size_t)l * NE * D * FF), C.G, C.bid};
        EpiStoreBf16 E{WSP(bf16, WS_XE), (size_t)D};
        g8::gemm_phase(C.lds, 512, FF * 2, FF * 2, S, E, C.tid);
    }
}

__device__ __forceinline__ void na_unit_latent(const Ctx& C, int l, int u) {
    const int b = u >> 5, hh = (u >> 3) & 3, rr = u & 7, w = C.wave;
    const bf16* Z = WSP(bf16, WS_Z);
    LAS float* btab = (LAS float*)(C.lds + 110 * 1024 + 256);
    for (int i = C.tid; i < 15 * 31; i += 512) btab[i] = C.in[I_RPB][((size_t)l * 4 + hh) * 465 + i] * LOG2E;
    __syncthreads();
    const int R = 4 * rr + (w >> 1), qc0 = 32 * (w & 1);
    int kr_lo = 4 * rr - 4; kr_lo = kr_lo < 0 ? 0 : (kr_lo > 24 ? 24 : kr_lo);
    int kr_hi = 4 * rr - 1; kr_hi = (kr_hi < 0 ? 0 : (kr_hi > 24 ? 24 : kr_hi)) + 8;
    int r0w = R - 4; r0w = r0w < 0 ? 0 : (r0w > 24 ? 24 : r0w);
    const size_t lat0 = (size_t)b * SEQ, ctx0 = (size_t)TL + (size_t)b * CTX;
    const bf16* q = Z + (lat0 + R * 64 + qc0) * NZ + ZQ + hh * 64;
    bf16* o = WSP(bf16, WS_Y) + (lat0 + R * 64 + qc0) * 256 + hh * 64;
    attn_unit<64, true>(C, q, NZ, Z + ctx0 * NZ + ZK + hh * 64, Z + ctx0 * NZ + ZV + hh * 64, 4,
                        Z + (lat0 + kr_lo * 64) * NZ + ZK + hh * 64, Z + (lat0 + kr_lo * 64) * NZ + ZV + hh * 64, kr_hi - kr_lo,
                        NZ, NZ, o, 256, r0w - kr_lo, r0w - kr_lo + 8, kr_lo - R + 7, qc0, btab);
    __syncthreads();
}
__device__ __forceinline__ void na_unit_ctx(const Ctx& C, int u) {
    const int b = u >> 2, hh = u & 3, w = C.wave;
    const bf16* Z = WSP(bf16, WS_Z);
    const size_t ctx0 = (size_t)TL + (size_t)b * CTX;
    const bf16* q = Z + (ctx0 + 32 * w) * NZ + ZQ + hh * 64;
    bf16* o = WSP(bf16, WS_Y) + (ctx0 + 32 * w) * 256 + hh * 64;
    attn_unit<64, false>(C, q, NZ, Z + ctx0 * NZ + ZK + hh * 64, Z + ctx0 * NZ + ZV + hh * 64, 4, nullptr, nullptr, 0, NZ, NZ, o, 256, 0, 0, 0, 0, nullptr);
    __syncthreads();
}
template <int NC>
__device__ __forceinline__ void row_rms(const Ctx& C, int tm, int zc, LAS float* rs) {
    const bf16* Z = WSP(bf16, WS_Z);
    const int r = C.tid >> 2, part = C.tid & 3;
    const bf16* p = Z + (size_t)(tm * 128 + r) * NZ + zc + part * (NC / 4);
    float s = 0.f;
#pragma unroll
    for (int i = 0; i < NC / 32; ++i) { const u32x4 v = *(const u32x4*)(p + 8 * i);
        const float a0 = bflo(v.x), a1 = bfhi(v.x), a2 = bflo(v.y), a3 = bfhi(v.y), a4 = bflo(v.z), a5 = bfhi(v.z), a6 = bflo(v.w), a7 = bfhi(v.w);
        s += a0 * a0 + a1 * a1 + a2 * a2 + a3 * a3 + a4 * a4 + a5 * a5 + a6 * a6 + a7 * a7; }
    s += __shfl_xor(s, 1); s += __shfl_xor(s, 2);
    if (part == 0) rs[r] = 1.0f / sqrtf(s * (1.0f / NC) + LN_EPS);
    __syncthreads();
}
__device__ __forceinline__ void mlaq_tile(const Ctx& C, int l, int u) {
    const int tm = u / 3, tn = u % 3;
    LAS float* rs = (LAS float*)(C.lds + 110 * 1024);
    row_rms<256>(C, tm, ZCQ, rs);
    const bf16* Z = WSP(bf16, WS_Z); const bf16* W = WSP(bf16, WS_WUQ) + (size_t)l * 384 * 256; bf16* QM = WSP(bf16, WS_QM);
    const float* rope = WSP(float, WS_ROPE);
    auto arow = [=](int r) { return Z + (size_t)(tm * 128 + r) * NZ + ZCQ; };
    auto brow = [=](int r) { return W + (size_t)(tn * 128 + r) * 256; };
    auto epi = [=](const f32x4 (&acc)[4][2], int wr, int wc, int fr, int fq) {
#pragma unroll
        for (int m = 0; m < 4; ++m)
#pragma unroll
            for (int n = 0; n < 2; ++n) { const int rl = wr * 64 + m * 16 + fr, row = tm * 128 + rl, col = tn * 128 + wc * 32 + n * 16 + 4 * fq;
                const float s = rs[rl] * MLA_QS; f32x4 v = acc[m][n] * s;
                const int cc = col % 96;
                if (cc >= 64 && row < TL) { const int pos = row & 2047, pi = (cc - 64) >> 1; const f32x4 cs = *(const f32x4*)(rope + (size_t)pos * 32 + 2 * pi);
                    const float x1 = v[0], x2 = v[1], y1 = v[2], y2 = v[3];
                    v[0] = x1 * cs[0] - x2 * cs[1]; v[1] = x1 * cs[1] + x2 * cs[0]; v[2] = y1 * cs[2] - y2 * cs[3]; v[3] = y1 * cs[3] + y2 * cs[2]; }
                u32x2 w; w.x = cvt_pk_bf16(v[0], v[1]); w.y = cvt_pk_bf16(v[2], v[3]); *(u32x2*)(QM + (size_t)row * 384 + col) = w; }
    };
    sgemm_tile(C, arow, brow, 256, 0, epi);
}
__device__ __forceinline__ void mlakv_tile(const Ctx& C, int l, int u) {
    const int tm = u >> 2, tn = u & 3;
    LAS float* rs = (LAS float*)(C.lds + 110 * 1024);
    row_rms<128>(C, tm, ZCKV, rs);
    const bf16* Z = WSP(bf16, WS_Z); const bf16* W = WSP(bf16, WS_WUKV) + (size_t)l * 512 * 128; bf16* KM = WSP(bf16, WS_KM); bf16* VM = WSP(bf16, WS_VM);
    const float* rope = WSP(float, WS_ROPE);
    auto arow = [=](int r) { return Z + (size_t)(tm * 128 + r) * NZ + ZCKV; };
    auto brow = [=](int r) { return W + (size_t)(tn * 128 + r) * 128; };
    auto epi = [=](const f32x4 (&acc)[4][2], int wr, int wc, int fr, int fq) {
#pragma unroll
        for (int m = 0; m < 4; ++m)
#pragma unroll
            for (int n = 0; n < 2; ++n) { const int rl = wr * 64 + m * 16 + fr, row = tm * 128 + rl, c = wc * 32 + n * 16 + 4 * fq;
                const f32x4 v = acc[m][n] * rs[rl]; u32x2 w; w.x = cvt_pk_bf16(v[0], v[1]); w.y = cvt_pk_bf16(v[2], v[3]);
                if (c < 64) *(u32x2*)(KM + (size_t)row * 384 + tn * 96 + c) = w; else *(u32x2*)(VM + (size_t)row * 256 + tn * 64 + (c - 64)) = w; }
    };
    sgemm_tile(C, arow, brow, 128, 0, epi);
    for (int i = C.tid; i < 128 * 8; i += 512) { const int rl = i >> 3, g4 = i & 7, row = tm * 128 + rl;
        const u32x2 w = *(const u32x2*)(Z + (size_t)row * NZ + ZKR + 4 * g4); float x1 = bflo(w.x), x2 = bfhi(w.x), y1 = bflo(w.y), y2 = bfhi(w.y);
        if (row < TL) { const int pos = row & 2047; const f32x4 cs = *(const f32x4*)(rope + (size_t)pos * 32 + 4 * g4);
            const float a = x1 * cs[0] - x2 * cs[1], b2 = x1 * cs[1] + x2 * cs[0], c2 = y1 * cs[2] - y2 * cs[3], d2 = y1 * cs[3] + y2 * cs[2]; x1 = a; x2 = b2; y1 = c2; y2 = d2; }
        u32x2 o; o.x = cvt_pk_bf16(x1, x2); o.y = cvt_pk_bf16(y1, y2); *(u32x2*)(KM + (size_t)row * 384 + tn * 96 + 64 + 4 * g4) = o; }
}
__device__ __forceinline__ void fft1_tile(const Ctx& C, int u) {
    const bf16* Z = WSP(bf16, WS_Z); const bf16* T64 = WSP(bf16, WS_T64);
    int b, g, ch, L; size_t tok0; bf16* dst; int ldd, half;
    if (u < 256) { b = u >> 5; g = (u >> 3) & 3; ch = u & 7; L = SEQ; tok0 = (size_t)b * SEQ; dst = WSP(bf16, WS_FB) + (size_t)((b * 4 + g) * 64) * 2048 + ch * 128; ldd = 2048; half = 1024; }
    else { const int v = u - 256; b = v >> 2; g = v & 3; ch = 0; L = CTX; tok0 = (size_t)TL + (size_t)b * CTX; dst = WSP(bf16, WS_FBC) + (size_t)((b * 4 + g) * 64) * 256; ldd = 256; half = 128; }
    const bf16* Zg = Z + tok0 * NZ + ZF + g * 64;
    auto arow = [=](int r) { return T64 + (size_t)r * 128; };
    auto brow = [=](int r) { return Zg + (size_t)(ch * 128 + r) * NZ; };
    auto bstep = [=](int r) { const int n = ch * 128 + r, mir = (L - n) & (L - 1); return (long)(mir - n) * NZ; };
    auto epi = [=](const f32x4 (&acc)[4][2], int wr, int wc, int fr, int fq) {
#pragma unroll
        for (int m = 0; m < 4; ++m)
#pragma unroll
            for (int n = 0; n < 2; ++n) { const int mrow = wr * 64 + m * 16 + fr, col = wc * 32 + n * 16 + 4 * fq;
                u32x2 w; w.x = cvt_pk_bf16(acc[m][n][0], acc[m][n][1]); w.y = cvt_pk_bf16(acc[m][n][2], acc[m][n][3]);
                *(u32x2*)(dst + (size_t)(mrow & 63) * ldd + (mrow >> 6) * half + col) = w; }
    };
    sgemm_tile_s(C, arow, brow, bstep, 128, epi);
    if (ch == 0 && C.tid < 64) {
        const bf16* zr = Zg + (size_t)(L >> 1) * NZ; const bf16* tr = T64 + (size_t)C.tid * 128; float s = 0.f;
#pragma unroll
        for (int c8 = 0; c8 < 8; ++c8) { const u32x4 z = *(const u32x4*)(zr + c8 * 8), t = *(const u32x4*)(tr + c8 * 8);
            s += bflo(z.x) * bflo(t.x) + bfhi(z.x) * bfhi(t.x) + bflo(z.y) * bflo(t.y) + bfhi(z.y) * bfhi(t.y) + bflo(z.z) * bflo(t.z) + bfhi(z.z) * bfhi(t.z) + bflo(z.w) * bflo(t.w) + bfhi(z.w) * bfhi(t.w); }
        dst[(size_t)C.tid * ldd + half] = (bf16)(cvt_pk_bf16(s, 0.f) & 0xffff);
    }
}
__device__ __forceinline__ void pool_all(const Ctx& C) {
    const bf16* Z = WSP(bf16, WS_Z); bf16* Y1 = WSP(bf16, WS_Y) + (size_t)T * 256;
    const size_t gtid = (size_t)C.bid * 512 + C.tid, gth = (size_t)C.G * 512;
    for (size_t i = gtid; i < (size_t)T * 32; i += gth) {
        const int row = (int)(i >> 5), c8 = (int)(i & 31), g = c8 >> 3;
        const int L = row < TL ? SEQ : CTX, s0 = row < TL ? (row & ~2047) : TL + ((row - TL) & ~255), t = row - s0, half = 1 << g;
        int lo = t - half; lo = lo < 0 ? 0 : lo; int hi = t + half; hi = hi > L ? L : hi;
        float a[8];
#pragma unroll
        for (int q = 0; q < 8; ++q) a[q] = 0.f;
        for (int tt = lo; tt < hi; ++tt) { const u32x4 v = *(const u32x4*)(Z + (size_t)(s0 + tt) * NZ + ZP + c8 * 8);
            a[0] += bflo(v.x); a[1] += bfhi(v.x); a[2] += bflo(v.y); a[3] += bfhi(v.y); a[4] += bflo(v.z); a[5] += bfhi(v.z); a[6] += bflo(v.w); a[7] += bfhi(v.w); }
        const float inv = 1.0f / (float)(hi - lo);
        const u32x4 me = *(const u32x4*)(Z + (size_t)row * NZ + ZP + c8 * 8);
        u32x4 o; o.x = cvt_pk_bf16(a[0] * inv - bflo(me.x), a[1] * inv - bfhi(me.x)); o.y = cvt_pk_bf16(a[2] * inv - bflo(me.y), a[3] * inv - bfhi(me.y));
        o.z = cvt_pk_bf16(a[4] * inv - bflo(me.z), a[5] * inv - bfhi(me.z)); o.w = cvt_pk_bf16(a[6] * inv - bflo(me.w), a[7] * inv - bfhi(me.w));
        *(u32x4*)(Y1 + (size_t)row * 256 + c8 * 8) = o;
    }
}
__device__ __forceinline__ void phase_b0(const Ctx& C, int l) {
    const bool wc = l < DEPTH - 1;
    const int n_na = 256, n_nac = wc ? 32 : 0, n_q = (T / 128) * 3, n_kv = (T / 128) * 4, n_f = wc ? 288 : 256;
    const int total = n_na + n_nac + n_q + n_kv + n_f;
    for (int u = C.bid; u < total; u += C.G) {
        int v = u;
        if (v < n_na) { na_unit_latent(C, l, v); continue; } v -= n_na;
        if (v < n_nac) { na_unit_ctx(C, v); continue; } v -= n_nac;
        if (v < n_q) { mlaq_tile(C, l, v); continue; } v -= n_q;
        if (v < n_kv) { mlakv_tile(C, l, v); continue; } v -= n_kv;
        fft1_tile(C, v);
    }
    pool_all(C);
}

__device__ __forceinline__ void mla_unit(const Ctx& C, int u, bool ctxq) {
    const bf16* QM = WSP(bf16, WS_QM); const bf16* KM = WSP(bf16, WS_KM); const bf16* VM = WSP(bf16, WS_VM);
    bf16* Y3 = WSP(bf16, WS_Y) + (size_t)3 * T * 256;
    const int w = C.wave;
    if (!ctxq) {
        const int b = u >> 5, hh = (u >> 3) & 3, qb = u & 7;
        const size_t lat0 = (size_t)b * SEQ, ctx0 = (size_t)TL + (size_t)b * CTX, q0 = lat0 + qb * 256 + w * 32;
        attn_unit<96, false>(C, QM + q0 * 384 + hh * 96, 384, KM + lat0 * 384 + hh * 96, VM + lat0 * 256 + hh * 64, 32,
                             KM + ctx0 * 384 + hh * 96, VM + ctx0 * 256 + hh * 64, 4, 384, 256, Y3 + q0 * 256 + hh * 64, 256, 0, 0, 0, 0, nullptr);
    } else {
        const int b = u >> 2, hh = u & 3;
        const size_t ctx0 = (size_t)TL + (size_t)b * CTX, q0 = ctx0 + w * 32;
        attn_unit<96, false>(C, QM + q0 * 384 + hh * 96, 384, KM + ctx0 * 384 + hh * 96, VM + ctx0 * 256 + hh * 64, 4,
                             nullptr, nullptr, 0, 384, 256, Y3 + q0 * 256 + hh * 64, 256, 0, 0, 0, 0, nullptr);
    }
    __syncthreads();
}
__device__ __forceinline__ void fft2_tile(const Ctx& C, int u, bool ctxq) {
    bf16* Y2 = WSP(bf16, WS_Y) + (size_t)2 * T * 256;
    if (!ctxq) {
        const int tm = u >> 4, tn = u & 15, b = tn >> 1;
        const bf16* A = WSP(bf16, WS_AFFT); const bf16* Bt = WSP(bf16, WS_FB);
        auto arow = [=](int r) { return A + (size_t)(tm * 128 + r) * 2048; };
        auto brow = [=](int r) { return Bt + (size_t)(tn * 128 + r) * 2048; };
        auto epi = [=](const f32x4 (&acc)[4][2], int wr, int wc, int fr, int fq) {
#pragma unroll
            for (int m = 0; m < 4; ++m)
#pragma unroll
                for (int n = 0; n < 2; ++n) { const int k1 = tm * 128 + wr * 64 + m * 16 + fr, chn = (tn & 1) * 128 + wc * 32 + n * 16 + 4 * fq;
                    u32x2 w; w.x = cvt_pk_bf16(acc[m][n][0], acc[m][n][1]); w.y = cvt_pk_bf16(acc[m][n][2], acc[m][n][3]);
                    *(u32x2*)(Y2 + ((size_t)b * SEQ + k1) * 256 + chn) = w; }
        };
        sgemm_tile(C, arow, brow, 2048, 0, epi);
    } else {
        const int tm = u >> 4, tn = u & 15, b = tn >> 1;
        const bf16* A = WSP(bf16, WS_AFFTC); const bf16* Bt = WSP(bf16, WS_FBC);
        auto arow = [=](int r) { return A + (size_t)(tm * 128 + r) * 256; };
        auto brow = [=](int r) { return Bt + (size_t)(tn * 128 + r) * 256; };
        auto epi = [=](const f32x4 (&acc)[4][2], int wr, int wc, int fr, int fq) {
#pragma unroll
            for (int m = 0; m < 4; ++m)
#pragma unroll
                for (int n = 0; n < 2; ++n) { const int k1 = tm * 128 + wr * 64 + m * 16 + fr, chn = (tn & 1) * 128 + wc * 32 + n * 16 + 4 * fq;
                    u32x2 w; w.x = cvt_pk_bf16(acc[m][n][0], acc[m][n][1]); w.y = cvt_pk_bf16(acc[m][n][2], acc[m][n][3]);
                    *(u32x2*)(Y2 + ((size_t)TL + (size_t)b * CTX + k1) * 256 + chn) = w; }
        };
        sgemm_tile(C, arow, brow, 256, 0, epi);
    }
}
__device__ __forceinline__ void phase_b1(const Ctx& C, int l) {
    const bool wc = l < DEPTH - 1;
    const int n_m = 256, n_f = 256, n_mc = wc ? 32 : 0, n_fc = wc ? 32 : 0;
    const int total = n_m + n_f + n_mc + n_fc;
    for (int u = C.bid; u < total; u += C.G) {
        int v = u;
        if (v < n_m) { mla_unit(C, v, false); continue; } v -= n_m;
        if (v < n_f) { fft2_tile(C, v, false); continue; } v -= n_f;
        if (v < n_mc) { mla_unit(C, v, true); continue; } v -= n_mc;
        fft2_tile(C, v, true);
    }
}

__device__ __forceinline__ void phase_e(const Ctx& C, int l, int nrows) {
    LAS float* wr = (LAS float*)C.lds;
    LAS float* lgl = (LAS float*)(C.lds + 65536);
    LAS float* lbl = lgl + 1024;
    LAS float* mdl = lbl + 1024;
    const int tid = C.tid, lane = C.lane, rg = lane >> 4, li = lane & 15;
    {   f32x4 wv[8];
#pragma unroll
        for (int q = 0; q < 8; ++q) wv[q] = *(const f32x4*)(C.in[I_WROUTER] + (size_t)l * 16384 + 4 * (tid + 512 * q));
        const f32x4 gv = *(const f32x4*)(C.in[(tid < 256) ? I_LN1G : I_LN1B] + l * D + 4 * (tid & 255));
#pragma unroll
        for (int q = 0; q < 8; ++q) { const int i4 = tid + 512 * q, d = i4 >> 2, e4 = (i4 & 3) * 4; wr[(e4 + 0) * 1024 + d] = wv[q][0]; wr[(e4 + 1) * 1024 + d] = wv[q][1]; wr[(e4 + 2) * 1024 + d] = wv[q][2]; wr[(e4 + 3) * 1024 + d] = wv[q][3]; }
        *(LAS f32x4*)(((tid < 256) ? lgl : lbl) + 4 * (tid & 255)) = gv; }
    const int bkk = blk_k(C), bxx = blk_x(C), bp = (bkk < 8) ? bxx * 8 + bkk : 64 + bxx * 24 + (bkk - 8);
    const int gw = bp * 8 + C.wave, NGW = C.G * 8, ngroups = nrows >> 2;
    const float* mod = WSP(float, WS_MOD) + (size_t)l * 9 * 6144;
    const float* X1 = WSP(float, WS_X1);
    float* AFFT = WSP(float, WS_AFF);
    f32x4 nx[16]; f32x4 nmd;
    const int mdv = tid >> 8, mdc = (tid & 255) * 4;
    if (gw < ngroups) {
        const int row = 4 * gw + rg; const float* mr = mod + (size_t)mod_row(4 * gw) * 6144;
#pragma unroll
        for (int j = 0; j < 16; ++j) nx[j] = *(const f32x4*)(X1 + (size_t)row * D + 4 * li + 64 * j);
        nmd = *(const f32x4*)(mr + (mdv ? 3072 : 4096) + mdc);
    }
    for (int g = gw, it = 0; g < ngroups; g += NGW, ++it) {
        {   f32x4 w = nmd; if (mdv == 0) w = w + 1.0f; *(LAS f32x4*)(mdl + (it & 1) * 2048 + mdv * 1024 + mdc) = w; }
        __syncthreads();
        const LAS float* scl = mdl + (it & 1) * 2048; const LAS float* shl = scl + 1024;
        f32x4 v[16]; float s = 0.f;
        const int row = 4 * g + rg;
        if (4 * g < TL) {
#pragma unroll
            for (int j = 0; j < 16; ++j) v[j] = nx[j];
        } else {
            const float* hr = WSP(float, WS_H) + (size_t)row * D + 4 * li; const float* g1 = mod + (size_t)8 * 6144 + 2048 + 4 * li;
            const float* pc = (const float*)(C.ws + WS_XE + (size_t)4 * NE * 256 * D * 2) + (size_t)(row - TL) * D + 4 * li;
#pragma unroll
            for (int j = 0; j < 16; ++j) { const f32x4 p0 = *(const f32x4*)(pc + 64 * j), p1 = *(const f32x4*)(pc + (size_t)TC * D + 64 * j), p2 = *(const f32x4*)(pc + (size_t)2 * TC * D + 64 * j), p3 = *(const f32x4*)(pc + (size_t)3 * TC * D + 64 * j);
                v[j] = *(const f32x4*)(hr + 64 * j) * DN_ALPHA + *(const f32x4*)(g1 + 64 * j) * ((p0 + p1) + (p2 + p3));
                *(f32x4*)(WSP(float, WS_X1) + (size_t)row * D + 4 * li + 64 * j) = v[j]; }
        }
#pragma unroll
        for (int j = 0; j < 16; ++j) s += (v[j][0] + v[j][1]) + (v[j][2] + v[j][3]);
        if (g + NGW < ngroups) { const int gn = g + NGW, rn = 4 * gn + rg; const float* mr = mod + (size_t)mod_row(4 * gn) * 6144;
            if (4 * gn < TL) {
#pragma unroll
                for (int j = 0; j < 16; ++j) nx[j] = *(const f32x4*)(X1 + (size_t)rn * D + 4 * li + 64 * j);
            }
            nmd = *(const f32x4*)(mr + (mdv ? 3072 : 4096) + mdc); }
        const float mean = row16_sum(s) * (1.0f / D); float q = 0.f;
#pragma unroll
        for (int j = 0; j < 16; ++j) { v[j] = v[j] - mean; q += (v[j][0] * v[j][0] + v[j][1] * v[j][1]) + (v[j][2] * v[j][2] + v[j][3] * v[j][3]); }
        const float rstd = 1.0f / sqrtf(row16_sum(q) * (1.0f / D) + LN_EPS);
        float lgt[16];
#pragma unroll
        for (int e = 0; e < 16; ++e) lgt[e] = 0.f;
        bf16* ud = WSP(bf16, WS_U2) + (size_t)row * D + 4 * li;
        if (li == 0) { typedef float f32x2v __attribute__((ext_vector_type(2))); *(f32x2v*)(WSP(float, WS_ST1) + (size_t)row * 2) = (f32x2v){mean, rstd}; }
#pragma unroll
        for (int j = 0; j < 16; ++j) { const int c = 4 * li + 64 * j;
            const f32x4 y = v[j] * rstd * *(const LAS f32x4*)(lgl + c) + *(const LAS f32x4*)(lbl + c);
            const f32x4 uu = y * *(const LAS f32x4*)(scl + c) + *(const LAS f32x4*)(shl + c);
            u32x2 w; w.x = cvt_pk_bf16(uu[0], uu[1]); w.y = cvt_pk_bf16(uu[2], uu[3]); st_wt8(ud + 64 * j, w);
#pragma unroll
            for (int eh = 0; eh < 4; ++eh) {
                f32x4 ww[4];
#pragma unroll
                for (int e = 0; e < 4; ++e) ww[e] = *(const LAS f32x4*)(wr + (4 * eh + e) * 1024 + c);
                __builtin_amdgcn_sched_barrier(0);
#pragma unroll
                for (int e = 0; e < 4; ++e) lgt[4 * eh + e] += (uu[0] * ww[e][0] + uu[1] * ww[e][1]) + (uu[2] * ww[e][2] + uu[3] * ww[e][3]);
                __builtin_amdgcn_sched_barrier(0);
            }
        }
        float mx = -1e30f;
#pragma unroll
        for (int e = 0; e < 16; ++e) { lgt[e] = row16_sum(lgt[e]); mx = fmaxf(mx, lgt[e]); }
        float den = 0.f;
#pragma unroll
        for (int e = 0; e < 16; ++e) { lgt[e] = __expf(lgt[e] - mx); den += lgt[e]; }
        const float inv = 1.0f / den; float mine = 0.f;
#pragma unroll
        for (int e = 0; e < 16; ++e) mine = (li == e) ? lgt[e] * inv : mine;
        AFFT[(size_t)li * T + row] = mine;
    }
    __syncthreads();
}
__device__ __forceinline__ void phase_f(const Ctx& C, int l) {
    const bool wc = l < DEPTH - 1;
    const int nunits = 128 + (wc ? 128 : 0);
    LAS unsigned* hist = (LAS unsigned*)(C.lds);
    LAS unsigned* wsum = (LAS unsigned*)(C.lds + 256);
    const int tid = C.tid, lane = C.lane, wave = C.wave;
    const float* AFF = WSP(float, WS_AFF); int* SLOT = WSP(int, WS_SLOT); float* GATEV = WSP(float, WS_GATEV); int* SROW = WSP(int, WS_SROW);
    {
        const int bx = blk_x(C), bk = blk_k(C); const int u = (bk < 16) ? bx * 16 + bk : 128 + bx * 16 + (bk - 16);
        if (u < nunits) {
        const bool isc = u >= 128; const int v = isc ? u - 128 : u, b = v >> 4, e = v & 15;
        const int cap = isc ? CAPC : CAPL, vpt = isc ? 1 : 4;
        const int row0 = isc ? TL + b * CTX : b * SEQ;
        const int sbase = e * ESLOT + (isc ? NB * CAPL + b * CAPC : b * CAPL);
        const bool have = isc ? (tid < 256) : true;
        unsigned key[4];
#pragma unroll
        for (int i = 0; i < 4; ++i) { key[i] = 0u; if (have && i < vpt) key[i] = __float_as_uint(AFF[(size_t)e * T + row0 + tid * vpt + i]); }
        if (tid < 48) hist[tid] = 0u;
        __syncthreads();
        unsigned prefix = 0u; int kth = cap;
#pragma unroll 1
        for (int it = 0; it < 8; ++it) {
            const int shift = 28 - 4 * it; LAS unsigned* hb = hist + 16 * (it % 3);
            if (tid < 16) hist[16 * ((it + 1) % 3) + tid] = 0u;
            unsigned mycnt = 0u;
#pragma unroll
            for (int i = 0; i < 4; ++i) {
                const bool in = have && i < vpt && (it == 0 || (key[i] >> (shift + 4)) == (prefix >> (shift + 4)));
                const unsigned dg = (key[i] >> shift) & 15u;
#pragma unroll
                for (int d = 0; d < 16; ++d) { const unsigned c = (unsigned)__popcll(__ballot(in && dg == (unsigned)d)); mycnt = (lane == d) ? mycnt + c : mycnt; }
            }
            if (lane < 16 && mycnt) atomicAdd((unsigned*)(hb + lane), mycnt);
            __syncthreads();
            unsigned cum = 0u; int dsel = 0; int kn = kth;
#pragma unroll
            for (int d = 15; d >= 0; --d) { const unsigned h = hb[d]; const bool hit = (cum < (unsigned)kth) && (cum + h >= (unsigned)kth); if (hit) { dsel = d; kn = kth - (int)cum; } cum += h; }
            prefix |= ((unsigned)dsel << shift); kth = kn;
        }
        const unsigned thr = prefix;
        unsigned neq = 0;
#pragma unroll
        for (int i = 0; i < 4; ++i) if (have && i < vpt) neq += (key[i] == thr);
        unsigned incl = neq;
#pragma unroll
        for (int o = 1; o < 64; o <<= 1) { const unsigned t2 = __shfl_up(incl, o); if (lane >= o) incl += t2; }
        if (lane == 63) wsum[wave] = incl;
        __syncthreads();
        unsigned woff = 0;
        for (int w2 = 0; w2 < wave; ++w2) woff += wsum[w2];
        unsigned eqrank = woff + incl - neq;
        unsigned sel[4]; unsigned nsel = 0;
#pragma unroll
        for (int i = 0; i < 4; ++i) { sel[i] = 0u; if (have && i < vpt) { if (key[i] > thr) sel[i] = 1u; else if (key[i] == thr) { sel[i] = ((int)eqrank < kth) ? 1u : 0u; ++eqrank; } nsel += sel[i]; } }
        incl = nsel;
#pragma unroll
        for (int o = 1; o < 64; o <<= 1) { const unsigned t2 = __shfl_up(incl, o); if (lane >= o) incl += t2; }
        if (lane == 63) wsum[8 + wave] = incl;
        __syncthreads();
        woff = 0;
        for (int w2 = 0; w2 < wave; ++w2) woff += wsum[8 + w2];
        unsigned pos = woff + incl - nsel;
#pragma unroll
        for (int i = 0; i < 4; ++i) if (have && i < vpt) { const int t = tid * vpt + i; int slot = -1;
            if (sel[i]) { slot = sbase + (int)pos; SROW[slot] = row0 + t; GATEV[slot] = __uint_as_float(key[i]); ++pos; }
            SLOT[(size_t)(row0 + t) * 16 + e] = slot; }
        __syncthreads();
    }
    }
}
__device__ __forceinline__ void phase_i(const Ctx& C, int l, int nrows) {
    LAS float* lgl = (LAS float*)C.lds;
    LAS float* lbl = lgl + 1024;
    LAS float* mdl = lbl + 1024;
    const int tid = C.tid, lane = C.lane, rg = lane >> 4, li = lane & 15;
    LAS float* l1g = mdl + 6144;
    LAS float* l1b = l1g + 1024;
    for (int i = tid; i < 1024; i += 512) { lgl[i] = C.in[I_LN2G][l * D + i]; lbl[i] = C.in[I_LN2B][l * D + i]; l1g[i] = C.in[I_LN1G][l * D + i]; l1b[i] = C.in[I_LN1B][l * D + i]; }
    const int bkk = blk_k(C), bxx = blk_x(C), bp = (bkk < 8) ? bxx * 8 + bkk : 64 + bxx * 24 + (bkk - 8);
    const int gw = bp * 8 + C.wave, NGW = C.G * 8, ngroups = nrows >> 2;
    const float* mod = WSP(float, WS_MOD) + (size_t)l * 9 * 6144;
    const float* modn = WSP(float, WS_MOD) + (size_t)(l + 1 < DEPTH ? l + 1 : l) * 9 * 6144;
    const int* SLOT = WSP(int, WS_SLOT); const float* GATEV = WSP(float, WS_GATEV); const bf16* YE = WSP(bf16, WS_YE); const bf16* YEC = WSP(bf16, WS_XE);
    float* Hb = WSP(float, WS_H); bf16* U1b = WSP(bf16, WS_U1); const float* X1b = WSP(float, WS_X1);
    const int mdv = tid >> 8, mdc = (tid & 255) * 4;
    auto mdload = [&](int g4row) -> f32x4 { const int r = mod_row(g4row); const float* p = (mdv == 0) ? mod + (size_t)r * 6144 + 5120 + mdc : modn + (size_t)r * 6144 + (mdv == 1 ? 1024 : 0) + mdc; return *(const f32x4*)p; };
    f32x4 nmd0 = (f32x4){0.f, 0.f, 0.f, 0.f}, nmd1 = nmd0;
    if (gw < ngroups) { nmd0 = mdload(4 * gw); if (tid < 256) { const int r = mod_row(4 * gw); nmd1 = *(const f32x4*)(modn + (size_t)r * 6144 + mdc); } }
    for (int g = gw, it = 0; g < ngroups; g += NGW, ++it) {
        {   LAS float* buf = mdl + (it & 1) * 3072;
            if (mdv < 2) { f32x4 w = nmd0; if (mdv == 1) w = w + 1.0f; *(LAS f32x4*)(buf + mdv * 1024 + mdc) = w; }
            if (tid < 256) *(LAS f32x4*)(buf + 2048 + mdc) = nmd1; }
        __syncthreads();
        const LAS float* g2l = mdl + (it & 1) * 3072; const LAS float* scl = g2l + 1024; const LAS float* shl = g2l + 2048;
        const int row = 4 * g + rg;
        const int myslot = SLOT[(size_t)row * 16 + li];
        f32x4 hv[16];
        typedef float f32x2v __attribute__((ext_vector_type(2))); const f32x2v st1 = *(const f32x2v*)(WSP(float, WS_ST1) + (size_t)row * 2);
#pragma unroll
        for (int j = 0; j < 16; ++j) hv[j] = *(const f32x4*)(X1b + (size_t)row * D + 4 * li + 64 * j);
        if (g + NGW < ngroups) { const int gn = g + NGW; nmd0 = mdload(4 * gn); if (tid < 256) { const int r = mod_row(4 * gn); nmd1 = *(const f32x4*)(modn + (size_t)r * 6144 + mdc); } }
        const unsigned long long bal = __ballot(myslot >= 0);
        unsigned m = (unsigned)(bal >> (16 * rg)) & 0xffffu;
#pragma unroll
        for (int j = 0; j < 16; ++j) { const int c = 4 * li + 64 * j; hv[j] = ((hv[j] - st1.x) * st1.y * *(const LAS f32x4*)(l1g + c) + *(const LAS f32x4*)(l1b + c)) * DN_ALPHA;
            if ((j & 3) == 3) __builtin_amdgcn_sched_barrier(0); }
        const bool isctx = (4 * g) >= TL;
        int ph = 0;
        while (__any(m != 0u)) {
            const bf16* p[2]; float gt[2];
            if (!isctx) {
#pragma unroll
                for (int k = 0; k < 2; ++k) { const bool ok = m != 0u; const int e = ok ? (int)__builtin_ctz(m) : 0; m = ok ? (m & (m - 1u)) : 0u;
                    const int sv = __shfl(myslot, (rg << 4) + e); const int se = ok ? sv : 0; gt[k] = ok ? GATEV[se] : 0.f; p[k] = YE + (size_t)se * D + 4 * li; }
            } else {
                const bool ok = m != 0u; const int e = ok ? (int)__builtin_ctz(m) : 0; if (ph) m = ok ? (m & (m - 1u)) : 0u;
                const int sv = __shfl(myslot, (rg << 4) + e); const int se = ok ? sv : NB * CAPL; const float gv = ok ? GATEV[se] : 0.f;
                const int ex = se / ESLOT, cr = se - ex * ESLOT - NB * CAPL; const bf16* base = YEC + ((size_t)ex * 256 + cr) * D + 4 * li + (size_t)(2 * ph) * (NE * 256) * D;
                p[0] = base; p[1] = base + (size_t)(NE * 256) * D; gt[0] = gv; gt[1] = gv; ph ^= 1;
            }
            const LAS float* g2p = g2l + 4 * li; asm volatile("" : "+v"(g2p));
            u32x2 w[2][16];
#pragma unroll
            for (int k = 0; k < 2; ++k)
#pragma unroll
                for (int j = 0; j < 16; ++j) w[k][j] = *(const u32x2*)(p[k] + 64 * j);
#pragma unroll
            for (int j = 0; j < 16; ++j) { const f32x4 g2v = *(const LAS f32x4*)(g2p + 64 * j);
#pragma unroll
                for (int k = 0; k < 2; ++k) { const f32x4 t = g2v * gt[k];
                    hv[j][0] += t[0] * bflo(w[k][j].x); hv[j][1] += t[1] * bfhi(w[k][j].x); hv[j][2] += t[2] * bflo(w[k][j].y); hv[j][3] += t[3] * bfhi(w[k][j].y); }
                if ((j & 3) == 3) __builtin_amdgcn_sched_barrier(0); }
        }
        float s = 0.f;
#pragma unroll
        for (int j = 0; j < 16; ++j) s += (hv[j][0] + hv[j][1]) + (hv[j][2] + hv[j][3]);
        const float mean = row16_sum(s) * (1.0f / D); float q = 0.f;
#pragma unroll
        for (int j = 0; j < 16; ++j) { hv[j] = hv[j] - mean; q += (hv[j][0] * hv[j][0] + hv[j][1] * hv[j][1]) + (hv[j][2] * hv[j][2] + hv[j][3] * hv[j][3]); }
        const float rstd = 1.0f / sqrtf(row16_sum(q) * (1.0f / D) + LN_EPS);
#pragma unroll
        for (int j = 0; j < 16; ++j) { const int c = 4 * li + 64 * j;
            const f32x4 y = hv[j] * rstd * *(const LAS f32x4*)(lgl + c) + *(const LAS f32x4*)(lbl + c);
            if (l + 1 < DEPTH) { *(f32x4*)(Hb + (size_t)row * D + c) = y; const f32x4 uu = y * *(const LAS f32x4*)(scl + c) + *(const LAS f32x4*)(shl + c);
                u32x2 w; w.x = cvt_pk_bf16(uu[0], uu[1]); w.y = cvt_pk_bf16(uu[2], uu[3]); *(u32x2*)(U1b + (size_t)row * D + c) = w; }
            else *(f32x4*)(C.out + (size_t)row * D + c) = y;
            if ((j & 3) == 3) __builtin_amdgcn_sched_barrier(0);
        }
    }
    __syncthreads();
}

constexpr int PH_PER_LAYER = 11, N_PHASES = 2 + DEPTH * PH_PER_LAYER;
__global__ void __launch_bounds__(512, 2) mega(Args args) {
    extern __shared__ __attribute__((aligned(16))) unsigned char lds_raw[];
#define MKCTX() Ctx C; { GAS unsigned char* w_ = (GAS unsigned char*)args.ws; asm volatile("" : "+s"(w_)); int t_ = threadIdx.x; asm volatile("" : "+v"(t_)); \
        C.lds = (LAS unsigned char*)lds_raw; C.ws = w_; C.in = args.in; C.out = args.out; C.tid = t_; C.lane = t_ & 63; C.wave = __builtin_amdgcn_readfirstlane(t_ >> 6); C.bid = (gridDim.x & 7u) ? blockIdx.x : (blockIdx.x & 7u) * (gridDim.x >> 3) + (blockIdx.x >> 3); C.G = gridDim.x; }
    LAS unsigned char* lds0 = (LAS unsigned char*)lds_raw;
    volatile LAS unsigned* misc = (volatile LAS unsigned*)(lds0 + LDS_MISC);
    if (threadIdx.x < 4) misc[threadIdx.x] = 0u;
    __syncthreads();
    const int lo = args.ph_lo, hi = args.ph_hi;
    const bool multi = (hi - lo) > 1;
    XcdBarrier bar; bar.bar = (unsigned*)(args.ws + WS_CTL) + 4096; bar.x = 0; bar.st = misc;
    if (multi) bar = xcd_barrier_post((unsigned*)(args.ws + WS_CTL) + 4096, misc);
#ifndef PHASE_MASK
#define PHASE_MASK 0xFFFFu
#endif
#define PM(i) (((PHASE_MASK) >> (i)) & 1u)
#define IN(k) (lo <= (k) && (k) < hi)
#define SEAM(k) do { if (IN((k) + 1)) xcd_barrier(bar); } while (0)
    if (PM(0) && IN(0)) { MKCTX(); phase_prep(C); SEAM(0); }
    if (PM(1) && IN(1)) { MKCTX(); phase_init(C); SEAM(1); }
    for (int l = 0; l < DEPTH; ++l) {
        const int p0 = 2 + l * PH_PER_LAYER;
        const int nrows = (l < DEPTH - 1) ? T : TL, mt = (l < DEPTH - 1) ? 9 : 8;
        if (PM(2) && IN(p0 + 0)) { MKCTX(); phase_inproj(C, l); SEAM(p0 + 0); }
        if (PM(3) && IN(p0 + 1)) { MKCTX(); phase_b0(C, l); SEAM(p0 + 1); }
        if (PM(4) && IN(p0 + 2)) { MKCTX(); phase_b1(C, l); SEAM(p0 + 2); }
        if (PM(5) && IN(p0 + 3)) { MKCTX(); phase_c1(C, l, nrows); if (l < DEPTH - 1 && blk_k(C) >= 16) slot_dn(C, l + 1, blk_x(C) * 16 + blk_k(C) - 16, DN_C1_FIRST, DN_C1_CNT); SEAM(p0 + 3); }
        if (PM(6) && IN(p0 + 4)) { MKCTX(); phase_c2(C, l, nrows); if (l < DEPTH - 1 && blk_k(C) >= 16) slot_gu(C, l + 1, blk_x(C) * 16 + blk_k(C) - 16, GU_C2_FIRST, GU_C2_CNT); SEAM(p0 + 4); }
        if (PM(7) && IN(p0 + 5)) { MKCTX(); phase_d(C, l, nrows); if (l < DEPTH - 1 && blk_k(C) >= 16) slot_gu(C, l + 1, blk_x(C) * 16 + blk_k(C) - 16, GU_D_FIRST, GU_D_CNT); SEAM(p0 + 5); }
        if (PM(8) && IN(p0 + 6)) { MKCTX(); phase_e(C, l, nrows); if (l < DEPTH - 1 && blk_k(C) >= 8) slot_dn(C, l + 1, blk_x(C) * 24 + blk_k(C) - 8, DN_E_FIRST, DN_E_CNT); SEAM(p0 + 6); }
        if (PM(9) && IN(p0 + 7)) { MKCTX(); phase_f(C, l); if (l < DEPTH - 1 && blk_k(C) >= 16) slot_gu(C, l + 1, blk_x(C) * 16 + blk_k(C) - 16, GU_F_FIRST, GU_F_CNT); SEAM(p0 + 7); }
        if (PM(10) && IN(p0 + 8)) { MKCTX(); phase_g(C, l, mt); SEAM(p0 + 8); }
        if (PM(11) && IN(p0 + 9)) { MKCTX(); phase_h(C, l, mt); SEAM(p0 + 9); }
        if (PM(12) && IN(p0 + 10)) { MKCTX(); phase_i(C, l, nrows); if (l < DEPTH - 1 && blk_k(C) >= 8) slot_dn(C, l + 1, blk_x(C) * 24 + blk_k(C) - 8, DN_I_FIRST, DN_I_CNT); SEAM(p0 + 10); }
    }
#undef IN
#undef SEAM
}

#ifdef DBG_STOP
__global__ void dbg_dump(const unsigned char* src, int mode, float* out, size_t n) {
    for (size_t i = (size_t)blockIdx.x * blockDim.x + threadIdx.x; i < n; i += (size_t)gridDim.x * blockDim.x) {
        if (mode == 0) out[i] = (float)((const unsigned short*)src)[i];
        else out[i] = (float)(((const unsigned*)src)[i] >> 8);
    }
}
__global__ void dbg_scan(const unsigned char* src, size_t n, int mode, float mark, float* out) {
    const size_t t = (size_t)blockIdx.x * blockDim.x + threadIdx.x, NT = (size_t)gridDim.x * blockDim.x;
    bool bad = false;
    for (size_t i = t; i < n; i += NT) { const float v = mode == 0 ? __uint_as_float(((unsigned)((const unsigned short*)src)[i]) << 16) : ((const float*)src)[i]; if (!(fabsf(v) < 1e6f)) bad = true; }
    out[t] = bad ? mark : 0.0f;
}
__global__ void dbg_check(const float* const* dummy, const float* x, const float* c, const float* cctx, const float* wmod, const float* bmod, const float* win, const unsigned char* ws, float* out) {
    const size_t t = (size_t)blockIdx.x * blockDim.x + threadIdx.x;
    const float* MOD = (const float*)(ws + WS_MOD); const bf16* WIN = (const bf16*)(ws + WS_WIN); const bf16* U1 = (const bf16*)(ws + WS_U1); const bf16* Z = (const bf16*)(ws + WS_Z);
    if ((DBG_SEG & 1) && t < 9 * 6144) { const int r = (int)(t / 6144), n = (int)(t % 6144); double s = 0; for (int k = 0; k < 1024; ++k) { const float v = r < 8 ? c[r * 1024 + k] : cctx[k]; s += (double)(v / (1.0f + expf(-v))) * wmod[(size_t)k * 6144 + n]; }
        s += bmod[n]; const float got = MOD[(size_t)r * 6144 + n]; out[t] = (fabs(got - s) > 1e-3 * fabs(s) + 1e-4) ? 1e6f : 0.f; }
    if (DBG_SEG & 2) { const size_t idx = (t * 6661) % ((size_t)1696 * 1024); const int n = (int)(idx / 1024), k = (int)(idx % 1024); const float ref = win[(size_t)k * IN_COLS + n] * (n < 256 ? NA_QS : 1.0f);
      const float got = __uint_as_float(((unsigned)WIN[(size_t)n * 1024 + k]) << 16); out[262144 + t] = (fabsf(got - ref) > 0.01f * fabsf(ref) + 1e-6f) ? 1e5f : 0.f; }
    if (DBG_SEG & 4) { const size_t idx = (t * 7919) % ((size_t)TL * 1024); const int row = (int)(idx / 1024), k = (int)(idx % 1024), r = row >> 11; const float ref = x[idx] * (1.0f + MOD[(size_t)r * 6144 + 1024 + k]) + MOD[(size_t)r * 6144 + k];
      const float got = __uint_as_float(((unsigned)U1[idx]) << 16); out[2 * 262144 + t] = (fabsf(got - ref) > 0.01f * fabsf(ref) + 1e-3f) ? 1e4f : 0.f; }
    if (DBG_SEG & 8) { const size_t idx = (t * 104729) % ((size_t)T * 1696); const int row = (int)(idx / 1696), col = (int)(idx % 1696); float sref = 0.f;
      for (int k = 0; k < 1024; ++k) sref += __uint_as_float(((unsigned)U1[(size_t)row * 1024 + k]) << 16) * __uint_as_float(((unsigned)WIN[(size_t)col * 1024 + k]) << 16);
      const float got = __uint_as_float(((unsigned)Z[(size_t)row * NZ + col]) << 16); out[3 * 262144 + t] = (fabsf(got - sref) > 0.02f * fabsf(sref) + 0.05f) ? 1e3f : 0.f; }
}
#endif
extern "C" void kernel_launch(void* const* d_in, const int* in_sizes, int n_in, void* d_out, int out_size, void* d_ws, size_t ws_size, hipStream_t stream) {
    static int grid = 0;
    if (grid == 0) {
        if (n_in != 24 || ws_size < WS_END) { fprintf(stderr, "kernel_launch: unexpected inputs (n_in %d, ws %zu, need %zu)\n", n_in, ws_size, (size_t)WS_END); grid = -1; return; }
        int dev = 0, cus = 0, per_cu = 0;
        if (hipGetDevice(&dev) != hipSuccess || hipDeviceGetAttribute(&cus, hipDeviceAttributeMultiprocessorCount, dev) != hipSuccess) { grid = -1; return; }
        if (hipFuncSetAttribute((const void*)mega, hipFuncAttributeMaxDynamicSharedMemorySize, LDS_BYTES) != hipSuccess) { fprintf(stderr, "kernel_launch: hipFuncSetAttribute failed\n"); grid = -1; return; }
        if (hipOccupancyMaxActiveBlocksPerMultiprocessor(&per_cu, (const void*)mega, 512, LDS_BYTES) != hipSuccess || per_cu < 1) fprintf(stderr, "kernel_launch: occupancy query says %d\n", per_cu);
        (void)hipGetLastError();
        grid = cus;
    }
    if (grid < 0) return;
#ifdef POISON_WS
    (void)hipMemsetAsync((char*)d_ws, 0x00, WS_END, stream);
#endif
    (void)hipMemsetAsync((char*)d_ws + WS_CTL, 0, CTL_BYTES, stream);
    Args a{};
    for (int i = 0; i < 24; ++i) a.in[i] = (const float*)d_in[i];
    a.out = (float*)d_out; a.ws = (unsigned char*)d_ws;
#if ONE_LAUNCH
    a.ph_lo = 0; a.ph_hi = N_PHASES;
    hipLaunchKernelGGL(mega, dim3(grid), dim3(512), LDS_BYTES, stream, a);
#else
#ifdef DBG_STOP
    for (int p = 0; p <= DBG_STOP; ++p) { a.ph_lo = p; a.ph_hi = p + 1; hipLaunchKernelGGL(mega, dim3(grid), dim3(512), LDS_BYTES, stream, a); }
    (void)hipMemsetAsync(d_out, 0, (size_t)out_size * 4, stream);
    hipLaunchKernelGGL(dbg_check, dim3(1024), dim3(256), 0, stream, (const float* const*)nullptr, (const float*)d_in[I_X], (const float*)d_in[I_C], (const float*)d_in[I_CCTX], (const float*)d_in[I_WMOD], (const float*)d_in[I_BMOD], (const float*)d_in[I_WIN], (const unsigned char*)d_ws, (float*)d_out);
#else
    for (int p = 0; p < N_PHASES; ++p) { a.ph_lo = p; a.ph_hi = p + 1; hipLaunchKernelGGL(mega, dim3(grid), dim3(512), LDS_BYTES, stream, a); }
#endif
#endif
}
```

```cpp
#include <hip/hip_runtime.h>
#include <cstdio>
#include <cstdint>

#ifndef ONE_LAUNCH
#define ONE_LAUNCH 1
#endif

#define GAS __attribute__((address_space(1)))
#define LAS __attribute__((address_space(3)))
typedef unsigned short bf16;
typedef short bf16x8 __attribute__((ext_vector_type(8)));
typedef short s16x4 __attribute__((ext_vector_type(4)));
typedef float f32x4 __attribute__((ext_vector_type(4)));
typedef float f32x16 __attribute__((ext_vector_type(16)));
typedef unsigned u32x4 __attribute__((ext_vector_type(4)));
typedef unsigned u32x2 __attribute__((ext_vector_type(2)));

constexpr int D = 1024, NB = 8, SEQ = 2048, CTX = 256, DEPTH = 4, GW = 64;
constexpr int TL = NB * SEQ, TC = NB * CTX, T = TL + TC;
constexpr int IN_COLS = 5792, NZ = 1792;
constexpr int ZQ = 0, ZK = 256, ZV = 512, ZP = 768, ZF = 1024, ZCQ = 1280, ZCKV = 1536, ZKR = 1664, ZEND = 1696;
constexpr int NE = 16, FF = 2048, CAPL = 256, CAPC = 32, ESLOT = NB * CAPL + NB * CAPC;
constexpr float LN_EPS = 1e-5f;
constexpr float DN_ALPHA = 1.681792830507429f;
constexpr float LOG2E = 1.4426950408889634f;
constexpr float NA_QS = 0.125f * LOG2E;
constexpr float MLA_QS = 0.10206207261596575f * LOG2E;

constexpr size_t al256(size_t x) { return (x + 255) & ~(size_t)255; }
constexpr size_t WS_CTL = 0, CTL_BYTES = 1u << 20;
constexpr size_t WS_MOD = WS_CTL + CTL_BYTES;
constexpr size_t WS_ROPE = al256(WS_MOD + (size_t)DEPTH * 9 * 6144 * 4);
constexpr size_t WS_T64 = al256(WS_ROPE + 2048 * 32 * 4);
constexpr size_t WS_AFFT = al256(WS_T64 + 128 * 128 * 2);
constexpr size_t WS_AFFTC = al256(WS_AFFT + (size_t)2048 * 2048 * 2);
constexpr size_t WS_WIN = al256(WS_AFFTC + 256 * 256 * 2);
constexpr size_t WS_WG = al256(WS_WIN + (size_t)DEPTH * NZ * D * 2);
constexpr size_t WS_WUQ = al256(WS_WG + (size_t)DEPTH * 4096 * D * 2);
constexpr size_t WS_WUKV = al256(WS_WUQ + (size_t)DEPTH * 384 * 256 * 2);
constexpr size_t WS_WB = al256(WS_WUKV + (size_t)DEPTH * 512 * 128 * 2);
constexpr size_t WS_WO = al256(WS_WB + (size_t)DEPTH * 4 * D * 256 * 2);
constexpr size_t WS_WGU = al256(WS_WO + (size_t)DEPTH * D * D * 2);
constexpr size_t WS_WD = al256(WS_WGU + (size_t)DEPTH * NE * 4096 * D * 2);
constexpr size_t WS_H = al256(WS_WD + (size_t)DEPTH * NE * D * FF * 2);
constexpr size_t WS_X1 = al256(WS_H + (size_t)T * D * 4);
constexpr size_t WS_U1 = al256(WS_X1 + (size_t)T * D * 4);
constexpr size_t WS_U2 = al256(WS_U1 + (size_t)T * D * 2);
constexpr size_t WS_Z = al256(WS_U2 + (size_t)T * D * 2);
constexpr size_t WS_QM = al256(WS_Z + (size_t)T * NZ * 2);
constexpr size_t WS_KM = al256(WS_QM + (size_t)T * 384 * 2);
constexpr size_t WS_VM = al256(WS_KM + (size_t)T * 384 * 2);
constexpr size_t WS_FB = al256(WS_VM + (size_t)T * 256 * 2);
constexpr size_t WS_FBC = al256(WS_FB + (size_t)2048 * 2048 * 2);
constexpr size_t WS_Y = al256(WS_FBC + (size_t)2048 * 256 * 2);
constexpr size_t WS_P = al256(WS_Y + (size_t)4 * T * 256 * 2);
constexpr size_t WS_AFF = al256(WS_P + (size_t)T * 4096 * 2);
constexpr size_t WS_SLOT = al256(WS_AFF + (size_t)T * 16 * 4);
constexpr size_t WS_GATEV = al256(WS_SLOT + (size_t)T * 16 * 4);
constexpr size_t WS_SROW = al256(WS_GATEV + (size_t)NE * ESLOT * 4);
constexpr size_t WS_XE = al256(WS_SROW + (size_t)NE * ESLOT * 4);
constexpr size_t WS_ACT = al256(WS_XE + (size_t)NE * ESLOT * D * 2);
constexpr size_t WS_YE = al256(WS_ACT + (size_t)NE * ESLOT * FF * 2);
constexpr size_t WS_S = al256(WS_YE + (size_t)NE * ESLOT * D * 2);
constexpr size_t WS_ST1 = al256(WS_S + (size_t)T * D * 2);
constexpr size_t WS_END = al256(WS_ST1 + (size_t)T * 2 * 4);
static_assert(WS_END <= (size_t)2047 * 1024 * 1024, "workspace map exceeds 2 GiB");

constexpr int LDS_BYTES = 147456;
constexpr int LDS_MISC = 140 * 1024;

typedef __bf16 bf16x2_t __attribute__((ext_vector_type(2)));
typedef float f32x2_t __attribute__((ext_vector_type(2)));
__device__ __forceinline__ unsigned cvt_pk_bf16(float lo, float hi) { f32x2_t v = {lo, hi}; bf16x2_t b = __builtin_convertvector(v, bf16x2_t); return __builtin_bit_cast(unsigned, b); }
__device__ __forceinline__ float bf2f(unsigned short b) { return __uint_as_float(((unsigned)b) << 16); }
__device__ __forceinline__ float bflo(unsigned w) { return __uint_as_float(w << 16); }
__device__ __forceinline__ float bfhi(unsigned w) { return __uint_as_float(w & 0xffff0000u); }
__device__ __forceinline__ float wave_sum(float v) {
    v += __builtin_bit_cast(float, __builtin_amdgcn_update_dpp(0, __builtin_bit_cast(int, v), 0xB1, 0xf, 0xf, true));
    v += __builtin_bit_cast(float, __builtin_amdgcn_update_dpp(0, __builtin_bit_cast(int, v), 0x4E, 0xf, 0xf, true));
    v += __builtin_bit_cast(float, __builtin_amdgcn_update_dpp(0, __builtin_bit_cast(int, v), 0x141, 0xf, 0xf, true));
    v += __builtin_bit_cast(float, __builtin_amdgcn_update_dpp(0, __builtin_bit_cast(int, v), 0x140, 0xf, 0xf, true));
    const int iv = __builtin_bit_cast(int, v);
    const float a = __builtin_bit_cast(float, __builtin_amdgcn_readlane(iv, 0)), b = __builtin_bit_cast(float, __builtin_amdgcn_readlane(iv, 16));
    const float c = __builtin_bit_cast(float, __builtin_amdgcn_readlane(iv, 32)), d = __builtin_bit_cast(float, __builtin_amdgcn_readlane(iv, 48));
    return (a + b) + (c + d);
}
__device__ __forceinline__ float row16_sum(float v) {
    v += __builtin_bit_cast(float, __builtin_amdgcn_update_dpp(0, __builtin_bit_cast(int, v), 0xB1, 0xf, 0xf, true));
    v += __builtin_bit_cast(float, __builtin_amdgcn_update_dpp(0, __builtin_bit_cast(int, v), 0x4E, 0xf, 0xf, true));
    v += __builtin_bit_cast(float, __builtin_amdgcn_update_dpp(0, __builtin_bit_cast(int, v), 0x141, 0xf, 0xf, true));
    v += __builtin_bit_cast(float, __builtin_amdgcn_update_dpp(0, __builtin_bit_cast(int, v), 0x140, 0xf, 0xf, true));
    return v;
}
__device__ __forceinline__ unsigned wave_sum_u(unsigned v) {
    v += (unsigned)__builtin_amdgcn_update_dpp(0, (int)v, 0xB1, 0xf, 0xf, true);
    v += (unsigned)__builtin_amdgcn_update_dpp(0, (int)v, 0x4E, 0xf, 0xf, true);
    v += (unsigned)__builtin_amdgcn_update_dpp(0, (int)v, 0x141, 0xf, 0xf, true);
    v += (unsigned)__builtin_amdgcn_update_dpp(0, (int)v, 0x140, 0xf, 0xf, true);
    return (unsigned)__builtin_amdgcn_readlane((int)v, 0) + (unsigned)__builtin_amdgcn_readlane((int)v, 16) + (unsigned)__builtin_amdgcn_readlane((int)v, 32) + (unsigned)__builtin_amdgcn_readlane((int)v, 48);
}
__device__ __forceinline__ void st_wt8(void* p, u32x2 v) { __hip_atomic_store((unsigned long long*)p, ((unsigned long long)v.y << 32) | v.x, __ATOMIC_RELAXED, __HIP_MEMORY_SCOPE_AGENT); }
__device__ __forceinline__ void st_wt16(void* p, u32x4 v) { __hip_atomic_store((unsigned long long*)p, ((unsigned long long)v.y << 32) | v.x, __ATOMIC_RELAXED, __HIP_MEMORY_SCOPE_AGENT); __hip_atomic_store((unsigned long long*)p + 1, ((unsigned long long)v.w << 32) | v.z, __ATOMIC_RELAXED, __HIP_MEMORY_SCOPE_AGENT); }
__device__ __forceinline__ float fast_exp2(float x) { return __builtin_amdgcn_exp2f(x); }
__device__ __forceinline__ float silu_f(float x) { return x / (1.0f + __expf(-x)); }

#define XB_TMO      128
#define XB_XCNT(j)  (256  + 64 * (j))
#define XB_XSUB(j)  (1280 + 64 * (j))
#define XB_XGEN(j)  (2304 + 64 * (j))
#define XB_TOP      3328
#define XB_TOPGEN   3392
#define XCD_BAR_WORDS 3456
#define XB_SPIN_CAP (1u << 18)
__device__ __forceinline__ unsigned xb_ld(unsigned* p)              { return __hip_atomic_load(p, __ATOMIC_RELAXED, __HIP_MEMORY_SCOPE_AGENT); }
__device__ __forceinline__ unsigned xb_add(unsigned* p, unsigned v) { return __hip_atomic_fetch_add(p, v, __ATOMIC_RELAXED, __HIP_MEMORY_SCOPE_AGENT); }
__device__ __forceinline__ unsigned xb_xcc_id() { return (unsigned)__builtin_amdgcn_s_getreg((3 << 11) | 20) & 0xFu; }
#define XB_SPIN(cond, bar) do { unsigned _sp = 0; while (cond) { __builtin_amdgcn_s_sleep(1); \
    if ((++_sp & 255u) == 0u) { if (xb_ld(&(bar)[XB_TMO])) break; if (_sp > XB_SPIN_CAP) { atomicAdd(&(bar)[XB_TMO], 1u); break; } } } } while (0)
struct XcdBarrier { unsigned* bar; unsigned x; volatile LAS unsigned* st; };
__device__ __forceinline__ XcdBarrier xcd_barrier_post(unsigned* bar, volatile LAS unsigned* st) {
    XcdBarrier b; b.bar = bar; b.x = xb_xcc_id(); b.st = st;
    if (threadIdx.x == 0) (void)xb_add(&bar[XB_XCNT(b.x)], 1u);
    return b;
}
__device__ __forceinline__ void xcd_barrier_complete(unsigned* bar, unsigned x, unsigned& nloc, unsigned& nx) {
    const unsigned G = gridDim.x * gridDim.y * gridDim.z;
    unsigned sum, cnt, mine, sp = 0u;
    for (;;) {
        sum = 0u; cnt = 0u; mine = 0u;
#pragma unroll
        for (unsigned j = 0; j < 16; ++j) { const unsigned c = xb_ld(&bar[XB_XCNT(j)]); sum += c; cnt += (c > 0u) ? 1u : 0u; mine = (j == x) ? c : mine; }
        if (sum == G) break;
        __builtin_amdgcn_s_sleep(1);
        if ((++sp & 255u) == 0u) { if (xb_ld(&bar[XB_TMO])) break; if (sp > XB_SPIN_CAP) { atomicAdd(&bar[XB_TMO], 1u); break; } }
    }
    nloc = mine > 0u ? mine : 1u; nx = cnt > 0u ? cnt : 1u;
}
__device__ __forceinline__ void xcd_barrier(const XcdBarrier& b) {
    asm volatile("s_waitcnt vmcnt(0)" ::: "memory");
    __syncthreads();
    if (threadIdx.x == 0) {
        unsigned* bar = b.bar;
        __builtin_amdgcn_s_waitcnt(0);
        unsigned nloc = b.st[0], nx = b.st[1];
        if (nloc == 0u) { xcd_barrier_complete(bar, b.x, nloc, nx); b.st[0] = nloc; b.st[1] = nx; }
        const unsigned old = xb_add(&bar[XB_XSUB(b.x)], 1u);
        const unsigned gen = old / nloc;
        if (old + 1u == (gen + 1u) * nloc) {
            __builtin_amdgcn_fence(__ATOMIC_RELEASE, "agent");
            asm volatile("s_waitcnt vmcnt(0)" ::: "memory");
            const unsigned og = xb_add(&bar[XB_TOP], 1u);
            const unsigned tg = og / nx;
            if (og + 1u == (tg + 1u) * nx) xb_add(&bar[XB_TOPGEN], 1u);
            else XB_SPIN(xb_ld(&bar[XB_TOPGEN]) == tg, bar);
            __builtin_amdgcn_fence(__ATOMIC_ACQUIRE, "agent");
            xb_add(&bar[XB_XGEN(b.x)], 1u);
            asm volatile("s_waitcnt vmcnt(0)" ::: "memory");
        } else {
            XB_SPIN(xb_ld(&bar[XB_XGEN(b.x)]) == gen, bar);
            __builtin_amdgcn_fence(__ATOMIC_ACQUIRE, "agent");
            asm volatile("s_waitcnt vmcnt(0)" ::: "memory");
        }
    }
    __syncthreads();
}

struct Args {
    const float* in[24];
    float* out;
    unsigned char* ws;
    int ph_lo, ph_hi;
};
enum { I_X = 0, I_C, I_CTX, I_CCTX, I_WMOD, I_BMOD, I_WIN, I_RPB, I_POOLW, I_POOLS, I_QNORM, I_WUQ, I_KVNORM, I_WUKV, I_WBR, I_WOUT,
       I_LN1G, I_LN1B, I_WROUTER, I_WGATE, I_WUP, I_WDOWN, I_LN2G, I_LN2B };

struct Ctx {
    LAS unsigned char* lds;
    GAS unsigned char* ws;
    const float* const* in;
    float* out;
    int tid, lane, wave, bid, G;
};
#define WSP(T_, off) ((T_*)(GAS T_*)(C.ws + (off)))

__device__ __forceinline__ int mod_row(int row) { return row < TL ? (row >> 11) : 8; }

constexpr int SG_TILE_B = 128 * 128;
constexpr int SG_LDS = 4 * SG_TILE_B;
template <class AF, class BF, class BS, class EPI>
__device__ __forceinline__ void sgemm_tile_s(const Ctx& C, AF arow, BF brow, BS bstep, int K, EPI epi) {
    const int tid = C.tid, lane = C.lane, wid = C.wave, wr = wid >> 2, wc = wid & 3, fr = lane & 15, fq = lane >> 4;
    LAS unsigned char* lds = C.lds;
    const bf16* ap[2]; const bf16* bp[2]; int lo[2]; long bst[2];
#pragma unroll
    for (int i = 0; i < 2; ++i) { const int c = tid + 512 * i, r = c >> 3, kc = c & 7; ap[i] = arow(r) + kc * 8; bp[i] = brow(r) + kc * 8; bst[i] = bstep(r); lo[i] = r * 128 + ((kc ^ ((r >> 1) & 7)) << 4); }
    f32x4 acc[4][2];
#pragma unroll
    for (int m = 0; m < 4; ++m)
#pragma unroll
        for (int n = 0; n < 2; ++n) acc[m][n] = (f32x4){0.f, 0.f, 0.f, 0.f};
    u32x4 ra0[2], rb0[2], ra1[2], rb1[2];
    const int nt = K >> 6;
    const int sw = (fr >> 1) & 7;
    const int ra_off = (wr * 64 + fr) * 128, rb_off = (wc * 32 + fr) * 128;
#define SG_GLOAD(RA, RB, t) do { const int ka_ = (t) * 64; _Pragma("unroll") for (int i = 0; i < 2; ++i) { RA[i] = *(const u32x4*)(ap[i] + ka_); RB[i] = *(const u32x4*)(bp[i] + (long)(t) * bst[i]); } } while (0)
#define SG_LSTORE(RA, RB, buf) do { _Pragma("unroll") for (int i = 0; i < 2; ++i) { *(LAS u32x4*)(lds + (buf) * SG_TILE_B + lo[i]) = RA[i]; *(LAS u32x4*)(lds + (2 + (buf)) * SG_TILE_B + lo[i]) = RB[i]; } } while (0)
#define SG_COMPUTE(buf) do { const LAS unsigned char* la = lds + (buf) * SG_TILE_B + ra_off; const LAS unsigned char* lb = lds + (2 + (buf)) * SG_TILE_B + rb_off; \
        _Pragma("unroll") for (int kk = 0; kk < 2; ++kk) { bf16x8 af[4], bfr[2]; const int co = (((4 * kk + fq) ^ sw) << 4); \
            _Pragma("unroll") for (int m = 0; m < 4; ++m) af[m] = *(const LAS bf16x8*)(la + m * 2048 + co); \
            _Pragma("unroll") for (int n = 0; n < 2; ++n) bfr[n] = *(const LAS bf16x8*)(lb + n * 2048 + co); \
            _Pragma("unroll") for (int m = 0; m < 4; ++m) _Pragma("unroll") for (int n = 0; n < 2; ++n) acc[m][n] = __builtin_amdgcn_mfma_f32_16x16x32_bf16(bfr[n], af[m], acc[m][n], 0, 0, 0); } } while (0)
    SG_GLOAD(ra0, rb0, 0);
    if (nt > 1) SG_GLOAD(ra1, rb1, 1);
    SG_LSTORE(ra0, rb0, 0);
    __syncthreads();
    for (int t = 0; t < nt; t += 2) {
        if (t + 2 < nt) SG_GLOAD(ra0, rb0, t + 2);
        SG_COMPUTE(0);
        if (t + 1 < nt) SG_LSTORE(ra1, rb1, 1);
        __syncthreads();
        if (t + 1 >= nt) break;
        if (t + 3 < nt) SG_GLOAD(ra1, rb1, t + 3);
        SG_COMPUTE(1);
        if (t + 2 < nt) SG_LSTORE(ra0, rb0, 0);
        __syncthreads();
    }
#undef SG_GLOAD
#undef SG_LSTORE
#undef SG_COMPUTE
    epi(acc, wr, wc, fr, fq);
    __syncthreads();
}
template <class AF, class BF, class EPI>
__device__ __forceinline__ void sgemm_tile(const Ctx& C, AF arow, BF brow, int K, int, EPI epi) { sgemm_tile_s(C, arow, brow, [](int) { return 64L; }, K, epi); }
template <class AF, class BF, class EPI>
__device__ __forceinline__ void sgemm_tile_d4(const Ctx& C, AF arow, BF brow, int K, EPI epi) {
    const int tid = C.tid, lane = C.lane, wid = C.wave, wr = wid >> 2, wc = wid & 3, fr = lane & 15, fq = lane >> 4;
    LAS unsigned char* lds = C.lds;
    const bf16* ap[2]; const bf16* bp[2]; int lo[2];
#pragma unroll
    for (int i = 0; i < 2; ++i) { const int c = tid + 512 * i, r = c >> 3, kc = c & 7; ap[i] = arow(r) + kc * 8; bp[i] = brow(r) + kc * 8; lo[i] = r * 128 + ((kc ^ ((r >> 1) & 7)) << 4); }
    f32x4 acc[4][2];
#pragma unroll
    for (int m = 0; m < 4; ++m)
#pragma unroll
        for (int n = 0; n < 2; ++n) acc[m][n] = (f32x4){0.f, 0.f, 0.f, 0.f};
    u32x4 ra[4][2], rb[4][2];
    const int nt = K >> 6;
    const int sw = (fr >> 1) & 7;
    const int ra_off = (wr * 64 + fr) * 128, rb_off = (wc * 32 + fr) * 128;
#define SG_GLOAD(q, t) do { const int ka_ = (t) * 64; _Pragma("unroll") for (int i = 0; i < 2; ++i) { ra[q][i] = *(const u32x4*)(ap[i] + ka_); rb[q][i] = *(const u32x4*)(bp[i] + ka_); } } while (0)
#define SG_LSTORE(q, buf) do { _Pragma("unroll") for (int i = 0; i < 2; ++i) { *(LAS u32x4*)(lds + (buf) * SG_TILE_B + lo[i]) = ra[q][i]; *(LAS u32x4*)(lds + (2 + (buf)) * SG_TILE_B + lo[i]) = rb[q][i]; } } while (0)
#define SG_COMPUTE(buf) do { const LAS unsigned char* la = lds + (buf) * SG_TILE_B + ra_off; const LAS unsigned char* lb = lds + (2 + (buf)) * SG_TILE_B + rb_off; \
        _Pragma("unroll") for (int kk = 0; kk < 2; ++kk) { bf16x8 af[4], bfr[2]; const int co = (((4 * kk + fq) ^ sw) << 4); \
            _Pragma("unroll") for (int m = 0; m < 4; ++m) af[m] = *(const LAS bf16x8*)(la + m * 2048 + co); \
            _Pragma("unroll") for (int n = 0; n < 2; ++n) bfr[n] = *(const LAS bf16x8*)(lb + n * 2048 + co); \
            _Pragma("unroll") for (int m = 0; m < 4; ++m) _Pragma("unroll") for (int n = 0; n < 2; ++n) acc[m][n] = __builtin_amdgcn_mfma_f32_16x16x32_bf16(bfr[n], af[m], acc[m][n], 0, 0, 0); } } while (0)
    SG_GLOAD(0, 0);
    if (nt > 1) SG_GLOAD(1, 1);
    if (nt > 2) SG_GLOAD(2, 2);
    if (nt > 3) SG_GLOAD(3, 3);
    SG_LSTORE(0, 0);
    __syncthreads();
    for (int t = 0; t < nt; t += 4) {
#pragma unroll
        for (int q = 0; q < 4; ++q) {
            if (t + q < nt) {
                if (t + q + 4 < nt) SG_GLOAD(q, t + q + 4);
                SG_COMPUTE(q & 1);
                if (t + q + 1 < nt) SG_LSTORE((q + 1) & 3, (q + 1) & 1);
                __syncthreads();
            }
        }
    }
#undef SG_GLOAD
#undef SG_LSTORE
#undef SG_COMPUTE
    epi(acc, wr, wc, fr, fq);
    __syncthreads();
}

namespace g8 {
constexpr int BM = 256, BK = 64, HALF = 128, HTB = HALF * BK * 2, STAGE_BYTES = 8 * HTB;
__device__ __forceinline__ int lds_byte(int r, int c) { const int st = (r >> 4) * 2 + (c >> 5), rr = r & 15, cc = c & 31, ob = rr * 64 + cc * 2; return st * 1024 + (ob ^ (((ob >> 9) & 1) << 5)); }
__device__ __forceinline__ void stage_rc(int b, int& R, int& C) { const int st = b / 1024, sb = b % 1024, swz = sb ^ (((sb >> 9) & 1) << 5); R = (st >> 1) * 16 + swz / 64; C = (st & 1) * 32 + (swz % 64) / 2; }
__device__ __forceinline__ int perm32(int rho) { const int n = rho >> 4, i = rho & 15; return 8 * (i >> 2) + 4 * n + (i & 3); }
struct Unit { const char* A; const char* B; int r0, c0, x; };
template <class Epi, class Sched, bool GATHER = false>
__device__ __forceinline__ void gemm_phase(LAS unsigned char* lds, const int K, const unsigned lda, const unsigned ldb, const Sched& S, const Epi& E, const int tid, const LAS int* srow = nullptr) {
    const int wid = __builtin_amdgcn_readfirstlane(tid >> 6), lane = tid & 63, wr = wid >> 2, wc = wid & 3, fr = lane & 15, fq = lane >> 4;
    const int nt = K / BK;
    unsigned voffA[2], voffB[2], vA1[2], nA0[2], nA1[2]; int gR[2]; unsigned gC[2];
#pragma unroll
    for (int i = 0; i < 2; ++i) { int R, Cc; stage_rc(tid * 16 + i * 8192, R, Cc); const int Rb = Epi::PERM ? ((R & ~31) + perm32(R & 31)) : R;
        voffA[i] = (unsigned)R * lda + (unsigned)Cc * 2u; voffB[i] = (unsigned)Rb * ldb + (unsigned)Cc * 2u; gR[i] = R; gC[i] = (unsigned)Cc * 2u; vA1[i] = voffA[i]; nA0[i] = voffA[i]; nA1[i] = voffA[i]; }
    if constexpr (GATHER) {
#pragma unroll
        for (int i = 0; i < 2; ++i) { voffA[i] = (unsigned)srow[gR[i]] * lda + gC[i]; vA1[i] = (unsigned)srow[128 + gR[i]] * lda + gC[i]; }
    }
    const size_t kstep = (size_t)(BK * 2);
    const size_t hstepA = GATHER ? (size_t)0 : (size_t)HALF * lda, hstepB = (size_t)HALF * ldb;
    const unsigned ldsw = (unsigned)wid * 1024u;
    const int aoff = lds_byte(wr * 64 + fr, fq * 8), boff = lds_byte(wc * 32 + fr, fq * 8);
#define PG8_SA(b, h) (((b) * 2 + (h)) * HTB)
#define PG8_SB(b, h) ((4 + (b) * 2 + (h)) * HTB)
#define PG8_STAGE(bufoff, gbase, voff) do { _Pragma("unroll") for (int _i = 0; _i < 2; ++_i) \
        __builtin_amdgcn_global_load_lds((const unsigned*)((const char*)(gbase) + (voff)[_i]), (LAS unsigned*)(lds + (bufoff) + ldsw + _i * 8192), 16, 0, 0); } while (0)
#define PG8_LDA(dst, b, h) do { _Pragma("unroll") for (int m = 0; m < 4; ++m) _Pragma("unroll") for (int k = 0; k < 2; ++k) dst[m][k] = *(const LAS bf16x8*)(lds + PG8_SA(b, h) + aoff + m * 2048 + k * 1024); } while (0)
#define PG8_LDB(dst, b, h) do { _Pragma("unroll") for (int n = 0; n < 2; ++n) _Pragma("unroll") for (int k = 0; k < 2; ++k) dst[n][k] = *(const LAS bf16x8*)(lds + PG8_SB(b, h) + boff + n * 2048 + k * 1024); } while (0)
#define PG8_MMA(ai, bj, At, Bt) do { __builtin_amdgcn_s_setprio(1); _Pragma("unroll") for (int m = 0; m < 4; ++m) _Pragma("unroll") for (int n = 0; n < 2; ++n) _Pragma("unroll") for (int k = 0; k < 2; ++k) \
        acc[ai][bj][m][n] = __builtin_amdgcn_mfma_f32_16x16x32_bf16(Bt[n][k], At[m][k], acc[ai][bj][m][n], 0, 0, 0); __builtin_amdgcn_s_setprio(0); } while (0)
#define PG8_WAIT_V(n) asm volatile("s_waitcnt vmcnt(" #n ")" ::: "memory")
#define PG8_WAIT_L(n) asm volatile("s_waitcnt lgkmcnt(" #n ")" ::: "memory")
#define PG8_BAR __builtin_amdgcn_s_barrier()
#define PG8_SCHED __builtin_amdgcn_sched_barrier(0)
    Unit cur, nxt; int ui = 0;
    if (!S.next(0, cur)) return;
    f32x4 acc[2][2][4][2];
#pragma unroll
    for (int a = 0; a < 2; ++a)
#pragma unroll
        for (int b = 0; b < 2; ++b)
#pragma unroll
            for (int m = 0; m < 4; ++m)
#pragma unroll
                for (int n = 0; n < 2; ++n) acc[a][b][m][n] = (f32x4){0.f, 0.f, 0.f, 0.f};
    bf16x8 At[4][2], B0[2][2], B1[2][2];
    const char* cA = cur.A; const char* cB = cur.B;
    PG8_STAGE(PG8_SB(0, 0), cB, voffB); PG8_STAGE(PG8_SB(0, 1), cB + hstepB, voffB); PG8_STAGE(PG8_SA(0, 0), cA, voffA); PG8_STAGE(PG8_SA(0, 1), cA + hstepA, vA1);
    if (wr == 1) PG8_BAR;
    PG8_WAIT_V(2); PG8_BAR;
    PG8_STAGE(PG8_SB(1, 0), cB + kstep, voffB); PG8_STAGE(PG8_SA(1, 0), cA + kstep, voffA); PG8_STAGE(PG8_SB(1, 1), cB + hstepB + kstep, voffB);
    PG8_WAIT_V(6); PG8_BAR;
    for (;;) {
        const bool has_next = S.next(ui + 1, nxt);
        const char* nA = has_next ? nxt.A : cA; const char* nB = has_next ? nxt.B : cB;
        if constexpr (GATHER) {
#pragma unroll
            for (int i = 0; i < 2; ++i) { nA0[i] = has_next ? (unsigned)srow[256 * (ui + 1) + gR[i]] * lda + gC[i] : voffA[i]; nA1[i] = has_next ? (unsigned)srow[256 * (ui + 1) + 128 + gR[i]] * lda + gC[i] : vA1[i]; }
        }
#pragma clang loop unroll(disable)
        for (int t = 0; t < nt; t += 2) {
            const bool last = (t == nt - 2);
            const char* a1 = cA + (size_t)(t + 1) * kstep;
            const char* a2 = last ? nA : cA + (size_t)(t + 2) * kstep; const char* b2 = last ? nB : cB + (size_t)(t + 2) * kstep;
            const char* a3 = a2 + kstep; const char* b3 = b2 + kstep;
            unsigned sA0[2], sA1[2];
#pragma unroll
            for (int i = 0; i < 2; ++i) { sA0[i] = (GATHER && last) ? nA0[i] : voffA[i]; sA1[i] = (GATHER && last) ? nA1[i] : vA1[i]; }
            PG8_LDB(B0, 0, 0); PG8_LDB(B1, 0, 1); PG8_SCHED; PG8_LDA(At, 0, 0); PG8_STAGE(PG8_SA(1, 1), a1 + hstepA, vA1);
            PG8_WAIT_V(8); PG8_WAIT_L(0); PG8_BAR; PG8_MMA(0, 0, At, B0); PG8_MMA(0, 1, At, B1); PG8_BAR; PG8_SCHED;
            PG8_LDA(At, 0, 1); PG8_STAGE(PG8_SB(0, 0), b2, voffB); PG8_STAGE(PG8_SB(0, 1), b2 + hstepB, voffB); PG8_STAGE(PG8_SA(0, 0), a2, sA0);
            PG8_WAIT_V(8); PG8_WAIT_L(0); PG8_BAR; PG8_MMA(1, 0, At, B0); PG8_MMA(1, 1, At, B1); PG8_BAR; PG8_SCHED;
            PG8_LDB(B0, 1, 0); PG8_LDB(B1, 1, 1); PG8_SCHED; PG8_LDA(At, 1, 0); PG8_STAGE(PG8_SA(0, 1), a2 + hstepA, sA1);
            PG8_WAIT_V(8); PG8_WAIT_L(0); PG8_BAR; PG8_MMA(0, 0, At, B0); PG8_MMA(0, 1, At, B1); PG8_BAR; PG8_SCHED;
            PG8_LDA(At, 1, 1); PG8_STAGE(PG8_SB(1, 0), b3, voffB); PG8_STAGE(PG8_SB(1, 1), b3 + hstepB, voffB); PG8_STAGE(PG8_SA(1, 0), a3, sA0);
            PG8_WAIT_V(8); PG8_WAIT_L(0); PG8_BAR; PG8_MMA(1, 0, At, B0); PG8_MMA(1, 1, At, B1); PG8_BAR; PG8_SCHED;
        }
        if (wr == 0) PG8_BAR;
        E(acc, cur, wr, wc, fr, fq);
        if (!has_next) break;
#pragma unroll
        for (int a = 0; a < 2; ++a)
#pragma unroll
            for (int b = 0; b < 2; ++b)
#pragma unroll
                for (int m = 0; m < 4; ++m)
#pragma unroll
                    for (int n = 0; n < 2; ++n) acc[a][b][m][n] = (f32x4){0.f, 0.f, 0.f, 0.f};
        cur = nxt; cA = nA; cB = nB; ++ui;
        if constexpr (GATHER) {
#pragma unroll
            for (int i = 0; i < 2; ++i) { voffA[i] = nA0[i]; vA1[i] = nA1[i]; }
        }
        if (wr == 1) PG8_BAR;
    }
    PG8_WAIT_V(0);
    PG8_BAR;
#undef PG8_SA
#undef PG8_SB
#undef PG8_STAGE
#undef PG8_LDA
#undef PG8_LDB
#undef PG8_MMA
#undef PG8_WAIT_V
#undef PG8_WAIT_L
#undef PG8_BAR
#undef PG8_SCHED
}
}

constexpr int AT_VS = 192;
template <int DK, bool WIN>
__device__ __forceinline__ void attn_unit(const Ctx& C,
        const bf16* qrow0, size_t ldq,
        const bf16* k0, const bf16* v0, int n0t,
        const bf16* k1, const bf16* v1, int n1t,
        size_t ldk, size_t ldv,
        bf16* orow0, size_t ldo,
        int w_lo, int w_hi, int dr0, int qc0, const LAS float* btab) {
    constexpr int KS = DK * 2 + 16;
    constexpr int KBUF = 64 * KS, VBUF = 64 * AT_VS;
    constexpr int KCH = DK / 8;
    constexpr int NS = DK / 16;
    const int tid = C.tid, lane = C.lane, l31 = lane & 31, h = lane >> 5;
    LAS unsigned char* lds = C.lds;
    LAS unsigned char* ldsK = lds; LAS unsigned char* ldsV = lds + 2 * KBUF;
    bf16x8 qf[NS];
#pragma unroll
    for (int s = 0; s < NS; ++s) qf[s] = *(const bf16x8*)(qrow0 + (size_t)l31 * ldq + 16 * s + 8 * h);
    f32x16 O0, O1;
#pragma unroll
    for (int i = 0; i < 16; ++i) { O0[i] = 0.f; O1[i] = 0.f; }
    float mrun = 0.f, lsum = 0.f;
    const int kc0 = tid, kr0 = kc0 / KCH, kk0 = kc0 % KCH;
    const int kc1 = tid + 512, kr1 = kc1 / KCH, kk1 = kc1 % KCH;
    constexpr bool HAS1 = (64 * KCH > 512);
    const bool has1 = HAS1 && (kc1 < 64 * KCH);
    const int vr = tid >> 3, vk = tid & 7;
    const int nt = n0t + n1t;
    u32x4 rk0, rk1, rv;
    auto gload = [&](int j, u32x4& a0, u32x4& a1, u32x4& av) {
        const bf16* kb = (j < n0t) ? k0 + (size_t)j * 64 * ldk : k1 + (size_t)(j - n0t) * 64 * ldk;
        const bf16* vb = (j < n0t) ? v0 + (size_t)j * 64 * ldv : v1 + (size_t)(j - n0t) * 64 * ldv;
        a0 = *(const u32x4*)(kb + (size_t)kr0 * ldk + kk0 * 8);
        if constexpr (HAS1) { if (has1) a1 = *(const u32x4*)(kb + (size_t)kr1 * ldk + kk1 * 8); }
        av = *(const u32x4*)(vb + (size_t)vr * ldv + vk * 8);
    };
    auto lstore = [&](int b, int vb3, const u32x4& a0, const u32x4& a1, const u32x4& av) {
        *(LAS u32x4*)(ldsK + b * KBUF + kr0 * KS + kk0 * 16) = a0;
        if constexpr (HAS1) { if (has1) *(LAS u32x4*)(ldsK + b * KBUF + kr1 * KS + kk1 * 16) = a1; }
        *(LAS u32x4*)(ldsV + vb3 * VBUF + vr * AT_VS + vk * 16) = av;
    };
    gload(0, rk0, rk1, rv);
    lstore(0, 0, rk0, rk1, rv);
    __syncthreads();
    const int trb = (4 * h + ((lane & 15) >> 2)) * AT_VS + (16 * ((lane >> 4) & 1) + 4 * (lane & 3)) * 2;
    int cq = qc0 + l31; asm volatile("" : "+v"(cq));
    int c0w = cq - 8; c0w = c0w < 0 ? 0 : (c0w > 48 ? 48 : c0w);
    const int mbase = 4 * h - c0w, bbase = 4 * h - cq + 15;
    const bool grpB = C.wave >= 4;
    union VF { bf16x8 v; s16x4 hlf[2]; };
    unsigned pfk[2][2][4];
#pragma unroll
    for (int a_ = 0; a_ < 2; ++a_)
#pragma unroll
        for (int b_ = 0; b_ < 2; ++b_)
#pragma unroll
            for (int c_ = 0; c_ < 4; ++c_) pfk[a_][b_][c_] = 0u;
    bool pend = false; int pend_vb = 0;
    auto vread = [&](int vbuf, VF (&vfr)[2][2][2]) {
        const LAS unsigned char* vb = ldsV + vbuf * VBUF + trb;
#pragma unroll
        for (int kb3 = 0; kb3 < 2; ++kb3)
#pragma unroll
            for (int s2 = 0; s2 < 2; ++s2)
#pragma unroll
                for (int db = 0; db < 2; ++db) { const int rowoff = (32 * kb3 + 16 * s2) * AT_VS;
                    vfr[kb3][s2][db].hlf[0] = __builtin_amdgcn_ds_read_tr16_b64_v4i16((LAS s16x4*)(vb + rowoff + db * 64));
                    vfr[kb3][s2][db].hlf[1] = __builtin_amdgcn_ds_read_tr16_b64_v4i16((LAS s16x4*)(vb + rowoff + 8 * AT_VS + db * 64)); }
    };
    auto pvmma = [&](const VF (&vfr)[2][2][2]) {
#pragma unroll
        for (int kb3 = 0; kb3 < 2; ++kb3)
#pragma unroll
            for (int s2 = 0; s2 < 2; ++s2) {
                union { bf16x8 v; unsigned u[4]; } pf;
#pragma unroll
                for (int q = 0; q < 4; ++q) pf.u[q] = pfk[kb3][s2][q];
                O0 = __builtin_amdgcn_mfma_f32_32x32x16_bf16(vfr[kb3][s2][0].v, pf.v, O0, 0, 0, 0);
                O1 = __builtin_amdgcn_mfma_f32_32x32x16_bf16(vfr[kb3][s2][1].v, pf.v, O1, 0, 0, 0);
            }
    };
    int vcur = 0;
    for (int j = 0; j < nt; ++j) {
        const int cur = j & 1; const int vnxt = (vcur == 2) ? 0 : vcur + 1;
        if (j + 1 < nt) gload(j + 1, rk0, rk1, rv);
        const bool act = !WIN || j < n0t || ((j - n0t) >= w_lo && (j - n0t) < w_hi);
        if (grpB && pend) { VF vfr[2][2][2]; vread(pend_vb, vfr); __builtin_amdgcn_sched_barrier(0); pvmma(vfr); pend = false; }
        if (act) {
            f32x16 S0, S1;
            const float nm = -mrun;
#pragma unroll
            for (int i = 0; i < 16; ++i) { S0[i] = nm; S1[i] = nm; }
            const LAS unsigned char* kb = ldsK + cur * KBUF + l31 * KS + 16 * h;
#pragma unroll
            for (int hs = 0; hs < 2; ++hs) {
                bf16x8 kfa[NS / 2], kfb[NS / 2];
#pragma unroll
                for (int s = 0; s < NS / 2; ++s) { kfa[s] = *(const LAS bf16x8*)(kb + 32 * (hs * (NS / 2) + s)); kfb[s] = *(const LAS bf16x8*)(kb + 32 * KS + 32 * (hs * (NS / 2) + s)); }
                __builtin_amdgcn_sched_barrier(0);
#pragma unroll
                for (int s = 0; s < NS / 2; ++s) {
                    S0 = __builtin_amdgcn_mfma_f32_32x32x16_bf16(kfa[s], qf[hs * (NS / 2) + s], S0, 0, 0, 0);
                    S1 = __builtin_amdgcn_mfma_f32_32x32x16_bf16(kfb[s], qf[hs * (NS / 2) + s], S1, 0, 0, 0);
                }
                __builtin_amdgcn_sched_barrier(0);
            }
            VF vfa[2][2][2];
            if (!grpB) { vread(vcur, vfa); __builtin_amdgcn_sched_barrier(0); }
            if (WIN && j >= n0t) {
                int mb = mbase; asm volatile("" : "+v"(mb));
                const LAS float* bt = btab + ((j - n0t) + dr0) * 31 + bbase;
#pragma unroll
                for (int i = 0; i < 16; ++i) {
                    const int kci = (i & 3) + 8 * (i >> 2);
                    S0[i] = ((unsigned)(kci + mb) < 16u) ? S0[i] + bt[kci] : -1e30f;
                    S1[i] = ((unsigned)(kci + 32 + mb) < 16u) ? S1[i] + bt[kci + 32] : -1e30f;
                }
            }
            float mx = fmaxf(S0[0], S1[0]);
#pragma unroll
            for (int i = 1; i < 16; ++i) mx = fmaxf(mx, fmaxf(S0[i], S1[i]));
            mx = fmaxf(mx, __shfl_xor(mx, 32));
            if (__any(mx > 8.0f)) {
                const float dl = fmaxf(mx, 0.f), alpha = fast_exp2(-dl);
                mrun += dl; lsum *= alpha;
#pragma unroll
                for (int i = 0; i < 16; ++i) { S0[i] -= dl; S1[i] -= dl; O0[i] *= alpha; O1[i] *= alpha; }
            }
            float ps = 0.f;
#pragma unroll
            for (int i = 0; i < 16; ++i) { S0[i] = fast_exp2(S0[i]); S1[i] = fast_exp2(S1[i]); ps += S0[i] + S1[i]; }
            lsum += ps;
#pragma unroll
            for (int s2 = 0; s2 < 2; ++s2)
#pragma unroll
                for (int q = 0; q < 4; ++q) { pfk[0][s2][q] = cvt_pk_bf16(S0[8 * s2 + 2 * q], S0[8 * s2 + 2 * q + 1]); pfk[1][s2][q] = cvt_pk_bf16(S1[8 * s2 + 2 * q], S1[8 * s2 + 2 * q + 1]); }
            if (!grpB) pvmma(vfa); else { pend = true; pend_vb = vcur; }
        }
        if (j + 1 < nt) lstore(cur ^ 1, vnxt, rk0, rk1, rv);
        __syncthreads();
        vcur = vnxt;
    }
    if (grpB && pend) { VF vfr[2][2][2]; vread(pend_vb, vfr); pvmma(vfr); }
    const float ltot = lsum + __shfl_xor(lsum, 32);
    const float inv = 1.0f / ltot;
    bf16* op = orow0 + (size_t)l31 * ldo + 4 * h;
#pragma unroll
    for (int g = 0; g < 4; ++g) {
        u32x2 w0, w1;
        w0.x = cvt_pk_bf16(O0[4 * g] * inv, O0[4 * g + 1] * inv); w0.y = cvt_pk_bf16(O0[4 * g + 2] * inv, O0[4 * g + 3] * inv);
        w1.x = cvt_pk_bf16(O1[4 * g] * inv, O1[4 * g + 1] * inv); w1.y = cvt_pk_bf16(O1[4 * g + 2] * inv, O1[4 * g + 3] * inv);
        *(u32x2*)(op + 8 * g) = w0;
        *(u32x2*)(op + 32 + 8 * g) = w1;
    }
}

template <class RM>
__device__ __forceinline__ void tconv64(const float* W, size_t ldw, int k0, int n0, int N, const float* kscale, RM rm, int lane) {
    const int q = lane >> 4, c = lane & 15, ncol = n0 + 4 * c;
    if (ncol >= N) return;
    const float* src = W + (size_t)(k0 + 16 * q) * ldw + ncol;
    f32x4 v[16];
#pragma unroll
    for (int i = 0; i < 16; ++i) v[i] = __builtin_nontemporal_load((const f32x4*)(src + (size_t)i * ldw));
    if (kscale) {
#pragma unroll
        for (int i = 0; i < 16; ++i) v[i] = v[i] * kscale[k0 + 16 * q + i];
    }
#pragma unroll
    for (int j = 0; j < 4; ++j) {
        float cs; bf16* dst = rm(ncol + j, cs);
        u32x4 o0, o1;
        o0.x = cvt_pk_bf16(v[0][j] * cs, v[1][j] * cs); o0.y = cvt_pk_bf16(v[2][j] * cs, v[3][j] * cs); o0.z = cvt_pk_bf16(v[4][j] * cs, v[5][j] * cs); o0.w = cvt_pk_bf16(v[6][j] * cs, v[7][j] * cs);
        o1.x = cvt_pk_bf16(v[8][j] * cs, v[9][j] * cs); o1.y = cvt_pk_bf16(v[10][j] * cs, v[11][j] * cs); o1.z = cvt_pk_bf16(v[12][j] * cs, v[13][j] * cs); o1.w = cvt_pk_bf16(v[14][j] * cs, v[15][j] * cs);
        *(u32x4*)(dst + k0 + 16 * q) = o0; *(u32x4*)(dst + k0 + 16 * q + 8) = o1;
    }
}
__device__ __forceinline__ void conv_gu_item(const Ctx& C, int L, int idx) {
    const int le = L * NE + (idx >> 9), t = idx & 511, kb = t >> 5, nb = t & 31;
    bf16* wgu = WSP(bf16, WS_WGU) + (size_t)le * 4096 * D;
    { auto rm = [=](int n, float& cs) -> bf16* { cs = 1.0f; return wgu + (size_t)(256 * (n >> 7) + (n & 127)) * D; };
      tconv64(C.in[I_WGATE] + (size_t)le * D * FF, FF, kb * 64, nb * 64, FF, nullptr, rm, C.lane); }
    { auto rm = [=](int n, float& cs) -> bf16* { cs = 1.0f; return wgu + (size_t)(256 * (n >> 7) + 128 + (n & 127)) * D; };
      tconv64(C.in[I_WUP] + (size_t)le * D * FF, FF, kb * 64, nb * 64, FF, nullptr, rm, C.lane); }
}
__device__ __forceinline__ void conv_dn_item(const Ctx& C, int L, int idx) {
    const int le = L * NE + (idx >> 9), t = idx & 511, kb = t >> 4, nb = t & 15;
    bf16* wd = WSP(bf16, WS_WD) + (size_t)le * D * FF;
    auto rm = [=](int n, float& cs) -> bf16* { cs = 1.0f; return wd + (size_t)n * FF; };
    tconv64(C.in[I_WDOWN] + (size_t)le * FF * D, D, kb * 64, nb * 64, D, nullptr, rm, C.lane);
}
constexpr int GU_C2_CNT = 3, GU_C2_FIRST = 0, GU_D_CNT = 1, GU_D_FIRST = 128 * 8 * GU_C2_CNT, GU_F_CNT = 1, GU_F_FIRST = GU_D_FIRST + 128 * 8 * GU_D_CNT, GU_SLOT_END = GU_F_FIRST + 128 * 8 * GU_F_CNT;
constexpr int DN_C1_CNT = 2, DN_C1_FIRST = 0, DN_E_CNT = 2, DN_E_FIRST = 128 * 8 * DN_C1_CNT, DN_I_CNT = 2, DN_I_FIRST = DN_E_FIRST + 192 * 8 * DN_E_CNT, DN_SLOT_END = DN_I_FIRST + 192 * 8 * DN_I_CNT;
static_assert(GU_SLOT_END <= 8192 && DN_SLOT_END <= 8192, "slot ranges");
__device__ __forceinline__ void slot_gu(const Ctx& C, int L, int pb, int first, int cnt) {
    for (int i = 0; i < cnt; ++i) { const int idx = first + (pb * 8 + C.wave) * cnt + i; if (idx < GU_SLOT_END) conv_gu_item(C, L, idx); }
}
__device__ __forceinline__ void slot_dn(const Ctx& C, int L, int pb, int first, int cnt) {
    for (int i = 0; i < cnt; ++i) { const int idx = first + (pb * 8 + C.wave) * cnt + i; if (idx < DN_SLOT_END) conv_dn_item(C, L, idx); }
}
__device__ __forceinline__ void phase_prep(const Ctx& C) {
    const int tid = C.tid, lane = C.lane;
    const size_t gtid = (size_t)C.bid * 512 + tid, gth = (size_t)C.G * 512;
    { bf16* afft = WSP(bf16, WS_AFFT); const float sc = 0.0027621358640099515f;
      for (size_t i = gtid; i < (size_t)2048 * 2048; i += gth) { const int k1 = (int)(i >> 11), j = (int)(i & 2047), n1 = j & 1023; const int m = (k1 * n1) & 2047;
          const float x = (float)m * (1.0f / 1024.0f); float v = (j < 1024) ? cospif(x) : -sinpif(x); if (j == 0) v = 0.5f; if (j == 1024) v = (k1 & 1) ? -1.0f : 1.0f;
          afft[i] = (bf16)(cvt_pk_bf16(v * sc, 0.f) & 0xffff); }
      bf16* afc = WSP(bf16, WS_AFFTC); const float scc = 0.0078125f;
      for (size_t i = gtid; i < (size_t)256 * 256; i += gth) { const int k1 = (int)(i >> 8), j = (int)(i & 255), n1 = j & 127; const int m = (k1 * n1) & 255;
          const float x = (float)m * (1.0f / 128.0f); float v = (j < 128) ? cospif(x) : -sinpif(x); if (j == 0) v = 0.5f; if (j == 128) v = (k1 & 1) ? -1.0f : 1.0f;
          afc[i] = (bf16)(cvt_pk_bf16(v * scc, 0.f) & 0xffff); }
      bf16* t64 = WSP(bf16, WS_T64);
      for (size_t i = gtid; i < 128 * 128; i += gth) { const int mrow = (int)(i >> 7), kk = (int)(i & 127), n2 = kk & 63, k2 = mrow & 63; const int m = (k2 * n2) & 63;
          const float x = (float)m * (1.0f / 32.0f); const float v = (mrow < 64) ? cospif(x) : ((kk < 64) ? sinpif(x) : -sinpif(x)); t64[i] = (bf16)(cvt_pk_bf16(v, 0.f) & 0xffff); }
      float* rope = WSP(float, WS_ROPE);
      for (size_t i = gtid; i < 2048 * 16; i += gth) { const int t = (int)(i >> 4), f = (int)(i & 15); const float pos = (f < 8) ? (float)(t >> 6) : (float)(t & 63);
          const float inv = powf(10000.0f, -(float)(f & 7) / 8.0f); const float ang = pos * inv; rope[2 * i] = cosf(ang); rope[2 * i + 1] = sinf(ang); }
      bf16* win = WSP(bf16, WS_WIN);
      for (size_t i = gtid; i < (size_t)DEPTH * 96 * 1024 / 8; i += gth) { const size_t l = i / (96 * 128), r = i % (96 * 128); *(u32x4*)(win + (l * NZ + ZEND) * D + r * 8) = (u32x4){0u, 0u, 0u, 0u}; }
    }
    {
        LAS float* sl = (LAS float*)(C.lds);
        LAS float* red = (LAS float*)(C.lds + 9 * 1024 * 4);
        for (int i = tid; i < 9 * 1024; i += 512) { const int r = i >> 10, k = i & 1023; const float v = (r < 8) ? C.in[I_C][r * 1024 + k] : C.in[I_CCTX][k]; sl[i] = silu_f(v); }
        __syncthreads();
        const int c32 = tid & 31, kg = tid >> 5;
        for (int it = C.bid; it < DEPTH * 192; it += C.G) {
            const int l = it / 192, n0 = (it % 192) * 32;
            const float* wm = C.in[I_WMOD] + (size_t)l * 1024 * 6144 + n0 + c32;
            float a[9];
#pragma unroll
            for (int r = 0; r < 9; ++r) a[r] = 0.f;
            for (int kk = 0; kk < 64; ++kk) { const int k = kg * 64 + kk; const float w = wm[(size_t)k * 6144];
#pragma unroll
                for (int r = 0; r < 9; ++r) a[r] += sl[r * 1024 + k] * w; }
#pragma unroll
            for (int r = 0; r < 9; ++r) red[(kg * 9 + r) * 32 + c32] = a[r];
            __syncthreads();
            if (tid < 288) { const int r = tid >> 5; float s = 0.f;
#pragma unroll
                for (int g = 0; g < 16; ++g) s += red[(g * 9 + r) * 32 + c32];
                WSP(float, WS_MOD)[((size_t)l * 9 + r) * 6144 + n0 + c32] = s + C.in[I_BMOD][l * 6144 + n0 + c32]; }
            __syncthreads();
        }
    }
    {
        for (size_t i = gtid; i < (size_t)DEPTH * 4 * 1024; i += gth) {
            const int l = (int)(i >> 12), g = (int)((i >> 10) & 3), d = (int)(i & 1023);
            const float* wb = C.in[I_WBR] + (((size_t)l * 4 + 1) * 256 + g * 64) * 1024 + d;
            const float* pw = C.in[I_POOLW] + ((size_t)l * 4 + g) * 64 * 64;
            const float* ps = C.in[I_POOLS] + l * 256 + g * 64;
            float wv[64];
#pragma unroll
            for (int c2 = 0; c2 < 64; ++c2) wv[c2] = wb[(size_t)c2 * 1024] * ps[c2];
            bf16* dst = WSP(bf16, WS_WB) + (((size_t)l * 4 + 1) * 1024 + d) * 256 + g * 64;
#pragma unroll 1
            for (int c8 = 0; c8 < 8; ++c8) {
                float o[8];
#pragma unroll
                for (int cc = 0; cc < 8; ++cc) { float s = 0.f; const float* pr = pw + (c8 * 8 + cc) * 64;
#pragma unroll
                    for (int c2 = 0; c2 < 64; ++c2) s += pr[c2] * wv[c2];
                    o[cc] = s; }
                u32x4 w; w.x = cvt_pk_bf16(o[0], o[1]); w.y = cvt_pk_bf16(o[2], o[3]); w.z = cvt_pk_bf16(o[4], o[5]); w.w = cvt_pk_bf16(o[6], o[7]);
                *(u32x4*)(dst + c8 * 8) = w;
            }
        }
    }
    {
        const int gw = C.bid * 8 + C.wave, NGW = C.G * 8;
        for (int it = gw; it < DEPTH * 16 * 91; it += NGW) {
            const int l = it / (16 * 91), t = it - l * (16 * 91), kb = t / 91, nb = t - kb * 91;
            bf16* win = WSP(bf16, WS_WIN) + (size_t)l * NZ * D; bf16* wg = WSP(bf16, WS_WG) + (size_t)l * 4096 * D;
            auto rm = [=](int n, float& cs) -> bf16* { cs = (n < 256) ? NA_QS : 1.0f; if (n < ZEND) return win + (size_t)n * D;
                const int g = n - ZEND, br = g >> 10, d = g & 1023, pn = d >> 6, ch = d & 63;
                const int row = 256 * pn + 128 * (br >> 1) + 32 * (ch >> 4) + 16 * (br & 1) + (ch & 15);
                return wg + (size_t)row * D; };
            tconv64(C.in[I_WIN] + (size_t)l * D * IN_COLS, IN_COLS, kb * 64, nb * 64, IN_COLS, nullptr, rm, C.lane);
        }
        for (int it = gw; it < DEPTH * 256; it += NGW) {
            const int l = it >> 8, t = it & 255, kb = t >> 4, nb = t & 15;
            bf16* w = WSP(bf16, WS_WO) + (size_t)l * D * D; auto rm = [=](int n, float& cs) -> bf16* { cs = 1.0f; return w + (size_t)n * D; };
            tconv64(C.in[I_WOUT] + (size_t)l * D * D, D, kb * 64, nb * 64, D, nullptr, rm, C.lane);
        }
        for (int it = gw; it < DEPTH * 4 * 64; it += NGW) {
            const int ln = it >> 6, t = it & 63, kb = t >> 4, nb = t & 15;
            if ((ln & 3) == 1) continue;
            bf16* w = WSP(bf16, WS_WB) + (size_t)ln * 1024 * 256; auto rm = [=](int n, float& cs) -> bf16* { cs = 1.0f; return w + (size_t)n * 256; };
            tconv64(C.in[I_WBR] + (size_t)ln * 256 * 1024, 1024, kb * 64, nb * 64, 1024, nullptr, rm, C.lane);
        }
        for (int it = gw; it < DEPTH * 24; it += NGW) {
            const int l = it / 24, t = it - l * 24, kb = t / 6, nb = t - kb * 6;
            bf16* w = WSP(bf16, WS_WUQ) + (size_t)l * 384 * 256; auto rm = [=](int n, float& cs) -> bf16* { cs = 1.0f; return w + (size_t)n * 256; };
            tconv64(C.in[I_WUQ] + (size_t)l * 256 * 384, 384, kb * 64, nb * 64, 384, C.in[I_QNORM] + l * 256, rm, C.lane);
        }
        for (int it = gw; it < DEPTH * 16; it += NGW) {
            const int l = it >> 4, t = it & 15, kb = t >> 3, nb = t & 7;
            bf16* w = WSP(bf16, WS_WUKV) + (size_t)l * 512 * 128; auto rm = [=](int n, float& cs) -> bf16* { cs = 1.0f; return w + (size_t)n * 128; };
            tconv64(C.in[I_WUKV] + (size_t)l * 128 * 512, 512, kb * 64, nb * 64, 512, C.in[I_KVNORM] + l * 128, rm, C.lane);
        }
    }
    {
        const int gw = C.bid * 8 + C.wave, NGW = C.G * 8;
        for (int it = gw; it < 8192; it += NGW) conv_gu_item(C, 0, it);
        for (int it = gw; it < 8192; it += NGW) conv_dn_item(C, 0, it);
        constexpr int GU_REST = 8192 - GU_SLOT_END, DN_REST = 8192 - DN_SLOT_END;
        for (int it = gw; it < 3 * GU_REST; it += NGW) conv_gu_item(C, 1 + it / GU_REST, GU_SLOT_END + it % GU_REST);
        if (DN_REST > 0) for (int it = gw; it < 3 * DN_REST; it += NGW) conv_dn_item(C, 1 + it / (DN_REST > 0 ? DN_REST : 1), DN_SLOT_END + it % (DN_REST > 0 ? DN_REST : 1));
    }
}

__device__ __forceinline__ void phase_init(const Ctx& C) {
    const int gw = C.bid * 8 + C.wave, NGW = C.G * 8, lane = C.lane;
    const float* mod = WSP(float, WS_MOD);
    for (int row = gw; row < T; row += NGW) {
        const float* src = (row < TL) ? C.in[I_X] + (size_t)row * D : C.in[I_CTX] + (size_t)(row - TL) * D;
        const float* mr = mod + (size_t)mod_row(row) * 6144;
        float* hd = WSP(float, WS_H) + (size_t)row * D; bf16* ud = WSP(bf16, WS_U1) + (size_t)row * D;
#pragma unroll
        for (int j = 0; j < 4; ++j) { const int c = 4 * lane + 256 * j; const f32x4 v = *(const f32x4*)(src + c); const f32x4 sh = *(const f32x4*)(mr + c), sc = *(const f32x4*)(mr + 1024 + c);
            *(f32x4*)(hd + c) = v; const f32x4 u = v * (sc + 1.0f) + sh; u32x2 w; w.x = cvt_pk_bf16(u[0], u[1]); w.y = cvt_pk_bf16(u[2], u[3]); *(u32x2*)(ud + c) = w; }
    }
}


__device__ __forceinline__ int unit_index(int i, int G, int c, int nunits) {
    const int full = nunits / G;
    if (i < full) return i * G + c;
    if (i > full) return -1;
    const int R = nunits - full * G; if (R == 0) return -1;
    const int cpx = G >> 3, per = (R + 7) >> 3, x = c / cpx, k = c - x * cpx, r = x * per + k;
    return (k < per && r < R) ? full * G + r : -1;
}
__device__ __forceinline__ int blk_x(const Ctx& C) { return C.bid / (C.G >> 3); }
__device__ __forceinline__ int blk_k(const Ctx& C) { return C.bid % (C.G >> 3); }
struct SchedDense {
    const char* A; const char* B; size_t lda, ldb; int nunits, G, c, nN;
    __device__ __forceinline__ bool next(int i, g8::Unit& u) const { const int L = unit_index(i, G, c, nunits); if (L < 0) return false; const int pm = L / nN, pn = L - pm * nN;
        u.A = A + (size_t)pm * 256 * lda; u.B = B + (size_t)pn * 256 * ldb; u.r0 = pm * 256; u.c0 = pn * 256; u.x = 0; return true; }
};
struct SchedGroup {
    const char* A; const char* B; size_t lda, ldb, bstride; int nunits, G, c, nN, per;
    __device__ __forceinline__ bool next(int i, g8::Unit& u) const { const int L = unit_index(i, G, c, nunits); if (L < 0) return false; const int e = L / per, r = L - e * per, pm = r / nN, pn = r - pm * nN;
        u.A = A + ((size_t)e * ESLOT + pm * 256) * lda; u.B = B + (size_t)e * bstride + (size_t)pn * 256 * ldb; u.r0 = e * ESLOT + pm * 256; u.c0 = pn * 256; u.x = e; return true; }
};
struct SchedC1 {
    const char* Y; const char* W; int nunits, G, c;
    __device__ __forceinline__ bool next(int i, g8::Unit& u) const { const int L = unit_index(i, G, c, nunits); if (L < 0) return false; const int pm = L >> 4, nb = (L >> 2) & 3, pn = L & 3;
        u.A = Y + ((size_t)nb * T + pm * 256) * 512; u.B = W + ((size_t)nb * 1024 + pn * 256) * 512; u.r0 = pm * 256; u.c0 = nb * 1024 + pn * 256; u.x = 0; return true; }
};
struct EpiStoreBf16 {
    static constexpr bool PERM = true; bf16* O; size_t ldc;
    __device__ __forceinline__ void operator()(const f32x4 (&acc)[2][2][4][2], const g8::Unit& u, int wr, int wc, int fr, int fq) const {
        bf16* base = O + (size_t)(u.r0 + wr * 64 + fr) * ldc + u.c0 + wc * 32 + 8 * fq;
#pragma unroll
        for (int ai = 0; ai < 2; ++ai)
#pragma unroll
            for (int m = 0; m < 4; ++m) { bf16* rowp = base + (size_t)(ai * 128 + m * 16) * ldc;
#pragma unroll
                for (int bj = 0; bj < 2; ++bj) { const f32x4 v0 = acc[ai][bj][m][0], v1 = acc[ai][bj][m][1];
                    u32x4 w; w.x = cvt_pk_bf16(v0[0], v0[1]); w.y = cvt_pk_bf16(v0[2], v0[3]); w.z = cvt_pk_bf16(v1[0], v1[1]); w.w = cvt_pk_bf16(v1[2], v1[3]); *(u32x4*)(rowp + bj * 128) = w; } }
    }
};
struct EpiSwiGLU {
    static constexpr bool PERM = true; bf16* O;
    __device__ __forceinline__ void operator()(const f32x4 (&acc)[2][2][4][2], const g8::Unit& u, int wr, int wc, int fr, int fq) const {
        bf16* base = O + (size_t)(u.r0 + wr * 64 + fr) * FF + (u.c0 >> 1) + wc * 32 + 8 * fq;
#pragma unroll
        for (int ai = 0; ai < 2; ++ai)
#pragma unroll
            for (int m = 0; m < 4; ++m) { float h[8];
#pragma unroll
                for (int n = 0; n < 2; ++n)
#pragma unroll
                    for (int j = 0; j < 4; ++j) { const float a = acc[ai][0][m][n][j], b = acc[ai][1][m][n][j]; h[4 * n + j] = a * __builtin_amdgcn_rcpf(1.0f + fast_exp2(-a * LOG2E)) * b; }
                u32x4 w; w.x = cvt_pk_bf16(h[0], h[1]); w.y = cvt_pk_bf16(h[2], h[3]); w.z = cvt_pk_bf16(h[4], h[5]); w.w = cvt_pk_bf16(h[6], h[7]);
                *(u32x4*)(base + (size_t)(ai * 128 + m * 16) * FF) = w; }
    }
};
struct EpiGateMerge {
    static constexpr bool PERM = false; const bf16* P; bf16* S;
    __device__ __forceinline__ void operator()(const f32x4 (&acc)[2][2][4][2], const g8::Unit& u, int wr, int wc, int fr, int fq) const {
        const int chb = (u.c0 >> 2) + wc * 16 + 4 * fq;
        const bf16* pr0 = P + (size_t)(u.r0 + wr * 64 + fr) * 4096 + chb;
        u32x2 pv[2][4][4];
#pragma unroll
        for (int ai = 0; ai < 2; ++ai)
#pragma unroll
            for (int m = 0; m < 4; ++m)
#pragma unroll
                for (int br = 0; br < 4; ++br) pv[ai][m][br] = *(const u32x2*)(pr0 + (size_t)(ai * 128 + m * 16) * 4096 + br * 1024);
#pragma unroll
        for (int ai = 0; ai < 2; ++ai)
#pragma unroll
            for (int m = 0; m < 4; ++m) { const size_t row = (size_t)(u.r0 + ai * 128 + wr * 64 + m * 16 + fr);
                f32x4 sum = (f32x4){0.f, 0.f, 0.f, 0.f};
#pragma unroll
                for (int bj = 0; bj < 2; ++bj)
#pragma unroll
                    for (int n = 0; n < 2; ++n) { const f32x4 a = acc[ai][bj][m][n]; const u32x2 p = pv[ai][m][2 * bj + n];
                        sum[0] += __builtin_amdgcn_rcpf(1.0f + fast_exp2(-a[0] * LOG2E)) * bflo(p.x); sum[1] += __builtin_amdgcn_rcpf(1.0f + fast_exp2(-a[1] * LOG2E)) * bfhi(p.x);
                        sum[2] += __builtin_amdgcn_rcpf(1.0f + fast_exp2(-a[2] * LOG2E)) * bflo(p.y); sum[3] += __builtin_amdgcn_rcpf(1.0f + fast_exp2(-a[3] * LOG2E)) * bfhi(p.y); }
                u32x2 w; w.x = cvt_pk_bf16(sum[0], sum[1]); w.y = cvt_pk_bf16(sum[2], sum[3]); *(u32x2*)(S + row * D + chb) = w; }
    }
};
struct EpiResid {
    static constexpr bool PERM = false; const float* H; float* X1; const float* mod;
    __device__ __forceinline__ void operator()(const f32x4 (&acc)[2][2][4][2], const g8::Unit& u, int wr, int wc, int fr, int fq) const {
        const int col0 = u.c0 + wc * 32 + 4 * fq;
#pragma unroll
        for (int ai = 0; ai < 2; ++ai)
#pragma unroll
            for (int m = 0; m < 4; ++m) { const int row = u.r0 + ai * 128 + wr * 64 + m * 16 + fr; const float* g1 = mod + (size_t)mod_row(row) * 6144 + 2048; const size_t off = (size_t)row * D;
#pragma unroll
                for (int bj = 0; bj < 2; ++bj)
#pragma unroll
                    for (int n = 0; n < 2; ++n) { const int c = col0 + bj * 128 + n * 16; *(f32x4*)(X1 + off + c) = *(const f32x4*)(H + off + c) * DN_ALPHA + *(const f32x4*)(g1 + c) * acc[ai][bj][m][n]; } }
    }
};
__device__ __forceinline__ void phase_inproj(const Ctx& C, int l) {
    SchedDense S{(const char*)WSP(bf16, WS_U1), (const char*)(WSP(bf16, WS_WIN) + (size_t)l * NZ * D), (size_t)D * 2, (size_t)D * 2, (T / 256) * (NZ / 256), C.G, C.bid, NZ / 256};
    EpiStoreBf16 E{WSP(bf16, WS_Z), (size_t)NZ};
    g8::gemm_phase(C.lds, D, D * 2, D * 2, S, E, C.tid);
}
__device__ __forceinline__ void phase_c1(const Ctx& C, int l, int nrows) {
    SchedC1 S{(const char*)WSP(bf16, WS_Y), (const char*)(WSP(bf16, WS_WB) + (size_t)l * 4 * 1024 * 256), (nrows / 256) * 16, C.G, C.bid};
    EpiStoreBf16 E{WSP(bf16, WS_P), (size_t)4096};
    g8::gemm_phase(C.lds, 256, 512, 512, S, E, C.tid);
}
__device__ __forceinline__ void phase_c2(const Ctx& C, int l, int nrows) {
    SchedDense S{(const char*)WSP(bf16, WS_U1), (const char*)(WSP(bf16, WS_WG) + (size_t)l * 4096 * D), (size_t)D * 2, (size_t)D * 2, (nrows / 256) * 16, C.G, C.bid, 16};
    EpiGateMerge E{WSP(bf16, WS_P), WSP(bf16, WS_S)};
    g8::gemm_phase(C.lds, D, D * 2, D * 2, S, E, C.tid);
}
struct SchedDctx {
    const char* A; const char* B; int G, c;
    __device__ __forceinline__ bool next(int i, g8::Unit& u) const { const int L = unit_index(i, G, c, 128); if (L < 0) return false; const int pm = L >> 4, pn = (L >> 2) & 3, ks = L & 3;
        u.A = A + ((size_t)TL + pm * 256) * (D * 2) + (size_t)ks * 512; u.B = B + (size_t)pn * 256 * (D * 2) + (size_t)ks * 512; u.r0 = ks * TC + pm * 256; u.c0 = pn * 256; u.x = ks; return true; }
};
struct EpiRawF32 {
    static constexpr bool PERM = false; float* O;
    __device__ __forceinline__ void operator()(const f32x4 (&acc)[2][2][4][2], const g8::Unit& u, int wr, int wc, int fr, int fq) const {
        float* base = O + (size_t)(u.r0 + wr * 64 + fr) * D + u.c0 + wc * 32 + 4 * fq;
#pragma unroll
        for (int ai = 0; ai < 2; ++ai)
#pragma unroll
            for (int m = 0; m < 4; ++m)
#pragma unroll
                for (int bj = 0; bj < 2; ++bj)
#pragma unroll
                    for (int n = 0; n < 2; ++n) *(f32x4*)(base + (size_t)(ai * 128 + m * 16) * D + bj * 128 + n * 16) = acc[ai][bj][m][n];
    }
};
__device__ __forceinline__ void phase_d(const Ctx& C, int l, int nrows) {
    {
        SchedDense S{(const char*)WSP(bf16, WS_S), (const char*)(WSP(bf16, WS_WO) + (size_t)l * D * D), (size_t)D * 2, (size_t)D * 2, (TL / 256) * 4, C.G, C.bid, 4};
        EpiResid E{WSP(float, WS_H), WSP(float, WS_X1), WSP(float, WS_MOD) + (size_t)l * 9 * 6144};
        g8::gemm_phase(C.lds, D, D * 2, D * 2, S, E, C.tid);
    }
    if (nrows > TL) {
        SchedDctx S{(const char*)WSP(bf16, WS_S), (const char*)(WSP(bf16, WS_WO) + (size_t)l * D * D), C.G, C.bid};
        EpiRawF32 E{(float*)(C.ws + WS_XE + (size_t)4 * NE * 256 * D * 2)};
        g8::gemm_phase(C.lds, 256, D * 2, D * 2, S, E, C.tid);
    }
}
__device__ __forceinline__ void phase_g(const Ctx& C, int l, int mt) {
    LAS int* srow = (LAS int*)(C.lds + g8::STAGE_BYTES);
    const int per = mt * 16, nunits = NE * per; const int* SROW = WSP(int, WS_SROW);
    for (int i = 0; i < 9; ++i) { const int L = unit_index(i, C.G, C.bid, nunits); if (L >= 0 && C.tid < 256) { const int e = L / per, r = L - e * per, pm = r >> 4; srow[i * 256 + C.tid] = SROW[e * ESLOT + pm * 256 + C.tid]; } }
    __syncthreads();
    SchedGroup S{(const char*)WSP(bf16, WS_U2), (const char*)(WSP(bf16, WS_WGU) + (size_t)l * NE * 4096 * D), (size_t)0, (size_t)D * 2, (size_t)4096 * D * 2, nunits, C.G, C.bid, 16, per};
    EpiSwiGLU E{WSP(bf16, WS_ACT)};
    g8::gemm_phase<EpiSwiGLU, SchedGroup, true>(C.lds, D, D * 2, D * 2, S, E, C.tid, srow);
    __syncthreads();
}
struct SchedHctx {
    const char* A; const char* B; int G, c;
    __device__ __forceinline__ bool next(int i, g8::Unit& u) const { const int L = unit_index(i, G, c, NE * 16); if (L < 0) return false; const int e = L >> 4, pn = (L >> 2) & 3, ks = L & 3;
        u.A = A + ((size_t)e * ESLOT + NB * CAPL) * (FF * 2) + (size_t)ks * 1024; u.B = B + ((size_t)e * D + pn * 256) * (FF * 2) + (size_t)ks * 1024; u.r0 = ks * (NE * 256) + e * 256; u.c0 = pn * 256; u.x = e; return true; }
};
__device__ __forceinline__ void phase_h(const Ctx& C, int l, int mt) {
    {
        SchedGroup S{(const char*)WSP(bf16, WS_ACT), (const char*)(WSP(bf16, WS_WD) + (size_t)l * NE * D * FF), (size_t)FF * 2, (size_t)FF * 2, (size_t)D * FF * 2, NE * 8 * 4, C.G, C.bid, 4, 8 * 4};
        EpiStoreBf16 E{WSP(bf16, WS_YE), (size_t)D};
        g8::gemm_phase(C.lds, FF, FF * 2, FF * 2, S, E, C.tid);
    }
    if (mt == 9) {
        SchedHctx S{(const char*)WSP(bf16, WS_ACT), (const char*)(WSP(bf16, WS_WD) + (size_t)l * NE * D * FF), C.G, C.bid};
        EpiStoreBf16 E{WSP(bf16, WS_XE), (size_t)D};
        g8::gemm_phase(C.lds, 512, FF * 2, FF * 2, S, E, C.tid);
    }
}

__device__ __forceinline__ void na_unit_latent(const Ctx& C, int l, int u) {
    const int b = u >> 5, hh = (u >> 3) & 3, rr = u & 7, w = C.wave;
    const bf16* Z = WSP(bf16, WS_Z);
    LAS float* btab = (LAS float*)(C.lds + 110 * 1024 + 256);
    for (int i = C.tid; i < 15 * 31; i += 512) btab[i] = C.in[I_RPB][((size_t)l * 4 + hh) * 465 + i] * LOG2E;
    __syncthreads();
    const int R = 4 * rr + (w >> 1), qc0 = 32 * (w & 1);
    int kr_lo = 4 * rr - 4; kr_lo = kr_lo < 0 ? 0 : (kr_lo > 24 ? 24 : kr_lo);
    int kr_hi = 4 * rr - 1; kr_hi = (kr_hi < 0 ? 0 : (kr_hi > 24 ? 24 : kr_hi)) + 8;
    int r0w = R - 4; r0w = r0w < 0 ? 0 : (r0w > 24 ? 24 : r0w);
    const size_t lat0 = (size_t)b * SEQ, ctx0 = (size_t)TL + (size_t)b * CTX;
    const bf16* q = Z + (lat0 + R * 64 + qc0) * NZ + ZQ + hh * 64;
    bf16* o = WSP(bf16, WS_Y) + (lat0 + R * 64 + qc0) * 256 + hh * 64;
    attn_unit<64, true>(C, q, NZ, Z + ctx0 * NZ + ZK + hh * 64, Z + ctx0 * NZ + ZV + hh * 64, 4,
                        Z + (lat0 + kr_lo * 64) * NZ + ZK + hh * 64, Z + (lat0 + kr_lo * 64) * NZ + ZV + hh * 64, kr_hi - kr_lo,
                        NZ, NZ, o, 256, r0w - kr_lo, r0w - kr_lo + 8, kr_lo - R + 7, qc0, btab);
    __syncthreads();
}
__device__ __forceinline__ void na_unit_ctx(const Ctx& C, int u) {
    const int b = u >> 2, hh = u & 3, w = C.wave;
    const bf16* Z = WSP(bf16, WS_Z);
    const size_t ctx0 = (size_t)TL + (size_t)b * CTX;
    const bf16* q = Z + (ctx0 + 32 * w) * NZ + ZQ + hh * 64;
    bf16* o = WSP(bf16, WS_Y) + (ctx0 + 32 * w) * 256 + hh * 64;
    attn_unit<64, false>(C, q, NZ, Z + ctx0 * NZ + ZK + hh * 64, Z + ctx0 * NZ + ZV + hh * 64, 4, nullptr, nullptr, 0, NZ, NZ, o, 256, 0, 0, 0, 0, nullptr);
    __syncthreads();
}
template <int NC>
__device__ __forceinline__ void row_rms(const Ctx& C, int tm, int zc, LAS float* rs) {
    const bf16* Z = WSP(bf16, WS_Z);
    const int r = C.tid >> 2, part = C.tid & 3;
    const bf16* p = Z + (size_t)(tm * 128 + r) * NZ + zc + part * (NC / 4);
    float s = 0.f;
#pragma unroll
    for (int i = 0; i < NC / 32; ++i) { const u32x4 v = *(const u32x4*)(p + 8 * i);
        const float a0 = bflo(v.x), a1 = bfhi(v.x), a2 = bflo(v.y), a3 = bfhi(v.y), a4 = bflo(v.z), a5 = bfhi(v.z), a6 = bflo(v.w), a7 = bfhi(v.w);
        s += a0 * a0 + a1 * a1 + a2 * a2 + a3 * a3 + a4 * a4 + a5 * a5 + a6 * a6 + a7 * a7; }
    s += __shfl_xor(s, 1); s += __shfl_xor(s, 2);
    if (part == 0) rs[r] = 1.0f / sqrtf(s * (1.0f / NC) + LN_EPS);
    __syncthreads();
}
__device__ __forceinline__ void mlaq_tile(const Ctx& C, int l, int u) {
    const int tm = u / 3, tn = u % 3;
    LAS float* rs = (LAS float*)(C.lds + 110 * 1024);
    row_rms<256>(C, tm, ZCQ, rs);
    const bf16* Z = WSP(bf16, WS_Z); const bf16* W = WSP(bf16, WS_WUQ) + (size_t)l * 384 * 256; bf16* QM = WSP(bf16, WS_QM);
    const float* rope = WSP(float, WS_ROPE);
    auto arow = [=](int r) { return Z + (size_t)(tm * 128 + r) * NZ + ZCQ; };
    auto brow = [=](int r) { return W + (size_t)(tn * 128 + r) * 256; };
    auto epi = [=](const f32x4 (&acc)[4][2], int wr, int wc, int fr, int fq) {
#pragma unroll
        for (int m = 0; m < 4; ++m)
#pragma unroll
            for (int n = 0; n < 2; ++n) { const int rl = wr * 64 + m * 16 + fr, row = tm * 128 + rl, col = tn * 128 + wc * 32 + n * 16 + 4 * fq;
                const float s = rs[rl] * MLA_QS; f32x4 v = acc[m][n] * s;
                const int cc = col % 96;
                if (cc >= 64 && row < TL) { const int pos = row & 2047, pi = (cc - 64) >> 1; const f32x4 cs = *(const f32x4*)(rope + (size_t)pos * 32 + 2 * pi);
                    const float x1 = v[0], x2 = v[1], y1 = v[2], y2 = v[3];
                    v[0] = x1 * cs[0] - x2 * cs[1]; v[1] = x1 * cs[1] + x2 * cs[0]; v[2] = y1 * cs[2] - y2 * cs[3]; v[3] = y1 * cs[3] + y2 * cs[2]; }
                u32x2 w; w.x = cvt_pk_bf16(v[0], v[1]); w.y = cvt_pk_bf16(v[2], v[3]); *(u32x2*)(QM + (size_t)row * 384 + col) = w; }
    };
    sgemm_tile(C, arow, brow, 256, 0, epi);
}
__device__ __forceinline__ void mlakv_tile(const Ctx& C, int l, int u) {
    const int tm = u >> 2, tn = u & 3;
    LAS float* rs = (LAS float*)(C.lds + 110 * 1024);
    row_rms<128>(C, tm, ZCKV, rs);
    const bf16* Z = WSP(bf16, WS_Z); const bf16* W = WSP(bf16, WS_WUKV) + (size_t)l * 512 * 128; bf16* KM = WSP(bf16, WS_KM); bf16* VM = WSP(bf16, WS_VM);
    const float* rope = WSP(float, WS_ROPE);
    auto arow = [=](int r) { return Z + (size_t)(tm * 128 + r) * NZ + ZCKV; };
    auto brow = [=](int r) { return W + (size_t)(tn * 128 + r) * 128; };
    auto epi = [=](const f32x4 (&acc)[4][2], int wr, int wc, int fr, int fq) {
#pragma unroll
        for (int m = 0; m < 4; ++m)
#pragma unroll
            for (int n = 0; n < 2; ++n) { const int rl = wr * 64 + m * 16 + fr, row = tm * 128 + rl, c = wc * 32 + n * 16 + 4 * fq;
                const f32x4 v = acc[m][n] * rs[rl]; u32x2 w; w.x = cvt_pk_bf16(v[0], v[1]); w.y = cvt_pk_bf16(v[2], v[3]);
                if (c < 64) *(u32x2*)(KM + (size_t)row * 384 + tn * 96 + c) = w; else *(u32x2*)(VM + (size_t)row * 256 + tn * 64 + (c - 64)) = w; }
    };
    sgemm_tile(C, arow, brow, 128, 0, epi);
    for (int i = C.tid; i < 128 * 8; i += 512) { const int rl = i >> 3, g4 = i & 7, row = tm * 128 + rl;
        const u32x2 w = *(const u32x2*)(Z + (size_t)row * NZ + ZKR + 4 * g4); float x1 = bflo(w.x), x2 = bfhi(w.x), y1 = bflo(w.y), y2 = bfhi(w.y);
        if (row < TL) { const int pos = row & 2047; const f32x4 cs = *(const f32x4*)(rope + (size_t)pos * 32 + 4 * g4);
            const float a = x1 * cs[0] - x2 * cs[1], b2 = x1 * cs[1] + x2 * cs[0], c2 = y1 * cs[2] - y2 * cs[3], d2 = y1 * cs[3] + y2 * cs[2]; x1 = a; x2 = b2; y1 = c2; y2 = d2; }
        u32x2 o; o.x = cvt_pk_bf16(x1, x2); o.y = cvt_pk_bf16(y1, y2); *(u32x2*)(KM + (size_t)row * 384 + tn * 96 + 64 + 4 * g4) = o; }
}
__device__ __forceinline__ void fft1_tile(const Ctx& C, int u) {
    const bf16* Z = WSP(bf16, WS_Z); const bf16* T64 = WSP(bf16, WS_T64);
    int b, g, ch, L; size_t tok0; bf16* dst; int ldd, half;
    if (u < 256) { b = u >> 5; g = (u >> 3) & 3; ch = u & 7; L = SEQ; tok0 = (size_t)b * SEQ; dst = WSP(bf16, WS_FB) + (size_t)((b * 4 + g) * 64) * 2048 + ch * 128; ldd = 2048; half = 1024; }
    else { const int v = u - 256; b = v >> 2; g = v & 3; ch = 0; L = CTX; tok0 = (size_t)TL + (size_t)b * CTX; dst = WSP(bf16, WS_FBC) + (size_t)((b * 4 + g) * 64) * 256; ldd = 256; half = 128; }
    const bf16* Zg = Z + tok0 * NZ + ZF + g * 64;
    auto arow = [=](int r) { return T64 + (size_t)r * 128; };
    auto brow = [=](int r) { return Zg + (size_t)(ch * 128 + r) * NZ; };
    auto bstep = [=](int r) { const int n = ch * 128 + r, mir = (L - n) & (L - 1); return (long)(mir - n) * NZ; };
    auto epi = [=](const f32x4 (&acc)[4][2], int wr, int wc, int fr, int fq) {
#pragma unroll
        for (int m = 0; m < 4; ++m)
#pragma unroll
            for (int n = 0; n < 2; ++n) { const int mrow = wr * 64 + m * 16 + fr, col = wc * 32 + n * 16 + 4 * fq;
                u32x2 w; w.x = cvt_pk_bf16(acc[m][n][0], acc[m][n][1]); w.y = cvt_pk_bf16(acc[m][n][2], acc[m][n][3]);
                *(u32x2*)(dst + (size_t)(mrow & 63) * ldd + (mrow >> 6) * half + col) = w; }
    };
    sgemm_tile_s(C, arow, brow, bstep, 128, epi);
    if (ch == 0 && C.tid < 64) {
        const bf16* zr = Zg + (size_t)(L >> 1) * NZ; const bf16* tr = T64 + (size_t)C.tid * 128; float s = 0.f;
#pragma unroll
        for (int c8 = 0; c8 < 8; ++c8) { const u32x4 z = *(const u32x4*)(zr + c8 * 8), t = *(const u32x4*)(tr + c8 * 8);
            s += bflo(z.x) * bflo(t.x) + bfhi(z.x) * bfhi(t.x) + bflo(z.y) * bflo(t.y) + bfhi(z.y) * bfhi(t.y) + bflo(z.z) * bflo(t.z) + bfhi(z.z) * bfhi(t.z) + bflo(z.w) * bflo(t.w) + bfhi(z.w) * bfhi(t.w); }
        dst[(size_t)C.tid * ldd + half] = (bf16)(cvt_pk_bf16(s, 0.f) & 0xffff);
    }
}
__device__ __forceinline__ void pool_all(const Ctx& C) {
    const bf16* Z = WSP(bf16, WS_Z); bf16* Y1 = WSP(bf16, WS_Y) + (size_t)T * 256;
    const size_t gtid = (size_t)C.bid * 512 + C.tid, gth = (size_t)C.G * 512;
    for (size_t i = gtid; i < (size_t)T * 32; i += gth) {
        const int row = (int)(i >> 5), c8 = (int)(i & 31), g = c8 >> 3;
        const int L = row < TL ? SEQ : CTX, s0 = row < TL ? (row & ~2047) : TL + ((row - TL) & ~255), t = row - s0, half = 1 << g;
        int lo = t - half; lo = lo < 0 ? 0 : lo; int hi = t + half; hi = hi > L ? L : hi;
        float a[8];
#pragma unroll
        for (int q = 0; q < 8; ++q) a[q] = 0.f;
        for (int tt = lo; tt < hi; ++tt) { const u32x4 v = *(const u32x4*)(Z + (size_t)(s0 + tt) * NZ + ZP + c8 * 8);
            a[0] += bflo(v.x); a[1] += bfhi(v.x); a[2] += bflo(v.y); a[3] += bfhi(v.y); a[4] += bflo(v.z); a[5] += bfhi(v.z); a[6] += bflo(v.w); a[7] += bfhi(v.w); }
        const float inv = 1.0f / (float)(hi - lo);
        const u32x4 me = *(const u32x4*)(Z + (size_t)row * NZ + ZP + c8 * 8);
        u32x4 o; o.x = cvt_pk_bf16(a[0] * inv - bflo(me.x), a[1] * inv - bfhi(me.x)); o.y = cvt_pk_bf16(a[2] * inv - bflo(me.y), a[3] * inv - bfhi(me.y));
        o.z = cvt_pk_bf16(a[4] * inv - bflo(me.z), a[5] * inv - bfhi(me.z)); o.w = cvt_pk_bf16(a[6] * inv - bflo(me.w), a[7] * inv - bfhi(me.w));
        *(u32x4*)(Y1 + (size_t)row * 256 + c8 * 8) = o;
    }
}
__device__ __forceinline__ void phase_b0(const Ctx& C, int l) {
    const bool wc = l < DEPTH - 1;
    const int n_na = 256, n_nac = wc ? 32 : 0, n_q = (T / 128) * 3, n_kv = (T / 128) * 4, n_f = wc ? 288 : 256;
    const int total = n_na + n_nac + n_q + n_kv + n_f;
    for (int u = C.bid; u < total; u += C.G) {
        int v = u;
        if (v < n_na) { na_unit_latent(C, l, v); continue; } v -= n_na;
        if (v < n_nac) { na_unit_ctx(C, v); continue; } v -= n_nac;
        if (v < n_q) { mlaq_tile(C, l, v); continue; } v -= n_q;
        if (v < n_kv) { mlakv_tile(C, l, v); continue; } v -= n_kv;
        fft1_tile(C, v);
    }
    pool_all(C);
}

__device__ __forceinline__ void mla_unit(const Ctx& C, int u, bool ctxq) {
    const bf16* QM = WSP(bf16, WS_QM); const bf16* KM = WSP(bf16, WS_KM); const bf16* VM = WSP(bf16, WS_VM);
    bf16* Y3 = WSP(bf16, WS_Y) + (size_t)3 * T * 256;
    const int w = C.wave;
    if (!ctxq) {
        const int b = u >> 5, hh = (u >> 3) & 3, qb = u & 7;
        const size_t lat0 = (size_t)b * SEQ, ctx0 = (size_t)TL + (size_t)b * CTX, q0 = lat0 + qb * 256 + w * 32;
        attn_unit<96, false>(C, QM + q0 * 384 + hh * 96, 384, KM + lat0 * 384 + hh * 96, VM + lat0 * 256 + hh * 64, 32,
                             KM + ctx0 * 384 + hh * 96, VM + ctx0 * 256 + hh * 64, 4, 384, 256, Y3 + q0 * 256 + hh * 64, 256, 0, 0, 0, 0, nullptr);
    } else {
        const int b = u >> 2, hh = u & 3;
        const size_t ctx0 = (size_t)TL + (size_t)b * CTX, q0 = ctx0 + w * 32;
        attn_unit<96, false>(C, QM + q0 * 384 + hh * 96, 384, KM + ctx0 * 384 + hh * 96, VM + ctx0 * 256 + hh * 64, 4,
                             nullptr, nullptr, 0, 384, 256, Y3 + q0 * 256 + hh * 64, 256, 0, 0, 0, 0, nullptr);
    }
    __syncthreads();
}
__device__ __forceinline__ void fft2_tile(const Ctx& C, int u, bool ctxq) {
    bf16* Y2 = WSP(bf16, WS_Y) + (size_t)2 * T * 256;
    if (!ctxq) {
        const int ux = u >> 5, uk = u & 31, tm = (ux >> 1) * 4 + (uk & 3), tn = (ux & 1) * 8 + (uk >> 2), b = tn >> 1;
        const bf16* A = WSP(bf16, WS_AFFT); const bf16* Bt = WSP(bf16, WS_FB);
        auto arow = [=](int r) { return A + (size_t)(tm * 128 + r) * 2048; };
        auto brow = [=](int r) { return Bt + (size_t)(tn * 128 + r) * 2048; };
        auto epi = [=](const f32x4 (&acc)[4][2], int wr, int wc, int fr, int fq) {
#pragma unroll
            for (int m = 0; m < 4; ++m)
#pragma unroll
                for (int n = 0; n < 2; ++n) { const int k1 = tm * 128 + wr * 64 + m * 16 + fr, chn = (tn & 1) * 128 + wc * 32 + n * 16 + 4 * fq;
                    u32x2 w; w.x = cvt_pk_bf16(acc[m][n][0], acc[m][n][1]); w.y = cvt_pk_bf16(acc[m][n][2], acc[m][n][3]);
                    *(u32x2*)(Y2 + ((size_t)b * SEQ + k1) * 256 + chn) = w; }
        };
        sgemm_tile_d4(C, arow, brow, 2048, epi);
    } else {
        const int tm = u >> 4, tn = u & 15, b = tn >> 1;
        const bf16* A = WSP(bf16, WS_AFFTC); const bf16* Bt = WSP(bf16, WS_FBC);
        auto arow = [=](int r) { return A + (size_t)(tm * 128 + r) * 256; };
        auto brow = [=](int r) { return Bt + (size_t)(tn * 128 + r) * 256; };
        auto epi = [=](const f32x4 (&acc)[4][2], int wr, int wc, int fr, int fq) {
#pragma unroll
            for (int m = 0; m < 4; ++m)
#pragma unroll
                for (int n = 0; n < 2; ++n) { const int k1 = tm * 128 + wr * 64 + m * 16 + fr, chn = (tn & 1) * 128 + wc * 32 + n * 16 + 4 * fq;
                    u32x2 w; w.x = cvt_pk_bf16(acc[m][n][0], acc[m][n][1]); w.y = cvt_pk_bf16(acc[m][n][2], acc[m][n][3]);
                    *(u32x2*)(Y2 + ((size_t)TL + (size_t)b * CTX + k1) * 256 + chn) = w; }
        };
        sgemm_tile_d4(C, arow, brow, 256, epi);
    }
}
__device__ __forceinline__ void phase_b1(const Ctx& C, int l) {
    const bool wc = l < DEPTH - 1;
    const int n_m = 256, n_f = 256, n_mc = wc ? 32 : 0, n_fc = wc ? 32 : 0;
    const int total = n_m + n_f + n_mc + n_fc;
    for (int u = C.bid; u < total; u += C.G) {
        int v = u;
        if (v < n_m) { mla_unit(C, v, false); continue; } v -= n_m;
        if (v < n_f) { fft2_tile(C, v, false); continue; } v -= n_f;
        if (v < n_mc) { mla_unit(C, v, true); continue; } v -= n_mc;
        fft2_tile(C, v, true);
    }
}

__device__ __forceinline__ void phase_e(const Ctx& C, int l, int nrows) {
    LAS float* wr = (LAS float*)C.lds;
    LAS float* lgl = (LAS float*)(C.lds + 65536);
    LAS float* lbl = lgl + 1024;
    LAS float* mdl = lbl + 1024;
    const int tid = C.tid, lane = C.lane, rg = lane >> 4, li = lane & 15;
    {   f32x4 wv[8];
#pragma unroll
        for (int q = 0; q < 8; ++q) wv[q] = *(const f32x4*)(C.in[I_WROUTER] + (size_t)l * 16384 + 4 * (tid + 512 * q));
        const f32x4 gv = *(const f32x4*)(C.in[(tid < 256) ? I_LN1G : I_LN1B] + l * D + 4 * (tid & 255));
#pragma unroll
        for (int q = 0; q < 8; ++q) { const int i4 = tid + 512 * q, d = i4 >> 2, e4 = (i4 & 3) * 4; wr[(e4 + 0) * 1024 + d] = wv[q][0]; wr[(e4 + 1) * 1024 + d] = wv[q][1]; wr[(e4 + 2) * 1024 + d] = wv[q][2]; wr[(e4 + 3) * 1024 + d] = wv[q][3]; }
        *(LAS f32x4*)(((tid < 256) ? lgl : lbl) + 4 * (tid & 255)) = gv; }
    const int bkk = blk_k(C), bxx = blk_x(C), bp = (bkk < 8) ? bxx * 8 + bkk : 64 + bxx * 24 + (bkk - 8);
    const int gw = bp * 8 + C.wave, NGW = C.G * 8, ngroups = nrows >> 2;
    const float* mod = WSP(float, WS_MOD) + (size_t)l * 9 * 6144;
    const float* X1 = WSP(float, WS_X1);
    float* AFFT = WSP(float, WS_AFF);
    f32x4 nx[16]; f32x4 nmd;
    const int mdv = tid >> 8, mdc = (tid & 255) * 4;
    if (gw < ngroups) {
        const int row = 4 * gw + rg; const float* mr = mod + (size_t)mod_row(4 * gw) * 6144;
#pragma unroll
        for (int j = 0; j < 16; ++j) nx[j] = *(const f32x4*)(X1 + (size_t)row * D + 4 * li + 64 * j);
        nmd = *(const f32x4*)(mr + (mdv ? 3072 : 4096) + mdc);
    }
    for (int g = gw, it = 0; g < ngroups; g += NGW, ++it) {
        {   f32x4 w = nmd; if (mdv == 0) w = w + 1.0f; *(LAS f32x4*)(mdl + (it & 1) * 2048 + mdv * 1024 + mdc) = w; }
        __syncthreads();
        const LAS float* scl = mdl + (it & 1) * 2048; const LAS float* shl = scl + 1024;
        f32x4 v[16]; float s = 0.f;
        const int row = 4 * g + rg;
        if (4 * g < TL) {
#pragma unroll
            for (int j = 0; j < 16; ++j) v[j] = nx[j];
        } else {
            const float* hr = WSP(float, WS_H) + (size_t)row * D + 4 * li; const float* g1 = mod + (size_t)8 * 6144 + 2048 + 4 * li;
            const float* pc = (const float*)(C.ws + WS_XE + (size_t)4 * NE * 256 * D * 2) + (size_t)(row - TL) * D + 4 * li;
#pragma unroll
            for (int j = 0; j < 16; ++j) { const f32x4 p0 = *(const f32x4*)(pc + 64 * j), p1 = *(const f32x4*)(pc + (size_t)TC * D + 64 * j), p2 = *(const f32x4*)(pc + (size_t)2 * TC * D + 64 * j), p3 = *(const f32x4*)(pc + (size_t)3 * TC * D + 64 * j);
                v[j] = *(const f32x4*)(hr + 64 * j) * DN_ALPHA + *(const f32x4*)(g1 + 64 * j) * ((p0 + p1) + (p2 + p3));
                *(f32x4*)(WSP(float, WS_X1) + (size_t)row * D + 4 * li + 64 * j) = v[j]; }
        }
#pragma unroll
        for (int j = 0; j < 16; ++j) s += (v[j][0] + v[j][1]) + (v[j][2] + v[j][3]);
        if (g + NGW < ngroups) { const int gn = g + NGW, rn = 4 * gn + rg; const float* mr = mod + (size_t)mod_row(4 * gn) * 6144;
            if (4 * gn < TL) {
#pragma unroll
                for (int j = 0; j < 16; ++j) nx[j] = *(const f32x4*)(X1 + (size_t)rn * D + 4 * li + 64 * j);
            }
            nmd = *(const f32x4*)(mr + (mdv ? 3072 : 4096) + mdc); }
        const float mean = row16_sum(s) * (1.0f / D); float q = 0.f;
#pragma unroll
        for (int j = 0; j < 16; ++j) { v[j] = v[j] - mean; q += (v[j][0] * v[j][0] + v[j][1] * v[j][1]) + (v[j][2] * v[j][2] + v[j][3] * v[j][3]); }
        const float rstd = 1.0f / sqrtf(row16_sum(q) * (1.0f / D) + LN_EPS);
        float lgt[16];
#pragma unroll
        for (int e = 0; e < 16; ++e) lgt[e] = 0.f;
        bf16* ud = WSP(bf16, WS_U2) + (size_t)row * D + 4 * li;
        if (li == 0) { typedef float f32x2v __attribute__((ext_vector_type(2))); *(f32x2v*)(WSP(float, WS_ST1) + (size_t)row * 2) = (f32x2v){mean, rstd}; }
#pragma unroll
        for (int j = 0; j < 16; ++j) { const int c = 4 * li + 64 * j;
            const f32x4 y = v[j] * rstd * *(const LAS f32x4*)(lgl + c) + *(const LAS f32x4*)(lbl + c);
            const f32x4 uu = y * *(const LAS f32x4*)(scl + c) + *(const LAS f32x4*)(shl + c);
            u32x2 w; w.x = cvt_pk_bf16(uu[0], uu[1]); w.y = cvt_pk_bf16(uu[2], uu[3]); st_wt8(ud + 64 * j, w);
#pragma unroll
            for (int eh = 0; eh < 4; ++eh) {
                f32x4 ww[4];
#pragma unroll
                for (int e = 0; e < 4; ++e) ww[e] = *(const LAS f32x4*)(wr + (4 * eh + e) * 1024 + c);
                __builtin_amdgcn_sched_barrier(0);
#pragma unroll
                for (int e = 0; e < 4; ++e) lgt[4 * eh + e] += (uu[0] * ww[e][0] + uu[1] * ww[e][1]) + (uu[2] * ww[e][2] + uu[3] * ww[e][3]);
                __builtin_amdgcn_sched_barrier(0);
            }
        }
        float mx = -1e30f;
#pragma unroll
        for (int e = 0; e < 16; ++e) { lgt[e] = row16_sum(lgt[e]); mx = fmaxf(mx, lgt[e]); }
        float den = 0.f;
#pragma unroll
        for (int e = 0; e < 16; ++e) { lgt[e] = __expf(lgt[e] - mx); den += lgt[e]; }
        const float inv = 1.0f / den; float mine = 0.f;
#pragma unroll
        for (int e = 0; e < 16; ++e) mine = (li == e) ? lgt[e] * inv : mine;
        AFFT[(size_t)li * T + row] = mine;
    }
    __syncthreads();
}
__device__ __forceinline__ void phase_f(const Ctx& C, int l) {
    const bool wc = l < DEPTH - 1;
    const int nunits = 128 + (wc ? 128 : 0);
    LAS unsigned* hist = (LAS unsigned*)(C.lds);
    LAS unsigned* wsum = (LAS unsigned*)(C.lds + 256);
    const int tid = C.tid, lane = C.lane, wave = C.wave;
    const float* AFF = WSP(float, WS_AFF); int* SLOT = WSP(int, WS_SLOT); float* GATEV = WSP(float, WS_GATEV); int* SROW = WSP(int, WS_SROW);
    {
        const int bx = blk_x(C), bk = blk_k(C); const int u = (bk < 16) ? bx * 16 + bk : 128 + bx * 16 + (bk - 16);
        if (u < nunits) {
        const bool isc = u >= 128; const int v = isc ? u - 128 : u, b = v >> 4, e = v & 15;
        const int cap = isc ? CAPC : CAPL, vpt = isc ? 1 : 4;
        const int row0 = isc ? TL + b * CTX : b * SEQ;
        const int sbase = e * ESLOT + (isc ? NB * CAPL + b * CAPC : b * CAPL);
        const bool have = isc ? (tid < 256) : true;
        unsigned key[4];
#pragma unroll
        for (int i = 0; i < 4; ++i) { key[i] = 0u; if (have && i < vpt) key[i] = __float_as_uint(AFF[(size_t)e * T + row0 + tid * vpt + i]); }
        if (tid < 48) hist[tid] = 0u;
        __syncthreads();
        unsigned prefix = 0u; int kth = cap;
#pragma unroll 1
        for (int it = 0; it < 8; ++it) {
            const int shift = 28 - 4 * it; LAS unsigned* hb = hist + 16 * (it % 3);
            if (tid < 16) hist[16 * ((it + 1) % 3) + tid] = 0u;
            unsigned mycnt = 0u;
#pragma unroll
            for (int i = 0; i < 4; ++i) {
                const bool in = have && i < vpt && (it == 0 || (key[i] >> (shift + 4)) == (prefix >> (shift + 4)));
                const unsigned dg = (key[i] >> shift) & 15u;
#pragma unroll
                for (int d = 0; d < 16; ++d) { const unsigned c = (unsigned)__popcll(__ballot(in && dg == (unsigned)d)); mycnt = (lane == d) ? mycnt + c : mycnt; }
            }
            if (lane < 16 && mycnt) atomicAdd((unsigned*)(hb + lane), mycnt);
            __syncthreads();
            unsigned cum = 0u; int dsel = 0; int kn = kth;
#pragma unroll
            for (int d = 15; d >= 0; --d) { const unsigned h = hb[d]; const bool hit = (cum < (unsigned)kth) && (cum + h >= (unsigned)kth); if (hit) { dsel = d; kn = kth - (int)cum; } cum += h; }
            prefix |= ((unsigned)dsel << shift); kth = kn;
        }
        const unsigned thr = prefix;
        unsigned neq = 0;
#pragma unroll
        for (int i = 0; i < 4; ++i) if (have && i < vpt) neq += (key[i] == thr);
        unsigned incl = neq;
#pragma unroll
        for (int o = 1; o < 64; o <<= 1) { const unsigned t2 = __shfl_up(incl, o); if (lane >= o) incl += t2; }
        if (lane == 63) wsum[wave] = incl;
        __syncthreads();
        unsigned woff = 0;
        for (int w2 = 0; w2 < wave; ++w2) woff += wsum[w2];
        unsigned eqrank = woff + incl - neq;
        unsigned sel[4]; unsigned nsel = 0;
#pragma unroll
        for (int i = 0; i < 4; ++i) { sel[i] = 0u; if (have && i < vpt) { if (key[i] > thr) sel[i] = 1u; else if (key[i] == thr) { sel[i] = ((int)eqrank < kth) ? 1u : 0u; ++eqrank; } nsel += sel[i]; } }
        incl = nsel;
#pragma unroll
        for (int o = 1; o < 64; o <<= 1) { const unsigned t2 = __shfl_up(incl, o); if (lane >= o) incl += t2; }
        if (lane == 63) wsum[8 + wave] = incl;
        __syncthreads();
        woff = 0;
        for (int w2 = 0; w2 < wave; ++w2) woff += wsum[8 + w2];
        unsigned pos = woff + incl - nsel;
#pragma unroll
        for (int i = 0; i < 4; ++i) if (have && i < vpt) { const int t = tid * vpt + i; int slot = -1;
            if (sel[i]) { slot = sbase + (int)pos; SROW[slot] = row0 + t; GATEV[slot] = __uint_as_float(key[i]); ++pos; }
            SLOT[(size_t)(row0 + t) * 16 + e] = slot; }
        __syncthreads();
    }
    }
}
__device__ __forceinline__ void phase_i(const Ctx& C, int l, int nrows) {
    LAS float* lgl = (LAS float*)C.lds;
    LAS float* lbl = lgl + 1024;
    LAS float* mdl = lbl + 1024;
    const int tid = C.tid, lane = C.lane, rg = lane >> 4, li = lane & 15;
    LAS float* l1g = mdl + 6144;
    LAS float* l1b = l1g + 1024;
    for (int i = tid; i < 1024; i += 512) { lgl[i] = C.in[I_LN2G][l * D + i]; lbl[i] = C.in[I_LN2B][l * D + i]; l1g[i] = C.in[I_LN1G][l * D + i]; l1b[i] = C.in[I_LN1B][l * D + i]; }
    const int bkk = blk_k(C), bxx = blk_x(C), bp = (bkk < 8) ? bxx * 8 + bkk : 64 + bxx * 24 + (bkk - 8);
    const int gw = bp * 8 + C.wave, NGW = C.G * 8, ngroups = nrows >> 2;
    const float* mod = WSP(float, WS_MOD) + (size_t)l * 9 * 6144;
    const float* modn = WSP(float, WS_MOD) + (size_t)(l + 1 < DEPTH ? l + 1 : l) * 9 * 6144;
    const int* SLOT = WSP(int, WS_SLOT); const float* GATEV = WSP(float, WS_GATEV); const bf16* YE = WSP(bf16, WS_YE); const bf16* YEC = WSP(bf16, WS_XE);
    float* Hb = WSP(float, WS_H); bf16* U1b = WSP(bf16, WS_U1); const float* X1b = WSP(float, WS_X1);
    const int mdv = tid >> 8, mdc = (tid & 255) * 4;
    auto mdload = [&](int g4row) -> f32x4 { const int r = mod_row(g4row); const float* p = (mdv == 0) ? mod + (size_t)r * 6144 + 5120 + mdc : modn + (size_t)r * 6144 + (mdv == 1 ? 1024 : 0) + mdc; return *(const f32x4*)p; };
    f32x4 nmd0 = (f32x4){0.f, 0.f, 0.f, 0.f}, nmd1 = nmd0;
    if (gw < ngroups) { nmd0 = mdload(4 * gw); if (tid < 256) { const int r = mod_row(4 * gw); nmd1 = *(const f32x4*)(modn + (size_t)r * 6144 + mdc); } }
    for (int g = gw, it = 0; g < ngroups; g += NGW, ++it) {
        {   LAS float* buf = mdl + (it & 1) * 3072;
            if (mdv < 2) { f32x4 w = nmd0; if (mdv == 1) w = w + 1.0f; *(LAS f32x4*)(buf + mdv * 1024 + mdc) = w; }
            if (tid < 256) *(LAS f32x4*)(buf + 2048 + mdc) = nmd1; }
        __syncthreads();
        const LAS float* g2l = mdl + (it & 1) * 3072; const LAS float* scl = g2l + 1024; const LAS float* shl = g2l + 2048;
        const int row = 4 * g + rg;
        const int myslot = SLOT[(size_t)row * 16 + li];
        f32x4 hv[16];
        typedef float f32x2v __attribute__((ext_vector_type(2))); const f32x2v st1 = *(const f32x2v*)(WSP(float, WS_ST1) + (size_t)row * 2);
#pragma unroll
        for (int j = 0; j < 16; ++j) hv[j] = *(const f32x4*)(X1b + (size_t)row * D + 4 * li + 64 * j);
        if (g + NGW < ngroups) { const int gn = g + NGW; nmd0 = mdload(4 * gn); if (tid < 256) { const int r = mod_row(4 * gn); nmd1 = *(const f32x4*)(modn + (size_t)r * 6144 + mdc); } }
        const unsigned long long bal = __ballot(myslot >= 0);
        unsigned m = (unsigned)(bal >> (16 * rg)) & 0xffffu;
#pragma unroll
        for (int j = 0; j < 16; ++j) { const int c = 4 * li + 64 * j; hv[j] = ((hv[j] - st1.x) * st1.y * *(const LAS f32x4*)(l1g + c) + *(const LAS f32x4*)(l1b + c)) * DN_ALPHA;
            if ((j & 3) == 3) __builtin_amdgcn_sched_barrier(0); }
        const bool isctx = (4 * g) >= TL;
        int ph = 0;
        while (__any(m != 0u)) {
            const bf16* p[2]; float gt[2];
            if (!isctx) {
#pragma unroll
                for (int k = 0; k < 2; ++k) { const bool ok = m != 0u; const int e = ok ? (int)__builtin_ctz(m) : 0; m = ok ? (m & (m - 1u)) : 0u;
                    const int sv = __shfl(myslot, (rg << 4) + e); const int se = ok ? sv : 0; gt[k] = ok ? GATEV[se] : 0.f; p[k] = YE + (size_t)se * D + 4 * li; }
            } else {
                const bool ok = m != 0u; const int e = ok ? (int)__builtin_ctz(m) : 0; if (ph) m = ok ? (m & (m - 1u)) : 0u;
                const int sv = __shfl(myslot, (rg << 4) + e); const int se = ok ? sv : NB * CAPL; const float gv = ok ? GATEV[se] : 0.f;
                const int ex = se / ESLOT, cr = se - ex * ESLOT - NB * CAPL; const bf16* base = YEC + ((size_t)ex * 256 + cr) * D + 4 * li + (size_t)(2 * ph) * (NE * 256) * D;
                p[0] = base; p[1] = base + (size_t)(NE * 256) * D; gt[0] = gv; gt[1] = gv; ph ^= 1;
            }
            const LAS float* g2p = g2l + 4 * li; asm volatile("" : "+v"(g2p));
            u32x2 w[2][16];
#pragma unroll
            for (int k = 0; k < 2; ++k)
#pragma unroll
                for (int j = 0; j < 16; ++j) w[k][j] = *(const u32x2*)(p[k] + 64 * j);
#pragma unroll
            for (int j = 0; j < 16; ++j) { const f32x4 g2v = *(const LAS f32x4*)(g2p + 64 * j);
#pragma unroll
                for (int k = 0; k < 2; ++k) { const f32x4 t = g2v * gt[k];
                    hv[j][0] += t[0] * bflo(w[k][j].x); hv[j][1] += t[1] * bfhi(w[k][j].x); hv[j][2] += t[2] * bflo(w[k][j].y); hv[j][3] += t[3] * bfhi(w[k][j].y); }
                if ((j & 3) == 3) __builtin_amdgcn_sched_barrier(0); }
        }
        float s = 0.f;
#pragma unroll
        for (int j = 0; j < 16; ++j) s += (hv[j][0] + hv[j][1]) + (hv[j][2] + hv[j][3]);
        const float mean = row16_sum(s) * (1.0f / D); float q = 0.f;
#pragma unroll
        for (int j = 0; j < 16; ++j) { hv[j] = hv[j] - mean; q += (hv[j][0] * hv[j][0] + hv[j][1] * hv[j][1]) + (hv[j][2] * hv[j][2] + hv[j][3] * hv[j][3]); }
        const float rstd = 1.0f / sqrtf(row16_sum(q) * (1.0f / D) + LN_EPS);
#pragma unroll
        for (int j = 0; j < 16; ++j) { const int c = 4 * li + 64 * j;
            const f32x4 y = hv[j] * rstd * *(const LAS f32x4*)(lgl + c) + *(const LAS f32x4*)(lbl + c);
            if (l + 1 < DEPTH) { *(f32x4*)(Hb + (size_t)row * D + c) = y; const f32x4 uu = y * *(const LAS f32x4*)(scl + c) + *(const LAS f32x4*)(shl + c);
                u32x2 w; w.x = cvt_pk_bf16(uu[0], uu[1]); w.y = cvt_pk_bf16(uu[2], uu[3]); *(u32x2*)(U1b + (size_t)row * D + c) = w; }
            else *(f32x4*)(C.out + (size_t)row * D + c) = y;
            if ((j & 3) == 3) __builtin_amdgcn_sched_barrier(0);
        }
    }
    __syncthreads();
}

constexpr int PH_PER_LAYER = 11, N_PHASES = 2 + DEPTH * PH_PER_LAYER;
__global__ void __launch_bounds__(512, 2) mega(Args args) {
    extern __shared__ __attribute__((aligned(16))) unsigned char lds_raw[];
#define MKCTX() Ctx C; { GAS unsigned char* w_ = (GAS unsigned char*)args.ws; asm volatile("" : "+s"(w_)); int t_ = threadIdx.x; asm volatile("" : "+v"(t_)); \
        C.lds = (LAS unsigned char*)lds_raw; C.ws = w_; C.in = args.in; C.out = args.out; C.tid = t_; C.lane = t_ & 63; C.wave = __builtin_amdgcn_readfirstlane(t_ >> 6); C.bid = (gridDim.x & 7u) ? blockIdx.x : (blockIdx.x & 7u) * (gridDim.x >> 3) + (blockIdx.x >> 3); C.G = gridDim.x; }
    LAS unsigned char* lds0 = (LAS unsigned char*)lds_raw;
    volatile LAS unsigned* misc = (volatile LAS unsigned*)(lds0 + LDS_MISC);
    if (threadIdx.x < 4) misc[threadIdx.x] = 0u;
    __syncthreads();
    const int lo = args.ph_lo, hi = args.ph_hi;
    const bool multi = (hi - lo) > 1;
    XcdBarrier bar; bar.bar = (unsigned*)(args.ws + WS_CTL) + 4096; bar.x = 0; bar.st = misc;
    if (multi) bar = xcd_barrier_post((unsigned*)(args.ws + WS_CTL) + 4096, misc);
#ifndef PHASE_MASK
#define PHASE_MASK 0xFFFFu
#endif
#define PM(i) (((PHASE_MASK) >> (i)) & 1u)
#define IN(k) (lo <= (k) && (k) < hi)
#define SEAM(k) do { if (IN((k) + 1)) xcd_barrier(bar); } while (0)
    if (PM(0) && IN(0)) { MKCTX(); phase_prep(C); SEAM(0); }
    if (PM(1) && IN(1)) { MKCTX(); phase_init(C); SEAM(1); }
    for (int l = 0; l < DEPTH; ++l) {
        const int p0 = 2 + l * PH_PER_LAYER;
        const int nrows = (l < DEPTH - 1) ? T : TL, mt = (l < DEPTH - 1) ? 9 : 8;
        if (PM(2) && IN(p0 + 0)) { MKCTX(); phase_inproj(C, l); SEAM(p0 + 0); }
        if (PM(3) && IN(p0 + 1)) { MKCTX(); phase_b0(C, l); SEAM(p0 + 1); }
        if (PM(4) && IN(p0 + 2)) { MKCTX(); phase_b1(C, l); SEAM(p0 + 2); }
        if (PM(5) && IN(p0 + 3)) { MKCTX(); phase_c1(C, l, nrows); if (l < DEPTH - 1 && blk_k(C) >= 16) slot_dn(C, l + 1, blk_x(C) * 16 + blk_k(C) - 16, DN_C1_FIRST, DN_C1_CNT); SEAM(p0 + 3); }
        if (PM(6) && IN(p0 + 4)) { MKCTX(); phase_c2(C, l, nrows); if (l < DEPTH - 1 && blk_k(C) >= 16) slot_gu(C, l + 1, blk_x(C) * 16 + blk_k(C) - 16, GU_C2_FIRST, GU_C2_CNT); SEAM(p0 + 4); }
        if (PM(7) && IN(p0 + 5)) { MKCTX(); phase_d(C, l, nrows); if (l < DEPTH - 1 && blk_k(C) >= 16) slot_gu(C, l + 1, blk_x(C) * 16 + blk_k(C) - 16, GU_D_FIRST, GU_D_CNT); SEAM(p0 + 5); }
        if (PM(8) && IN(p0 + 6)) { MKCTX(); phase_e(C, l, nrows); if (l < DEPTH - 1 && blk_k(C) >= 8) slot_dn(C, l + 1, blk_x(C) * 24 + blk_k(C) - 8, DN_E_FIRST, DN_E_CNT); SEAM(p0 + 6); }
        if (PM(9) && IN(p0 + 7)) { MKCTX(); phase_f(C, l); if (l < DEPTH - 1 && blk_k(C) >= 16) slot_gu(C, l + 1, blk_x(C) * 16 + blk_k(C) - 16, GU_F_FIRST, GU_F_CNT); SEAM(p0 + 7); }
        if (PM(10) && IN(p0 + 8)) { MKCTX(); phase_g(C, l, mt); SEAM(p0 + 8); }
        if (PM(11) && IN(p0 + 9)) { MKCTX(); phase_h(C, l, mt); SEAM(p0 + 9); }
        if (PM(12) && IN(p0 + 10)) { MKCTX(); phase_i(C, l, nrows); if (l < DEPTH - 1 && blk_k(C) >= 8) slot_dn(C, l + 1, blk_x(C) * 24 + blk_k(C) - 8, DN_I_FIRST, DN_I_CNT); SEAM(p0 + 10); }
    }
#undef IN
#undef SEAM
}

#ifdef DBG_STOP
__global__ void dbg_dump(const unsigned char* src, int mode, float* out, size_t n) {
    for (size_t i = (size_t)blockIdx.x * blockDim.x + threadIdx.x; i < n; i += (size_t)gridDim.x * blockDim.x) {
        if (mode == 0) out[i] = (float)((const unsigned short*)src)[i];
        else out[i] = (float)(((const unsigned*)src)[i] >> 8);
    }
}
__global__ void dbg_scan(const unsigned char* src, size_t n, int mode, float mark, float* out) {
    const size_t t = (size_t)blockIdx.x * blockDim.x + threadIdx.x, NT = (size_t)gridDim.x * blockDim.x;
    bool bad = false;
    for (size_t i = t; i < n; i += NT) { const float v = mode == 0 ? __uint_as_float(((unsigned)((const unsigned short*)src)[i]) << 16) : ((const float*)src)[i]; if (!(fabsf(v) < 1e6f)) bad = true; }
    out[t] = bad ? mark : 0.0f;
}
__global__ void dbg_check(const float* const* dummy, const float* x, const float* c, const float* cctx, const float* wmod, const float* bmod, const float* win, const unsigned char* ws, float* out) {
    const size_t t = (size_t)blockIdx.x * blockDim.x + threadIdx.x;
    const float* MOD = (const float*)(ws + WS_MOD); const bf16* WIN = (const bf16*)(ws + WS_WIN); const bf16* U1 = (const bf16*)(ws + WS_U1); const bf16* Z = (const bf16*)(ws + WS_Z);
    if ((DBG_SEG & 1) && t < 9 * 6144) { const int r = (int)(t / 6144), n = (int)(t % 6144); double s = 0; for (int k = 0; k < 1024; ++k) { const float v = r < 8 ? c[r * 1024 + k] : cctx[k]; s += (double)(v / (1.0f + expf(-v))) * wmod[(size_t)k * 6144 + n]; }
        s += bmod[n]; const float got = MOD[(size_t)r * 6144 + n]; out[t] = (fabs(got - s) > 1e-3 * fabs(s) + 1e-4) ? 1e6f : 0.f; }
    if (DBG_SEG & 2) { const size_t idx = (t * 6661) % ((size_t)1696 * 1024); const int n = (int)(idx / 1024), k = (int)(idx % 1024); const float ref = win[(size_t)k * IN_COLS + n] * (n < 256 ? NA_QS : 1.0f);
      const float got = __uint_as_float(((unsigned)WIN[(size_t)n * 1024 + k]) << 16); out[262144 + t] = (fabsf(got - ref) > 0.01f * fabsf(ref) + 1e-6f) ? 1e5f : 0.f; }
    if (DBG_SEG & 4) { const size_t idx = (t * 7919) % ((size_t)TL * 1024); const int row = (int)(idx / 1024), k = (int)(idx % 1024), r = row >> 11; const float ref = x[idx] * (1.0f + MOD[(size_t)r * 6144 + 1024 + k]) + MOD[(size_t)r * 6144 + k];
      const float got = __uint_as_float(((unsigned)U1[idx]) << 16); out[2 * 262144 + t] = (fabsf(got - ref) > 0.01f * fabsf(ref) + 1e-3f) ? 1e4f : 0.f; }
    if (DBG_SEG & 8) { const size_t idx = (t * 104729) % ((size_t)T * 1696); const int row = (int)(idx / 1696), col = (int)(idx % 1696); float sref = 0.f;
      for (int k = 0; k < 1024; ++k) sref += __uint_as_float(((unsigned)U1[(size_t)row * 1024 + k]) << 16) * __uint_as_float(((unsigned)WIN[(size_t)col * 1024 + k]) << 16);
      const float got = __uint_as_float(((unsigned)Z[(size_t)row * NZ + col]) << 16); out[3 * 262144 + t] = (fabsf(got - sref) > 0.02f * fabsf(sref) + 0.05f) ? 1e3f : 0.f; }
}
#endif
extern "C" void kernel_launch(void* const* d_in, const int* in_sizes, int n_in, void* d_out, int out_size, void* d_ws, size_t ws_size, hipStream_t stream) {
    static int grid = 0;
    if (grid == 0) {
        if (n_in != 24 || ws_size < WS_END) { fprintf(stderr, "kernel_launch: unexpected inputs (n_in %d, ws %zu, need %zu)\n", n_in, ws_size, (size_t)WS_END); grid = -1; return; }
        int dev = 0, cus = 0, per_cu = 0;
        if (hipGetDevice(&dev) != hipSuccess || hipDeviceGetAttribute(&cus, hipDeviceAttributeMultiprocessorCount, dev) != hipSuccess) { grid = -1; return; }
        if (hipFuncSetAttribute((const void*)mega, hipFuncAttributeMaxDynamicSharedMemorySize, LDS_BYTES) != hipSuccess) { fprintf(stderr, "kernel_launch: hipFuncSetAttribute failed\n"); grid = -1; return; }
        if (hipOccupancyMaxActiveBlocksPerMultiprocessor(&per_cu, (const void*)mega, 512, LDS_BYTES) != hipSuccess || per_cu < 1) fprintf(stderr, "kernel_launch: occupancy query says %d\n", per_cu);
        (void)hipGetLastError();
        grid = cus;
    }
    if (grid < 0) return;
#ifdef POISON_WS
    (void)hipMemsetAsync((char*)d_ws, 0x00, WS_END, stream);
#endif
    (void)hipMemsetAsync((char*)d_ws + WS_CTL, 0, CTL_BYTES, stream);
    Args a{};
    for (int i = 0; i < 24; ++i) a.in[i] = (const float*)d_in[i];
    a.out = (float*)d_out; a.ws = (unsigned char*)d_ws;
#if ONE_LAUNCH
    a.ph_lo = 0; a.ph_hi = N_PHASES;
    hipLaunchKernelGGL(mega, dim3(grid), dim3(512), LDS_BYTES, stream, a);
#else
#ifdef DBG_STOP
    for (int p = 0; p <= DBG_STOP; ++p) { a.ph_lo = p; a.ph_hi = p + 1; hipLaunchKernelGGL(mega, dim3(grid), dim3(512), LDS_BYTES, stream, a); }
    (void)hipMemsetAsync(d_out, 0, (size_t)out_size * 4, stream);
    hipLaunchKernelGGL(dbg_check, dim3(1024), dim3(256), 0, stream, (const float* const*)nullptr, (const float*)d_in[I_X], (const float*)d_in[I_C], (const float*)d_in[I_CCTX], (const float*)d_in[I_WMOD], (const float*)d_in[I_BMOD], (const float*)d_in[I_WIN], (const unsigned char*)d_ws, (float*)d_out);
#else
    for (int p = 0; p < N_PHASES; ++p) { a.ph_lo = p; a.ph_hi = p + 1; hipLaunchKernelGGL(mega, dim3(grid), dim3(512), LDS_BYTES, stream, a); }
#endif
#endif
}
```

```cpp
#include <hip/hip_runtime.h>
#include <cstdio>
#include <cstdint>

#ifndef ONE_LAUNCH
#define ONE_LAUNCH 1
#endif

#define GAS __attribute__((address_space(1)))
#define LAS __attribute__((address_space(3)))
typedef unsigned short bf16;
typedef short bf16x8 __attribute__((ext_vector_type(8)));
typedef short s16x4 __attribute__((ext_vector_type(4)));
typedef float f32x4 __attribute__((ext_vector_type(4)));
typedef float f32x16 __attribute__((ext_vector_type(16)));
typedef unsigned u32x4 __attribute__((ext_vector_type(4)));
typedef unsigned u32x2 __attribute__((ext_vector_type(2)));

constexpr int D = 1024, NB = 8, SEQ = 2048, CTX = 256, DEPTH = 4, GW = 64;
constexpr int TL = NB * SEQ, TC = NB * CTX, T = TL + TC;
constexpr int IN_COLS = 5792, NZ = 1792;
constexpr int ZQ = 0, ZK = 256, ZV = 512, ZP = 768, ZF = 1024, ZCQ = 1280, ZCKV = 1536, ZKR = 1664, ZEND = 1696;
constexpr int NE = 16, FF = 2048, CAPL = 256, CAPC = 32, ESLOT = NB * CAPL + NB * CAPC;
constexpr float LN_EPS = 1e-5f;
constexpr float DN_ALPHA = 1.681792830507429f;
constexpr float LOG2E = 1.4426950408889634f;
constexpr float NA_QS = 0.125f * LOG2E;
constexpr float MLA_QS = 0.10206207261596575f * LOG2E;

constexpr size_t al256(size_t x) { return (x + 255) & ~(size_t)255; }
constexpr size_t WS_CTL = 0, CTL_BYTES = 1u << 20;
constexpr size_t WS_MOD = WS_CTL + CTL_BYTES;
constexpr size_t WS_ROPE = al256(WS_MOD + (size_t)DEPTH * 9 * 6144 * 4);
constexpr size_t WS_T64 = al256(WS_ROPE + 2048 * 32 * 4);
constexpr size_t WS_AFFT = al256(WS_T64 + 128 * 128 * 2);
constexpr size_t WS_AFFTC = al256(WS_AFFT + (size_t)2048 * 2048 * 2);
constexpr size_t WS_WIN = al256(WS_AFFTC + 256 * 256 * 2);
constexpr size_t WS_WG = al256(WS_WIN + (size_t)DEPTH * NZ * D * 2);
constexpr size_t WS_WUQ = al256(WS_WG + (size_t)DEPTH * 4096 * D * 2);
constexpr size_t WS_WUKV = al256(WS_WUQ + (size_t)DEPTH * 384 * 256 * 2);
constexpr size_t WS_WB = al256(WS_WUKV + (size_t)DEPTH * 512 * 128 * 2);
constexpr size_t WS_WO = al256(WS_WB + (size_t)DEPTH * 4 * D * 256 * 2);
constexpr size_t WS_WGU = al256(WS_WO + (size_t)DEPTH * D * D * 2);
constexpr size_t WS_WD = al256(WS_WGU + (size_t)DEPTH * NE * 4096 * D * 2);
constexpr size_t WS_H = al256(WS_WD + (size_t)DEPTH * NE * D * FF * 2);
constexpr size_t WS_X1 = al256(WS_H + (size_t)T * D * 4);
constexpr size_t WS_U1 = al256(WS_X1 + (size_t)T * D * 4);
constexpr size_t WS_U2 = al256(WS_U1 + (size_t)T * D * 2);
constexpr size_t WS_Z = al256(WS_U2 + (size_t)T * D * 2);
constexpr size_t WS_QM = al256(WS_Z + (size_t)T * NZ * 2);
constexpr size_t WS_KM = al256(WS_QM + (size_t)T * 384 * 2);
constexpr size_t WS_VM = al256(WS_KM + (size_t)T * 384 * 2);
constexpr size_t WS_FB = al256(WS_VM + (size_t)T * 256 * 2);
constexpr size_t WS_FBC = al256(WS_FB + (size_t)2048 * 2048 * 2);
constexpr size_t WS_Y = al256(WS_FBC + (size_t)2048 * 256 * 2);
constexpr size_t WS_P = al256(WS_Y + (size_t)4 * T * 256 * 2);
constexpr size_t WS_AFF = al256(WS_P + (size_t)T * 4096 * 2);
constexpr size_t WS_SLOT = al256(WS_AFF + (size_t)T * 16 * 4);
constexpr size_t WS_GATEV = al256(WS_SLOT + (size_t)T * 16 * 4);
constexpr size_t WS_SROW = al256(WS_GATEV + (size_t)NE * ESLOT * 4);
constexpr size_t WS_XE = al256(WS_SROW + (size_t)NE * ESLOT * 4);
constexpr size_t WS_ACT = al256(WS_XE + (size_t)NE * ESLOT * D * 2);
constexpr size_t WS_YE = al256(WS_ACT + (size_t)NE * ESLOT * FF * 2);
constexpr size_t WS_S = al256(WS_YE + (size_t)NE * ESLOT * D * 2);
constexpr size_t WS_ST1 = al256(WS_S + (size_t)T * D * 2);
constexpr size_t WS_END = al256(WS_ST1 + (size_t)T * 2 * 4);
static_assert(WS_END <= (size_t)2047 * 1024 * 1024, "workspace map exceeds 2 GiB");

constexpr int LDS_BYTES = 147456;
constexpr int LDS_MISC = 140 * 1024;

typedef __bf16 bf16x2_t __attribute__((ext_vector_type(2)));
typedef float f32x2_t __attribute__((ext_vector_type(2)));
__device__ __forceinline__ unsigned cvt_pk_bf16(float lo, float hi) { f32x2_t v = {lo, hi}; bf16x2_t b = __builtin_convertvector(v, bf16x2_t); return __builtin_bit_cast(unsigned, b); }
__device__ __forceinline__ float bf2f(unsigned short b) { return __uint_as_float(((unsigned)b) << 16); }
__device__ __forceinline__ float bflo(unsigned w) { return __uint_as_float(w << 16); }
__device__ __forceinline__ float bfhi(unsigned w) { return __uint_as_float(w & 0xffff0000u); }
__device__ __forceinline__ float wave_sum(float v) {
    v += __builtin_bit_cast(float, __builtin_amdgcn_update_dpp(0, __builtin_bit_cast(int, v), 0xB1, 0xf, 0xf, true));
    v += __builtin_bit_cast(float, __builtin_amdgcn_update_dpp(0, __builtin_bit_cast(int, v), 0x4E, 0xf, 0xf, true));
    v += __builtin_bit_cast(float, __builtin_amdgcn_update_dpp(0, __builtin_bit_cast(int, v), 0x141, 0xf, 0xf, true));
    v += __builtin_bit_cast(float, __builtin_amdgcn_update_dpp(0, __builtin_bit_cast(int, v), 0x140, 0xf, 0xf, true));
    const int iv = __builtin_bit_cast(int, v);
    const float a = __builtin_bit_cast(float, __builtin_amdgcn_readlane(iv, 0)), b = __builtin_bit_cast(float, __builtin_amdgcn_readlane(iv, 16));
    const float c = __builtin_bit_cast(float, __builtin_amdgcn_readlane(iv, 32)), d = __builtin_bit_cast(float, __builtin_amdgcn_readlane(iv, 48));
    return (a + b) + (c + d);
}
__device__ __forceinline__ float row16_sum(float v) {
    v += __builtin_bit_cast(float, __builtin_amdgcn_update_dpp(0, __builtin_bit_cast(int, v), 0xB1, 0xf, 0xf, true));
    v += __builtin_bit_cast(float, __builtin_amdgcn_update_dpp(0, __builtin_bit_cast(int, v), 0x4E, 0xf, 0xf, true));
    v += __builtin_bit_cast(float, __builtin_amdgcn_update_dpp(0, __builtin_bit_cast(int, v), 0x141, 0xf, 0xf, true));
    v += __builtin_bit_cast(float, __builtin_amdgcn_update_dpp(0, __builtin_bit_cast(int, v), 0x140, 0xf, 0xf, true));
    return v;
}
__device__ __forceinline__ unsigned wave_sum_u(unsigned v) {
    v += (unsigned)__builtin_amdgcn_update_dpp(0, (int)v, 0xB1, 0xf, 0xf, true);
    v += (unsigned)__builtin_amdgcn_update_dpp(0, (int)v, 0x4E, 0xf, 0xf, true);
    v += (unsigned)__builtin_amdgcn_update_dpp(0, (int)v, 0x141, 0xf, 0xf, true);
    v += (unsigned)__builtin_amdgcn_update_dpp(0, (int)v, 0x140, 0xf, 0xf, true);
    return (unsigned)__builtin_amdgcn_readlane((int)v, 0) + (unsigned)__builtin_amdgcn_readlane((int)v, 16) + (unsigned)__builtin_amdgcn_readlane((int)v, 32) + (unsigned)__builtin_amdgcn_readlane((int)v, 48);
}
__device__ __forceinline__ void st_wt8(void* p, u32x2 v) { __hip_atomic_store((unsigned long long*)p, ((unsigned long long)v.y << 32) | v.x, __ATOMIC_RELAXED, __HIP_MEMORY_SCOPE_AGENT); }
__device__ __forceinline__ void st_wt16(void* p, u32x4 v) { __hip_atomic_store((unsigned long long*)p, ((unsigned long long)v.y << 32) | v.x, __ATOMIC_RELAXED, __HIP_MEMORY_SCOPE_AGENT); __hip_atomic_store((unsigned long long*)p + 1, ((unsigned long long)v.w << 32) | v.z, __ATOMIC_RELAXED, __HIP_MEMORY_SCOPE_AGENT); }
__device__ __forceinline__ float fast_exp2(float x) { return __builtin_amdgcn_exp2f(x); }
__device__ __forceinline__ float silu_f(float x) { return x / (1.0f + __expf(-x)); }

#define XB_TMO      128
#define XB_XCNT(j)  (256  + 64 * (j))
#define XB_XSUB(j)  (1280 + 64 * (j))
#define XB_XGEN(j)  (2304 + 64 * (j))
#define XB_TOP      3328
#define XB_TOPGEN   3392
#define XCD_BAR_WORDS 3456
#define XB_SPIN_CAP (1u << 18)
__device__ __forceinline__ unsigned xb_ld(unsigned* p)              { return __hip_atomic_load(p, __ATOMIC_RELAXED, __HIP_MEMORY_SCOPE_AGENT); }
__device__ __forceinline__ unsigned xb_add(unsigned* p, unsigned v) { return __hip_atomic_fetch_add(p, v, __ATOMIC_RELAXED, __HIP_MEMORY_SCOPE_AGENT); }
__device__ __forceinline__ unsigned xb_xcc_id() { return (unsigned)__builtin_amdgcn_s_getreg((3 << 11) | 20) & 0xFu; }
#define XB_SPIN(cond, bar) do { unsigned _sp = 0; while (cond) { __builtin_amdgcn_s_sleep(1); \
    if ((++_sp & 255u) == 0u) { if (xb_ld(&(bar)[XB_TMO])) break; if (_sp > XB_SPIN_CAP) { atomicAdd(&(bar)[XB_TMO], 1u); break; } } } } while (0)
struct XcdBarrier { unsigned* bar; unsigned x; volatile LAS unsigned* st; };
__device__ __forceinline__ XcdBarrier xcd_barrier_post(unsigned* bar, volatile LAS unsigned* st) {
    XcdBarrier b; b.bar = bar; b.x = xb_xcc_id(); b.st = st;
    if (threadIdx.x == 0) (void)xb_add(&bar[XB_XCNT(b.x)], 1u);
    return b;
}
__device__ __forceinline__ void xcd_barrier_complete(unsigned* bar, unsigned x, unsigned& nloc, unsigned& nx) {
    const unsigned G = gridDim.x * gridDim.y * gridDim.z;
    unsigned sum, cnt, mine, sp = 0u;
    for (;;) {
        sum = 0u; cnt = 0u; mine = 0u;
#pragma unroll
        for (unsigned j = 0; j < 16; ++j) { const unsigned c = xb_ld(&bar[XB_XCNT(j)]); sum += c; cnt += (c > 0u) ? 1u : 0u; mine = (j == x) ? c : mine; }
        if (sum == G) break;
        __builtin_amdgcn_s_sleep(1);
        if ((++sp & 255u) == 0u) { if (xb_ld(&bar[XB_TMO])) break; if (sp > XB_SPIN_CAP) { atomicAdd(&bar[XB_TMO], 1u); break; } }
    }
    nloc = mine > 0u ? mine : 1u; nx = cnt > 0u ? cnt : 1u;
}
__device__ __forceinline__ void xcd_barrier(const XcdBarrier& b) {
    asm volatile("s_waitcnt vmcnt(0)" ::: "memory");
    __syncthreads();
    if (threadIdx.x == 0) {
        unsigned* bar = b.bar;
        __builtin_amdgcn_s_waitcnt(0);
        unsigned nloc = b.st[0], nx = b.st[1];
        if (nloc == 0u) { xcd_barrier_complete(bar, b.x, nloc, nx); b.st[0] = nloc; b.st[1] = nx; }
        const unsigned old = xb_add(&bar[XB_XSUB(b.x)], 1u);
        const unsigned gen = old / nloc;
        if (old + 1u == (gen + 1u) * nloc) {
            __builtin_amdgcn_fence(__ATOMIC_RELEASE, "agent");
            asm volatile("s_waitcnt vmcnt(0)" ::: "memory");
            const unsigned og = xb_add(&bar[XB_TOP], 1u);
            const unsigned tg = og / nx;
            if (og + 1u == (tg + 1u) * nx) xb_add(&bar[XB_TOPGEN], 1u);
            else XB_SPIN(xb_ld(&bar[XB_TOPGEN]) == tg, bar);
            __builtin_amdgcn_fence(__ATOMIC_ACQUIRE, "agent");
            xb_add(&bar[XB_XGEN(b.x)], 1u);
            asm volatile("s_waitcnt vmcnt(0)" ::: "memory");
        } else {
            XB_SPIN(xb_ld(&bar[XB_XGEN(b.x)]) == gen, bar);
            __builtin_amdgcn_fence(__ATOMIC_ACQUIRE, "agent");
            asm volatile("s_waitcnt vmcnt(0)" ::: "memory");
        }
    }
    __syncthreads();
}

struct Args {
    const float* in[24];
    float* out;
    unsigned char* ws;
    int ph_lo, ph_hi;
};
enum { I_X = 0, I_C, I_CTX, I_CCTX, I_WMOD, I_BMOD, I_WIN, I_RPB, I_POOLW, I_POOLS, I_QNORM, I_WUQ, I_KVNORM, I_WUKV, I_WBR, I_WOUT,
       I_LN1G, I_LN1B, I_WROUTER, I_WGATE, I_WUP, I_WDOWN, I_LN2G, I_LN2B };

struct Ctx {
    LAS unsigned char* lds;
    GAS unsigned char* ws;
    const float* const* in;
    float* out;
    int tid, lane, wave, bid, G;
};
#define WSP(T_, off) ((T_*)(GAS T_*)(C.ws + (off)))

__device__ __forceinline__ void l2_touch(const Ctx& C, const void* p) {
    __builtin_amdgcn_global_load_lds((const unsigned*)p, (LAS unsigned*)(C.lds + 136 * 1024), 4, 0, 0);
}

__device__ __forceinline__ int mod_row(int row) { return row < TL ? (row >> 11) : 8; }

constexpr int SG_TILE_B = 128 * 128;
constexpr int SG_LDS = 4 * SG_TILE_B;
template <class AF, class BF, class BS, class EPI>
__device__ __forceinline__ void sgemm_tile_s(const Ctx& C, AF arow, BF brow, BS bstep, int K, EPI epi) {
    const int tid = C.tid, lane = C.lane, wid = C.wave, wr = wid >> 2, wc = wid & 3, fr = lane & 15, fq = lane >> 4;
    LAS unsigned char* lds = C.lds;
    const bf16* ap[2]; const bf16* bp[2]; int lo[2]; long bst[2];
#pragma unroll
    for (int i = 0; i < 2; ++i) { const int c = tid + 512 * i, r = c >> 3, kc = c & 7; ap[i] = arow(r) + kc * 8; bp[i] = brow(r) + kc * 8; bst[i] = bstep(r); lo[i] = r * 128 + ((kc ^ ((r >> 1) & 7)) << 4); }
    f32x4 acc[4][2];
#pragma unroll
    for (int m = 0; m < 4; ++m)
#pragma unroll
        for (int n = 0; n < 2; ++n) acc[m][n] = (f32x4){0.f, 0.f, 0.f, 0.f};
    u32x4 ra0[2], rb0[2], ra1[2], rb1[2];
    const int nt = K >> 6;
    const int sw = (fr >> 1) & 7;
    const int ra_off = (wr * 64 + fr) * 128, rb_off = (wc * 32 + fr) * 128;
#define SG_GLOAD(RA, RB, t) do { const int ka_ = (t) * 64; _Pragma("unroll") for (int i = 0; i < 2; ++i) { RA[i] = *(const u32x4*)(ap[i] + ka_); RB[i] = *(const u32x4*)(bp[i] + (long)(t) * bst[i]); } } while (0)
#define SG_LSTORE(RA, RB, buf) do { _Pragma("unroll") for (int i = 0; i < 2; ++i) { *(LAS u32x4*)(lds + (buf) * SG_TILE_B + lo[i]) = RA[i]; *(LAS u32x4*)(lds + (2 + (buf)) * SG_TILE_B + lo[i]) = RB[i]; } } while (0)
#define SG_COMPUTE(buf) do { const LAS unsigned char* la = lds + (buf) * SG_TILE_B + ra_off; const LAS unsigned char* lb = lds + (2 + (buf)) * SG_TILE_B + rb_off; \
        _Pragma("unroll") for (int kk = 0; kk < 2; ++kk) { bf16x8 af[4], bfr[2]; const int co = (((4 * kk + fq) ^ sw) << 4); \
            _Pragma("unroll") for (int m = 0; m < 4; ++m) af[m] = *(const LAS bf16x8*)(la + m * 2048 + co); \
            _Pragma("unroll") for (int n = 0; n < 2; ++n) bfr[n] = *(const LAS bf16x8*)(lb + n * 2048 + co); \
            _Pragma("unroll") for (int m = 0; m < 4; ++m) _Pragma("unroll") for (int n = 0; n < 2; ++n) acc[m][n] = __builtin_amdgcn_mfma_f32_16x16x32_bf16(bfr[n], af[m], acc[m][n], 0, 0, 0); } } while (0)
    SG_GLOAD(ra0, rb0, 0);
    if (nt > 1) SG_GLOAD(ra1, rb1, 1);
    SG_LSTORE(ra0, rb0, 0);
    __syncthreads();
    for (int t = 0; t < nt; t += 2) {
        if (t + 2 < nt) SG_GLOAD(ra0, rb0, t + 2);
        SG_COMPUTE(0);
        if (t + 1 < nt) SG_LSTORE(ra1, rb1, 1);
        __syncthreads();
        if (t + 1 >= nt) break;
        if (t + 3 < nt) SG_GLOAD(ra1, rb1, t + 3);
        SG_COMPUTE(1);
        if (t + 2 < nt) SG_LSTORE(ra0, rb0, 0);
        __syncthreads();
    }
#undef SG_GLOAD
#undef SG_LSTORE
#undef SG_COMPUTE
    epi(acc, wr, wc, fr, fq);
    __syncthreads();
}
template <class AF, class BF, class EPI>
__device__ __forceinline__ void sgemm_tile(const Ctx& C, AF arow, BF brow, int K, int, EPI epi) { sgemm_tile_s(C, arow, brow, [](int) { return 64L; }, K, epi); }
template <class AF, class BF, class EPI>
__device__ __forceinline__ void sgemm_tile_d4(const Ctx& C, AF arow, BF brow, int K, EPI epi) {
    const int tid = C.tid, lane = C.lane, wid = C.wave, wr = wid >> 2, wc = wid & 3, fr = lane & 15, fq = lane >> 4;
    LAS unsigned char* lds = C.lds;
    const bf16* ap[2]; const bf16* bp[2]; int lo[2];
#pragma unroll
    for (int i = 0; i < 2; ++i) { const int c = tid + 512 * i, r = c >> 3, kc = c & 7; ap[i] = arow(r) + kc * 8; bp[i] = brow(r) + kc * 8; lo[i] = r * 128 + ((kc ^ ((r >> 1) & 7)) << 4); }
    f32x4 acc[4][2];
#pragma unroll
    for (int m = 0; m < 4; ++m)
#pragma unroll
        for (int n = 0; n < 2; ++n) acc[m][n] = (f32x4){0.f, 0.f, 0.f, 0.f};
    u32x4 ra[4][2], rb[4][2];
    const int nt = K >> 6;
    const int sw = (fr >> 1) & 7;
    const int ra_off = (wr * 64 + fr) * 128, rb_off = (wc * 32 + fr) * 128;
#define SG_GLOAD(q, t) do { const int ka_ = (t) * 64; _Pragma("unroll") for (int i = 0; i < 2; ++i) { ra[q][i] = *(const u32x4*)(ap[i] + ka_); rb[q][i] = *(const u32x4*)(bp[i] + ka_); } } while (0)
#define SG_LSTORE(q, buf) do { _Pragma("unroll") for (int i = 0; i < 2; ++i) { *(LAS u32x4*)(lds + (buf) * SG_TILE_B + lo[i]) = ra[q][i]; *(LAS u32x4*)(lds + (2 + (buf)) * SG_TILE_B + lo[i]) = rb[q][i]; } } while (0)
#define SG_COMPUTE(buf) do { const LAS unsigned char* la = lds + (buf) * SG_TILE_B + ra_off; const LAS unsigned char* lb = lds + (2 + (buf)) * SG_TILE_B + rb_off; \
        _Pragma("unroll") for (int kk = 0; kk < 2; ++kk) { bf16x8 af[4], bfr[2]; const int co = (((4 * kk + fq) ^ sw) << 4); \
            _Pragma("unroll") for (int m = 0; m < 4; ++m) af[m] = *(const LAS bf16x8*)(la + m * 2048 + co); \
            _Pragma("unroll") for (int n = 0; n < 2; ++n) bfr[n] = *(const LAS bf16x8*)(lb + n * 2048 + co); \
            _Pragma("unroll") for (int m = 0; m < 4; ++m) _Pragma("unroll") for (int n = 0; n < 2; ++n) acc[m][n] = __builtin_amdgcn_mfma_f32_16x16x32_bf16(bfr[n], af[m], acc[m][n], 0, 0, 0); } } while (0)
    SG_GLOAD(0, 0);
    if (nt > 1) SG_GLOAD(1, 1);
    if (nt > 2) SG_GLOAD(2, 2);
    if (nt > 3) SG_GLOAD(3, 3);
    SG_LSTORE(0, 0);
    __syncthreads();
    for (int t = 0; t < nt; t += 4) {
#pragma unroll
        for (int q = 0; q < 4; ++q) {
            if (t + q < nt) {
                if (t + q + 4 < nt) SG_GLOAD(q, t + q + 4);
                SG_COMPUTE(q & 1);
                if (t + q + 1 < nt) SG_LSTORE((q + 1) & 3, (q + 1) & 1);
                __syncthreads();
            }
        }
    }
#undef SG_GLOAD
#undef SG_LSTORE
#undef SG_COMPUTE
    epi(acc, wr, wc, fr, fq);
    __syncthreads();
}

namespace g8 {
constexpr int BM = 256, BK = 64, HALF = 128, HTB = HALF * BK * 2, STAGE_BYTES = 8 * HTB;
__device__ __forceinline__ int lds_byte(int r, int c) { const int st = (r >> 4) * 2 + (c >> 5), rr = r & 15, cc = c & 31, ob = rr * 64 + cc * 2; return st * 1024 + (ob ^ (((ob >> 9) & 1) << 5)); }
__device__ __forceinline__ void stage_rc(int b, int& R, int& C) { const int st = b / 1024, sb = b % 1024, swz = sb ^ (((sb >> 9) & 1) << 5); R = (st >> 1) * 16 + swz / 64; C = (st & 1) * 32 + (swz % 64) / 2; }
__device__ __forceinline__ int perm32(int rho) { const int n = rho >> 4, i = rho & 15; return 8 * (i >> 2) + 4 * n + (i & 3); }
struct Unit { const char* A; const char* B; int r0, c0, x; };
template <class Epi, class Sched, bool GATHER = false>
__device__ __forceinline__ void gemm_phase(LAS unsigned char* lds, const int K, const unsigned lda, const unsigned ldb, const Sched& S, const Epi& E, const int tid, const LAS int* srow = nullptr) {
    const int wid = __builtin_amdgcn_readfirstlane(tid >> 6), lane = tid & 63, wr = wid >> 2, wc = wid & 3, fr = lane & 15, fq = lane >> 4;
    const int nt = K / BK;
    unsigned voffA[2], voffB[2], vA1[2], nA0[2], nA1[2]; int gR[2]; unsigned gC[2];
#pragma unroll
    for (int i = 0; i < 2; ++i) { int R, Cc; stage_rc(tid * 16 + i * 8192, R, Cc); const int Rb = Epi::PERM ? ((R & ~31) + perm32(R & 31)) : R;
        voffA[i] = (unsigned)R * lda + (unsigned)Cc * 2u; voffB[i] = (unsigned)Rb * ldb + (unsigned)Cc * 2u; gR[i] = R; gC[i] = (unsigned)Cc * 2u; vA1[i] = voffA[i]; nA0[i] = voffA[i]; nA1[i] = voffA[i]; }
    if constexpr (GATHER) {
#pragma unroll
        for (int i = 0; i < 2; ++i) { voffA[i] = (unsigned)srow[gR[i]] * lda + gC[i]; vA1[i] = (unsigned)srow[128 + gR[i]] * lda + gC[i]; }
    }
    const size_t kstep = (size_t)(BK * 2);
    const size_t hstepA = GATHER ? (size_t)0 : (size_t)HALF * lda, hstepB = (size_t)HALF * ldb;
    const unsigned ldsw = (unsigned)wid * 1024u;
    const int aoff = lds_byte(wr * 64 + fr, fq * 8), boff = lds_byte(wc * 32 + fr, fq * 8);
#define PG8_SA(b, h) (((b) * 2 + (h)) * HTB)
#define PG8_SB(b, h) ((4 + (b) * 2 + (h)) * HTB)
#define PG8_STAGE(bufoff, gbase, voff) do { _Pragma("unroll") for (int _i = 0; _i < 2; ++_i) \
        __builtin_amdgcn_global_load_lds((const unsigned*)((const char*)(gbase) + (voff)[_i]), (LAS unsigned*)(lds + (bufoff) + ldsw + _i * 8192), 16, 0, 0); } while (0)
#define PG8_LDA(dst, b, h) do { _Pragma("unroll") for (int m = 0; m < 4; ++m) _Pragma("unroll") for (int k = 0; k < 2; ++k) dst[m][k] = *(const LAS bf16x8*)(lds + PG8_SA(b, h) + aoff + m * 2048 + k * 1024); } while (0)
#define PG8_LDB(dst, b, h) do { _Pragma("unroll") for (int n = 0; n < 2; ++n) _Pragma("unroll") for (int k = 0; k < 2; ++k) dst[n][k] = *(const LAS bf16x8*)(lds + PG8_SB(b, h) + boff + n * 2048 + k * 1024); } while (0)
#define PG8_MMA(ai, bj, At, Bt) do { __builtin_amdgcn_s_setprio(1); _Pragma("unroll") for (int m = 0; m < 4; ++m) _Pragma("unroll") for (int n = 0; n < 2; ++n) _Pragma("unroll") for (int k = 0; k < 2; ++k) \
        acc[ai][bj][m][n] = __builtin_amdgcn_mfma_f32_16x16x32_bf16(Bt[n][k], At[m][k], acc[ai][bj][m][n], 0, 0, 0); __builtin_amdgcn_s_setprio(0); } while (0)
#define PG8_WAIT_V(n) asm volatile("s_waitcnt vmcnt(" #n ")" ::: "memory")
#define PG8_WAIT_L(n) asm volatile("s_waitcnt lgkmcnt(" #n ")" ::: "memory")
#define PG8_BAR __builtin_amdgcn_s_barrier()
#define PG8_SCHED __builtin_amdgcn_sched_barrier(0)
    Unit cur, nxt; int ui = 0;
    if (!S.next(0, cur)) return;
    f32x4 acc[2][2][4][2];
#pragma unroll
    for (int a = 0; a < 2; ++a)
#pragma unroll
        for (int b = 0; b < 2; ++b)
#pragma unroll
            for (int m = 0; m < 4; ++m)
#pragma unroll
                for (int n = 0; n < 2; ++n) acc[a][b][m][n] = (f32x4){0.f, 0.f, 0.f, 0.f};
    bf16x8 At[4][2], B0[2][2], B1[2][2];
    const char* cA = cur.A; const char* cB = cur.B;
    PG8_STAGE(PG8_SB(0, 0), cB, voffB); PG8_STAGE(PG8_SB(0, 1), cB + hstepB, voffB); PG8_STAGE(PG8_SA(0, 0), cA, voffA); PG8_STAGE(PG8_SA(0, 1), cA + hstepA, vA1);
    if (wr == 1) PG8_BAR;
    PG8_WAIT_V(2); PG8_BAR;
    PG8_STAGE(PG8_SB(1, 0), cB + kstep, voffB); PG8_STAGE(PG8_SA(1, 0), cA + kstep, voffA); PG8_STAGE(PG8_SB(1, 1), cB + hstepB + kstep, voffB);
    PG8_WAIT_V(6); PG8_BAR;
    for (;;) {
        const bool has_next = S.next(ui + 1, nxt);
        const char* nA = has_next ? nxt.A : cA; const char* nB = has_next ? nxt.B : cB;
        if constexpr (GATHER) {
#pragma unroll
            for (int i = 0; i < 2; ++i) { nA0[i] = has_next ? (unsigned)srow[256 * (ui + 1) + gR[i]] * lda + gC[i] : voffA[i]; nA1[i] = has_next ? (unsigned)srow[256 * (ui + 1) + 128 + gR[i]] * lda + gC[i] : vA1[i]; }
        }
#pragma clang loop unroll(disable)
        for (int t = 0; t < nt; t += 2) {
            const bool last = (t == nt - 2);
            const char* a1 = cA + (size_t)(t + 1) * kstep;
            const char* a2 = last ? nA : cA + (size_t)(t + 2) * kstep; const char* b2 = last ? nB : cB + (size_t)(t + 2) * kstep;
            const char* a3 = a2 + kstep; const char* b3 = b2 + kstep;
            unsigned sA0[2], sA1[2];
#pragma unroll
            for (int i = 0; i < 2; ++i) { sA0[i] = (GATHER && last) ? nA0[i] : voffA[i]; sA1[i] = (GATHER && last) ? nA1[i] : vA1[i]; }
            PG8_LDB(B0, 0, 0); PG8_LDB(B1, 0, 1); PG8_SCHED; PG8_LDA(At, 0, 0); PG8_STAGE(PG8_SA(1, 1), a1 + hstepA, vA1);
            PG8_WAIT_V(8); PG8_WAIT_L(0); PG8_BAR; PG8_MMA(0, 0, At, B0); PG8_MMA(0, 1, At, B1); PG8_BAR; PG8_SCHED;
            PG8_LDA(At, 0, 1); PG8_STAGE(PG8_SB(0, 0), b2, voffB); PG8_STAGE(PG8_SB(0, 1), b2 + hstepB, voffB); PG8_STAGE(PG8_SA(0, 0), a2, sA0);
            PG8_WAIT_V(8); PG8_WAIT_L(0); PG8_BAR; PG8_MMA(1, 0, At, B0); PG8_MMA(1, 1, At, B1); PG8_BAR; PG8_SCHED;
            PG8_LDB(B0, 1, 0); PG8_LDB(B1, 1, 1); PG8_SCHED; PG8_LDA(At, 1, 0); PG8_STAGE(PG8_SA(0, 1), a2 + hstepA, sA1);
            PG8_WAIT_V(8); PG8_WAIT_L(0); PG8_BAR; PG8_MMA(0, 0, At, B0); PG8_MMA(0, 1, At, B1); PG8_BAR; PG8_SCHED;
            PG8_LDA(At, 1, 1); PG8_STAGE(PG8_SB(1, 0), b3, voffB); PG8_STAGE(PG8_SB(1, 1), b3 + hstepB, voffB); PG8_STAGE(PG8_SA(1, 0), a3, sA0);
            PG8_WAIT_V(8); PG8_WAIT_L(0); PG8_BAR; PG8_MMA(1, 0, At, B0); PG8_MMA(1, 1, At, B1); PG8_BAR; PG8_SCHED;
        }
        if (wr == 0) PG8_BAR;
        E(acc, cur, wr, wc, fr, fq);
        if (!has_next) break;
#pragma unroll
        for (int a = 0; a < 2; ++a)
#pragma unroll
            for (int b = 0; b < 2; ++b)
#pragma unroll
                for (int m = 0; m < 4; ++m)
#pragma unroll
                    for (int n = 0; n < 2; ++n) acc[a][b][m][n] = (f32x4){0.f, 0.f, 0.f, 0.f};
        cur = nxt; cA = nA; cB = nB; ++ui;
        if constexpr (GATHER) {
#pragma unroll
            for (int i = 0; i < 2; ++i) { voffA[i] = nA0[i]; vA1[i] = nA1[i]; }
        }
        if (wr == 1) PG8_BAR;
    }
    PG8_WAIT_V(0);
    PG8_BAR;
#undef PG8_SA
#undef PG8_SB
#undef PG8_STAGE
#undef PG8_LDA
#undef PG8_LDB
#undef PG8_MMA
#undef PG8_WAIT_V
#undef PG8_WAIT_L
#undef PG8_BAR
#undef PG8_SCHED
}
}

constexpr int AT_VS = 192;
template <int DK, bool WIN>
__device__ __forceinline__ void attn_unit(const Ctx& C,
        const bf16* qrow0, size_t ldq,
        const bf16* k0, const bf16* v0, int n0t,
        const bf16* k1, const bf16* v1, int n1t,
        size_t ldk, size_t ldv,
        bf16* orow0, size_t ldo,
        int w_lo, int w_hi, int dr0, int qc0, const LAS float* btab) {
    constexpr int KS = DK * 2 + 16;
    constexpr int KBUF = 64 * KS, VBUF = 64 * AT_VS;
    constexpr int KCH = DK / 8;
    constexpr int NS = DK / 16;
    const int tid = C.tid, lane = C.lane, l31 = lane & 31, h = lane >> 5;
    LAS unsigned char* lds = C.lds;
    LAS unsigned char* ldsK = lds; LAS unsigned char* ldsV = lds + 2 * KBUF;
    bf16x8 qf[NS];
#pragma unroll
    for (int s = 0; s < NS; ++s) qf[s] = *(const bf16x8*)(qrow0 + (size_t)l31 * ldq + 16 * s + 8 * h);
    f32x16 O0, O1;
#pragma unroll
    for (int i = 0; i < 16; ++i) { O0[i] = 0.f; O1[i] = 0.f; }
    float mrun = 0.f, lsum = 0.f;
    const int kc0 = tid, kr0 = kc0 / KCH, kk0 = kc0 % KCH;
    const int kc1 = tid + 512, kr1 = kc1 / KCH, kk1 = kc1 % KCH;
    constexpr bool HAS1 = (64 * KCH > 512);
    const bool has1 = HAS1 && (kc1 < 64 * KCH);
    const int vr = tid >> 3, vk = tid & 7;
    const int nt = n0t + n1t;
    u32x4 rk0, rk1, rv;
    auto gload = [&](int j, u32x4& a0, u32x4& a1, u32x4& av) {
        const bf16* kb = (j < n0t) ? k0 + (size_t)j * 64 * ldk : k1 + (size_t)(j - n0t) * 64 * ldk;
        const bf16* vb = (j < n0t) ? v0 + (size_t)j * 64 * ldv : v1 + (size_t)(j - n0t) * 64 * ldv;
        a0 = *(const u32x4*)(kb + (size_t)kr0 * ldk + kk0 * 8);
        if constexpr (HAS1) { if (has1) a1 = *(const u32x4*)(kb + (size_t)kr1 * ldk + kk1 * 8); }
        av = *(const u32x4*)(vb + (size_t)vr * ldv + vk * 8);
    };
    auto lstore = [&](int b, int vb3, const u32x4& a0, const u32x4& a1, const u32x4& av) {
        *(LAS u32x4*)(ldsK + b * KBUF + kr0 * KS + kk0 * 16) = a0;
        if constexpr (HAS1) { if (has1) *(LAS u32x4*)(ldsK + b * KBUF + kr1 * KS + kk1 * 16) = a1; }
        *(LAS u32x4*)(ldsV + vb3 * VBUF + vr * AT_VS + vk * 16) = av;
    };
    gload(0, rk0, rk1, rv);
    lstore(0, 0, rk0, rk1, rv);
    __syncthreads();
    const int trb = (4 * h + ((lane & 15) >> 2)) * AT_VS + (16 * ((lane >> 4) & 1) + 4 * (lane & 3)) * 2;
    int cq = qc0 + l31; asm volatile("" : "+v"(cq));
    int c0w = cq - 8; c0w = c0w < 0 ? 0 : (c0w > 48 ? 48 : c0w);
    const int mbase = 4 * h - c0w, bbase = 4 * h - cq + 15;
    const bool grpB = C.wave >= 4;
    union VF { bf16x8 v; s16x4 hlf[2]; };
    unsigned pfk[2][2][4];
#pragma unroll
    for (int a_ = 0; a_ < 2; ++a_)
#pragma unroll
        for (int b_ = 0; b_ < 2; ++b_)
#pragma unroll
            for (int c_ = 0; c_ < 4; ++c_) pfk[a_][b_][c_] = 0u;
    bool pend = false; int pend_vb = 0;
    auto vread = [&](int vbuf, VF (&vfr)[2][2][2]) {
        const LAS unsigned char* vb = ldsV + vbuf * VBUF + trb;
#pragma unroll
        for (int kb3 = 0; kb3 < 2; ++kb3)
#pragma unroll
            for (int s2 = 0; s2 < 2; ++s2)
#pragma unroll
                for (int db = 0; db < 2; ++db) { const int rowoff = (32 * kb3 + 16 * s2) * AT_VS;
                    vfr[kb3][s2][db].hlf[0] = __builtin_amdgcn_ds_read_tr16_b64_v4i16((LAS s16x4*)(vb + rowoff + db * 64));
                    vfr[kb3][s2][db].hlf[1] = __builtin_amdgcn_ds_read_tr16_b64_v4i16((LAS s16x4*)(vb + rowoff + 8 * AT_VS + db * 64)); }
    };
    auto pvmma = [&](const VF (&vfr)[2][2][2]) {
#pragma unroll
        for (int kb3 = 0; kb3 < 2; ++kb3)
#pragma unroll
            for (int s2 = 0; s2 < 2; ++s2) {
                union { bf16x8 v; unsigned u[4]; } pf;
#pragma unroll
                for (int q = 0; q < 4; ++q) pf.u[q] = pfk[kb3][s2][q];
                O0 = __builtin_amdgcn_mfma_f32_32x32x16_bf16(vfr[kb3][s2][0].v, pf.v, O0, 0, 0, 0);
                O1 = __builtin_amdgcn_mfma_f32_32x32x16_bf16(vfr[kb3][s2][1].v, pf.v, O1, 0, 0, 0);
            }
    };
    int vcur = 0;
    for (int j = 0; j < nt; ++j) {
        const int cur = j & 1; const int vnxt = (vcur == 2) ? 0 : vcur + 1;
        if (j + 1 < nt) gload(j + 1, rk0, rk1, rv);
        const bool act = !WIN || j < n0t || ((j - n0t) >= w_lo && (j - n0t) < w_hi);
        if (grpB && pend) { VF vfr[2][2][2]; vread(pend_vb, vfr); __builtin_amdgcn_sched_barrier(0); pvmma(vfr); pend = false; }
        if (act) {
            f32x16 S0, S1;
            const float nm = -mrun;
#pragma unroll
            for (int i = 0; i < 16; ++i) { S0[i] = nm; S1[i] = nm; }
            const LAS unsigned char* kb = ldsK + cur * KBUF + l31 * KS + 16 * h;
#pragma unroll
            for (int hs = 0; hs < 2; ++hs) {
                bf16x8 kfa[NS / 2], kfb[NS / 2];
#pragma unroll
                for (int s = 0; s < NS / 2; ++s) { kfa[s] = *(const LAS bf16x8*)(kb + 32 * (hs * (NS / 2) + s)); kfb[s] = *(const LAS bf16x8*)(kb + 32 * KS + 32 * (hs * (NS / 2) + s)); }
                __builtin_amdgcn_sched_barrier(0);
#pragma unroll
                for (int s = 0; s < NS / 2; ++s) {
                    S0 = __builtin_amdgcn_mfma_f32_32x32x16_bf16(kfa[s], qf[hs * (NS / 2) + s], S0, 0, 0, 0);
                    S1 = __builtin_amdgcn_mfma_f32_32x32x16_bf16(kfb[s], qf[hs * (NS / 2) + s], S1, 0, 0, 0);
                }
                __builtin_amdgcn_sched_barrier(0);
            }
            VF vfa[2][2][2];
            if (!grpB) { vread(vcur, vfa); __builtin_amdgcn_sched_barrier(0); }
            if (WIN && j >= n0t) {
                int mb = mbase; asm volatile("" : "+v"(mb));
                const LAS float* bt = btab + ((j - n0t) + dr0) * 31 + bbase;
                float bv0[16], bv1[16];
#pragma unroll
                for (int i = 0; i < 16; ++i) { const int kci = (i & 3) + 8 * (i >> 2); bv0[i] = bt[kci]; bv1[i] = bt[kci + 32]; }
#pragma unroll
                for (int i = 0; i < 16; ++i) asm volatile("" : "+v"(bv0[i]), "+v"(bv1[i]));
#pragma unroll
                for (int i = 0; i < 16; ++i) {
                    const int kci = (i & 3) + 8 * (i >> 2);
                    S0[i] = ((unsigned)(kci + mb) < 16u) ? S0[i] + bv0[i] : -1e30f;
                    S1[i] = ((unsigned)(kci + 32 + mb) < 16u) ? S1[i] + bv1[i] : -1e30f;
                }
            }
            float mx = fmaxf(S0[0], S1[0]);
#pragma unroll
            for (int i = 1; i < 16; ++i) mx = fmaxf(mx, fmaxf(S0[i], S1[i]));
            mx = fmaxf(mx, __shfl_xor(mx, 32));
            if (__any(mx > 8.0f)) {
                const float dl = fmaxf(mx, 0.f), alpha = fast_exp2(-dl);
                mrun += dl; lsum *= alpha;
#pragma unroll
                for (int i = 0; i < 16; ++i) { S0[i] -= dl; S1[i] -= dl; O0[i] *= alpha; O1[i] *= alpha; }
            }
            float ps = 0.f;
#pragma unroll
            for (int i = 0; i < 16; ++i) { S0[i] = fast_exp2(S0[i]); S1[i] = fast_exp2(S1[i]); ps += S0[i] + S1[i]; }
            lsum += ps;
#pragma unroll
            for (int s2 = 0; s2 < 2; ++s2)
#pragma unroll
                for (int q = 0; q < 4; ++q) { pfk[0][s2][q] = cvt_pk_bf16(S0[8 * s2 + 2 * q], S0[8 * s2 + 2 * q + 1]); pfk[1][s2][q] = cvt_pk_bf16(S1[8 * s2 + 2 * q], S1[8 * s2 + 2 * q + 1]); }
            if (!grpB) pvmma(vfa); else { pend = true; pend_vb = vcur; }
        }
        if (j + 1 < nt) lstore(cur ^ 1, vnxt, rk0, rk1, rv);
        __syncthreads();
        vcur = vnxt;
    }
    if (grpB && pend) { VF vfr[2][2][2]; vread(pend_vb, vfr); pvmma(vfr); }
    const float ltot = lsum + __shfl_xor(lsum, 32);
    const float inv = 1.0f / ltot;
    bf16* op = orow0 + (size_t)l31 * ldo + 4 * h;
#pragma unroll
    for (int g = 0; g < 4; ++g) {
        u32x2 w0, w1;
        w0.x = cvt_pk_bf16(O0[4 * g] * inv, O0[4 * g + 1] * inv); w0.y = cvt_pk_bf16(O0[4 * g + 2] * inv, O0[4 * g + 3] * inv);
        w1.x = cvt_pk_bf16(O1[4 * g] * inv, O1[4 * g + 1] * inv); w1.y = cvt_pk_bf16(O1[4 * g + 2] * inv, O1[4 * g + 3] * inv);
        *(u32x2*)(op + 8 * g) = w0;
        *(u32x2*)(op + 32 + 8 * g) = w1;
    }
}

template <class RM>
__device__ __forceinline__ void tconv64(const float* W, size_t ldw, int k0, int n0, int N, const float* kscale, RM rm, int lane) {
    const int q = lane >> 4, c = lane & 15, ncol = n0 + 4 * c;
    if (ncol >= N) return;
    const float* src = W + (size_t)(k0 + 16 * q) * ldw + ncol;
    f32x4 v[16];
#pragma unroll
    for (int i = 0; i < 16; ++i) v[i] = __builtin_nontemporal_load((const f32x4*)(src + (size_t)i * ldw));
    if (kscale) {
#pragma unroll
        for (int i = 0; i < 16; ++i) v[i] = v[i] * kscale[k0 + 16 * q + i];
    }
#pragma unroll
    for (int j = 0; j < 4; ++j) {
        float cs; bf16* dst = rm(ncol + j, cs);
        u32x4 o0, o1;
        o0.x = cvt_pk_bf16(v[0][j] * cs, v[1][j] * cs); o0.y = cvt_pk_bf16(v[2][j] * cs, v[3][j] * cs); o0.z = cvt_pk_bf16(v[4][j] * cs, v[5][j] * cs); o0.w = cvt_pk_bf16(v[6][j] * cs, v[7][j] * cs);
        o1.x = cvt_pk_bf16(v[8][j] * cs, v[9][j] * cs); o1.y = cvt_pk_bf16(v[10][j] * cs, v[11][j] * cs); o1.z = cvt_pk_bf16(v[12][j] * cs, v[13][j] * cs); o1.w = cvt_pk_bf16(v[14][j] * cs, v[15][j] * cs);
        *(u32x4*)(dst + k0 + 16 * q) = o0; *(u32x4*)(dst + k0 + 16 * q + 8) = o1;
    }
}
__device__ __forceinline__ void conv_gu_item(const Ctx& C, int L, int idx) {
    const int le = L * NE + (idx >> 9), t = idx & 511, kb = t >> 5, nb = t & 31;
    bf16* wgu = WSP(bf16, WS_WGU) + (size_t)le * 4096 * D;
    { auto rm = [=](int n, float& cs) -> bf16* { cs = 1.0f; return wgu + (size_t)(256 * (n >> 7) + (n & 127)) * D; };
      tconv64(C.in[I_WGATE] + (size_t)le * D * FF, FF, kb * 64, nb * 64, FF, nullptr, rm, C.lane); }
    { auto rm = [=](int n, float& cs) -> bf16* { cs = 1.0f; return wgu + (size_t)(256 * (n >> 7) + 128 + (n & 127)) * D; };
      tconv64(C.in[I_WUP] + (size_t)le * D * FF, FF, kb * 64, nb * 64, FF, nullptr, rm, C.lane); }
}
__device__ __forceinline__ void conv_dn_item(const Ctx& C, int L, int idx) {
    const int le = L * NE + (idx >> 9), t = idx & 511, kb = t >> 4, nb = t & 15;
    bf16* wd = WSP(bf16, WS_WD) + (size_t)le * D * FF;
    auto rm = [=](int n, float& cs) -> bf16* { cs = 1.0f; return wd + (size_t)n * FF; };
    tconv64(C.in[I_WDOWN] + (size_t)le * FF * D, D, kb * 64, nb * 64, D, nullptr, rm, C.lane);
}
constexpr int GU_C2_CNT = 3, GU_C2_FIRST = 0, GU_D_CNT = 1, GU_D_FIRST = 128 * 8 * GU_C2_CNT, GU_F_CNT = 1, GU_F_FIRST = GU_D_FIRST + 128 * 8 * GU_D_CNT, GU_SLOT_END = GU_F_FIRST + 128 * 8 * GU_F_CNT;
constexpr int DN_C1_CNT = 2, DN_C1_FIRST = 0, DN_E_CNT = 2, DN_E_FIRST = 128 * 8 * DN_C1_CNT, DN_I_CNT = 2, DN_I_FIRST = DN_E_FIRST + 192 * 8 * DN_E_CNT, DN_SLOT_END = DN_I_FIRST + 192 * 8 * DN_I_CNT;
static_assert(GU_SLOT_END <= 8192 && DN_SLOT_END <= 8192, "slot ranges");
__device__ __forceinline__ void slot_gu(const Ctx& C, int L, int pb, int first, int cnt) {
    for (int i = 0; i < cnt; ++i) { const int idx = first + (pb * 8 + C.wave) * cnt + i; if (idx < GU_SLOT_END) conv_gu_item(C, L, idx); }
}
__device__ __forceinline__ void slot_dn(const Ctx& C, int L, int pb, int first, int cnt) {
    for (int i = 0; i < cnt; ++i) { const int idx = first + (pb * 8 + C.wave) * cnt + i; if (idx < DN_SLOT_END) conv_dn_item(C, L, idx); }
}
__device__ __forceinline__ void phase_prep(const Ctx& C) {
    const int tid = C.tid, lane = C.lane;
    const size_t gtid = (size_t)C.bid * 512 + tid, gth = (size_t)C.G * 512;
    { bf16* afft = WSP(bf16, WS_AFFT); const float sc = 0.0027621358640099515f;
      for (size_t i = gtid; i < (size_t)2048 * 2048; i += gth) { const int k1 = (int)(i >> 11), j = (int)(i & 2047), n1 = j & 1023; const int m = (k1 * n1) & 2047;
          const float x = (float)m * (1.0f / 1024.0f); float v = (j < 1024) ? cospif(x) : -sinpif(x); if (j == 0) v = 0.5f; if (j == 1024) v = (k1 & 1) ? -1.0f : 1.0f;
          afft[i] = (bf16)(cvt_pk_bf16(v * sc, 0.f) & 0xffff); }
      bf16* afc = WSP(bf16, WS_AFFTC); const float scc = 0.0078125f;
      for (size_t i = gtid; i < (size_t)256 * 256; i += gth) { const int k1 = (int)(i >> 8), j = (int)(i & 255), n1 = j & 127; const int m = (k1 * n1) & 255;
          const float x = (float)m * (1.0f / 128.0f); float v = (j < 128) ? cospif(x) : -sinpif(x); if (j == 0) v = 0.5f; if (j == 128) v = (k1 & 1) ? -1.0f : 1.0f;
          afc[i] = (bf16)(cvt_pk_bf16(v * scc, 0.f) & 0xffff); }
      bf16* t64 = WSP(bf16, WS_T64);
      for (size_t i = gtid; i < 128 * 128; i += gth) { const int mrow = (int)(i >> 7), kk = (int)(i & 127), n2 = kk & 63, k2 = mrow & 63; const int m = (k2 * n2) & 63;
          const float x = (float)m * (1.0f / 32.0f); const float v = (mrow < 64) ? cospif(x) : ((kk < 64) ? sinpif(x) : -sinpif(x)); t64[i] = (bf16)(cvt_pk_bf16(v, 0.f) & 0xffff); }
      float* rope = WSP(float, WS_ROPE);
      for (size_t i = gtid; i < 2048 * 16; i += gth) { const int t = (int)(i >> 4), f = (int)(i & 15); const float pos = (f < 8) ? (float)(t >> 6) : (float)(t & 63);
          const float inv = powf(10000.0f, -(float)(f & 7) / 8.0f); const float ang = pos * inv; rope[2 * i] = cosf(ang); rope[2 * i + 1] = sinf(ang); }
      bf16* win = WSP(bf16, WS_WIN);
      for (size_t i = gtid; i < (size_t)DEPTH * 96 * 1024 / 8; i += gth) { const size_t l = i / (96 * 128), r = i % (96 * 128); *(u32x4*)(win + (l * NZ + ZEND) * D + r * 8) = (u32x4){0u, 0u, 0u, 0u}; }
    }
    {
        LAS float* sl = (LAS float*)(C.lds);
        LAS float* red = (LAS float*)(C.lds + 9 * 1024 * 4);
        for (int i = tid; i < 9 * 1024; i += 512) { const int r = i >> 10, k = i & 1023; const float v = (r < 8) ? C.in[I_C][r * 1024 + k] : C.in[I_CCTX][k]; sl[i] = silu_f(v); }
        __syncthreads();
        const int c32 = tid & 31, kg = tid >> 5;
        for (int it = C.bid; it < DEPTH * 192; it += C.G) {
            const int l = it / 192, n0 = (it % 192) * 32;
            const float* wm = C.in[I_WMOD] + (size_t)l * 1024 * 6144 + n0 + c32;
            float a[9];
#pragma unroll
            for (int r = 0; r < 9; ++r) a[r] = 0.f;
            for (int kk = 0; kk < 64; ++kk) { const int k = kg * 64 + kk; const float w = wm[(size_t)k * 6144];
#pragma unroll
                for (int r = 0; r < 9; ++r) a[r] += sl[r * 1024 + k] * w; }
#pragma unroll
            for (int r = 0; r < 9; ++r) red[(kg * 9 + r) * 32 + c32] = a[r];
            __syncthreads();
            if (tid < 288) { const int r = tid >> 5; float s = 0.f;
#pragma unroll
                for (int g = 0; g < 16; ++g) s += red[(g * 9 + r) * 32 + c32];
                WSP(float, WS_MOD)[((size_t)l * 9 + r) * 6144 + n0 + c32] = s + C.in[I_BMOD][l * 6144 + n0 + c32]; }
            __syncthreads();
        }
    }
    {
        for (size_t i = gtid; i < (size_t)DEPTH * 4 * 1024; i += gth) {
            const int l = (int)(i >> 12), g = (int)((i >> 10) & 3), d = (int)(i & 1023);
            const float* wb = C.in[I_WBR] + (((size_t)l * 4 + 1) * 256 + g * 64) * 1024 + d;
            const float* pw = C.in[I_POOLW] + ((size_t)l * 4 + g) * 64 * 64;
            const float* ps = C.in[I_POOLS] + l * 256 + g * 64;
            float wv[64];
#pragma unroll
            for (int c2 = 0; c2 < 64; ++c2) wv[c2] = wb[(size_t)c2 * 1024] * ps[c2];
            bf16* dst = WSP(bf16, WS_WB) + (((size_t)l * 4 + 1) * 1024 + d) * 256 + g * 64;
#pragma unroll 1
            for (int c8 = 0; c8 < 8; ++c8) {
                float o[8];
#pragma unroll
                for (int cc = 0; cc < 8; ++cc) { float s = 0.f; const float* pr = pw + (c8 * 8 + cc) * 64;
#pragma unroll
                    for (int c2 = 0; c2 < 64; ++c2) s += pr[c2] * wv[c2];
                    o[cc] = s; }
                u32x4 w; w.x = cvt_pk_bf16(o[0], o[1]); w.y = cvt_pk_bf16(o[2], o[3]); w.z = cvt_pk_bf16(o[4], o[5]); w.w = cvt_pk_bf16(o[6], o[7]);
                *(u32x4*)(dst + c8 * 8) = w;
            }
        }
    }
    {
        const int gw = C.bid * 8 + C.wave, NGW = C.G * 8;
        for (int it = gw; it < DEPTH * 16 * 91; it += NGW) {
            const int l = it / (16 * 91), t = it - l * (16 * 91), kb = t / 91, nb = t - kb * 91;
            bf16* win = WSP(bf16, WS_WIN) + (size_t)l * NZ * D; bf16* wg = WSP(bf16, WS_WG) + (size_t)l * 4096 * D;
            auto rm = [=](int n, float& cs) -> bf16* { cs = (n < 256) ? NA_QS : 1.0f; if (n < ZEND) return win + (size_t)n * D;
                const int g = n - ZEND, br = g >> 10, d = g & 1023, pn = d >> 6, ch = d & 63;
                const int row = 256 * pn + 128 * (br >> 1) + 32 * (ch >> 4) + 16 * (br & 1) + (ch & 15);
                return wg + (size_t)row * D; };
            tconv64(C.in[I_WIN] + (size_t)l * D * IN_COLS, IN_COLS, kb * 64, nb * 64, IN_COLS, nullptr, rm, C.lane);
        }
        for (int it = gw; it < DEPTH * 256; it += NGW) {
            const int l = it >> 8, t = it & 255, kb = t >> 4, nb = t & 15;
            bf16* w = WSP(bf16, WS_WO) + (size_t)l * D * D; auto rm = [=](int n, float& cs) -> bf16* { cs = 1.0f; return w + (size_t)n * D; };
            tconv64(C.in[I_WOUT] + (size_t)l * D * D, D, kb * 64, nb * 64, D, nullptr, rm, C.lane);
        }
        for (int it = gw; it < DEPTH * 4 * 64; it += NGW) {
            const int ln = it >> 6, t = it & 63, kb = t >> 4, nb = t & 15;
            if ((ln & 3) == 1) continue;
            bf16* w = WSP(bf16, WS_WB) + (size_t)ln * 1024 * 256; auto rm = [=](int n, float& cs) -> bf16* { cs = 1.0f; return w + (size_t)n * 256; };
            tconv64(C.in[I_WBR] + (size_t)ln * 256 * 1024, 1024, kb * 64, nb * 64, 1024, nullptr, rm, C.lane);
        }
        for (int it = gw; it < DEPTH * 24; it += NGW) {
            const int l = it / 24, t = it - l * 24, kb = t / 6, nb = t - kb * 6;
            bf16* w = WSP(bf16, WS_WUQ) + (size_t)l * 384 * 256; auto rm = [=](int n, float& cs) -> bf16* { cs = 1.0f; return w + (size_t)n * 256; };
            tconv64(C.in[I_WUQ] + (size_t)l * 256 * 384, 384, kb * 64, nb * 64, 384, C.in[I_QNORM] + l * 256, rm, C.lane);
        }
        for (int it = gw; it < DEPTH * 16; it += NGW) {
            const int l = it >> 4, t = it & 15, kb = t >> 3, nb = t & 7;
            bf16* w = WSP(bf16, WS_WUKV) + (size_t)l * 512 * 128; auto rm = [=](int n, float& cs) -> bf16* { cs = 1.0f; return w + (size_t)n * 128; };
            tconv64(C.in[I_WUKV] + (size_t)l * 128 * 512, 512, kb * 64, nb * 64, 512, C.in[I_KVNORM] + l * 128, rm, C.lane);
        }
    }
    {
        const int gw = C.bid * 8 + C.wave, NGW = C.G * 8;
        for (int it = gw; it < 8192; it += NGW) conv_gu_item(C, 0, it);
        for (int it = gw; it < 8192; it += NGW) conv_dn_item(C, 0, it);
        constexpr int GU_REST = 8192 - GU_SLOT_END, DN_REST = 8192 - DN_SLOT_END;
        for (int it = gw; it < 3 * GU_REST; it += NGW) conv_gu_item(C, 1 + it / GU_REST, GU_SLOT_END + it % GU_REST);
        if (DN_REST > 0) for (int it = gw; it < 3 * DN_REST; it += NGW) conv_dn_item(C, 1 + it / (DN_REST > 0 ? DN_REST : 1), DN_SLOT_END + it % (DN_REST > 0 ? DN_REST : 1));
    }
}

__device__ __forceinline__ void phase_init(const Ctx& C) {
    const int gw = C.bid * 8 + C.wave, NGW = C.G * 8, lane = C.lane;
    const float* mod = WSP(float, WS_MOD);
    for (int row = gw; row < T; row += NGW) {
        const float* src = (row < TL) ? C.in[I_X] + (size_t)row * D : C.in[I_CTX] + (size_t)(row - TL) * D;
        const float* mr = mod + (size_t)mod_row(row) * 6144;
        float* hd = WSP(float, WS_H) + (size_t)row * D; bf16* ud = WSP(bf16, WS_U1) + (size_t)row * D;
#pragma unroll
        for (int j = 0; j < 4; ++j) { const int c = 4 * lane + 256 * j; const f32x4 v = *(const f32x4*)(src + c); const f32x4 sh = *(const f32x4*)(mr + c), sc = *(const f32x4*)(mr + 1024 + c);
            *(f32x4*)(hd + c) = v; const f32x4 u = v * (sc + 1.0f) + sh; u32x2 w; w.x = cvt_pk_bf16(u[0], u[1]); w.y = cvt_pk_bf16(u[2], u[3]); *(u32x2*)(ud + c) = w; }
    }
}


__device__ __forceinline__ int unit_index(int i, int G, int c, int nunits) {
    const int full = nunits / G;
    if (i < full) return i * G + c;
    if (i > full) return -1;
    const int R = nunits - full * G; if (R == 0) return -1;
    const int cpx = G >> 3, per = (R + 7) >> 3, x = c / cpx, k = c - x * cpx, r = x * per + k;
    return (k < per && r < R) ? full * G + r : -1;
}
__device__ __forceinline__ int blk_x(const Ctx& C) { return C.bid / (C.G >> 3); }
__device__ __forceinline__ int blk_k(const Ctx& C) { return C.bid % (C.G >> 3); }
struct SchedDense {
    const char* A; const char* B; size_t lda, ldb; int nunits, G, c, nN;
    __device__ __forceinline__ bool next(int i, g8::Unit& u) const { const int L = unit_index(i, G, c, nunits); if (L < 0) return false; const int pm = L / nN, pn = L - pm * nN;
        u.A = A + (size_t)pm * 256 * lda; u.B = B + (size_t)pn * 256 * ldb; u.r0 = pm * 256; u.c0 = pn * 256; u.x = 0; return true; }
};
struct SchedGroup {
    const char* A; const char* B; size_t lda, ldb, bstride; int nunits, G, c, nN, per;
    __device__ __forceinline__ bool next(int i, g8::Unit& u) const { const int L = unit_index(i, G, c, nunits); if (L < 0) return false; const int e = L / per, r = L - e * per, pm = r / nN, pn = r - pm * nN;
        u.A = A + ((size_t)e * ESLOT + pm * 256) * lda; u.B = B + (size_t)e * bstride + (size_t)pn * 256 * ldb; u.r0 = e * ESLOT + pm * 256; u.c0 = pn * 256; u.x = e; return true; }
};
struct SchedC1 {
    const char* Y; const char* W; int nunits, G, c;
    __device__ __forceinline__ bool next(int i, g8::Unit& u) const { const int L = unit_index(i, G, c, nunits); if (L < 0) return false; const int pm = L >> 4, nb = (L >> 2) & 3, pn = L & 3;
        u.A = Y + ((size_t)nb * T + pm * 256) * 512; u.B = W + ((size_t)nb * 1024 + pn * 256) * 512; u.r0 = pm * 256; u.c0 = nb * 1024 + pn * 256; u.x = 0; return true; }
};
struct EpiStoreBf16 {
    static constexpr bool PERM = true; bf16* O; size_t ldc;
    __device__ __forceinline__ void operator()(const f32x4 (&acc)[2][2][4][2], const g8::Unit& u, int wr, int wc, int fr, int fq) const {
        bf16* base = O + (size_t)(u.r0 + wr * 64 + fr) * ldc + u.c0 + wc * 32 + 8 * fq;
#pragma unroll
        for (int ai = 0; ai < 2; ++ai)
#pragma unroll
            for (int m = 0; m < 4; ++m) { bf16* rowp = base + (size_t)(ai * 128 + m * 16) * ldc;
#pragma unroll
                for (int bj = 0; bj < 2; ++bj) { const f32x4 v0 = acc[ai][bj][m][0], v1 = acc[ai][bj][m][1];
                    u32x4 w; w.x = cvt_pk_bf16(v0[0], v0[1]); w.y = cvt_pk_bf16(v0[2], v0[3]); w.z = cvt_pk_bf16(v1[0], v1[1]); w.w = cvt_pk_bf16(v1[2], v1[3]); *(u32x4*)(rowp + bj * 128) = w; } }
    }
};
struct EpiSwiGLU {
    static constexpr bool PERM = true; bf16* O;
    __device__ __forceinline__ void operator()(const f32x4 (&acc)[2][2][4][2], const g8::Unit& u, int wr, int wc, int fr, int fq) const {
        bf16* base = O + (size_t)(u.r0 + wr * 64 + fr) * FF + (u.c0 >> 1) + wc * 32 + 8 * fq;
#pragma unroll
        for (int ai = 0; ai < 2; ++ai)
#pragma unroll
            for (int m = 0; m < 4; ++m) { float h[8];
#pragma unroll
                for (int n = 0; n < 2; ++n)
#pragma unroll
                    for (int j = 0; j < 4; ++j) { const float a = acc[ai][0][m][n][j], b = acc[ai][1][m][n][j]; h[4 * n + j] = a * __builtin_amdgcn_rcpf(1.0f + fast_exp2(-a * LOG2E)) * b; }
                u32x4 w; w.x = cvt_pk_bf16(h[0], h[1]); w.y = cvt_pk_bf16(h[2], h[3]); w.z = cvt_pk_bf16(h[4], h[5]); w.w = cvt_pk_bf16(h[6], h[7]);
                *(u32x4*)(base + (size_t)(ai * 128 + m * 16) * FF) = w; }
    }
};
struct EpiGateMerge {
    static constexpr bool PERM = false; const bf16* P; bf16* S;
    __device__ __forceinline__ void operator()(const f32x4 (&acc)[2][2][4][2], const g8::Unit& u, int wr, int wc, int fr, int fq) const {
        const int chb = (u.c0 >> 2) + wc * 16 + 4 * fq;
        const bf16* pr0 = P + (size_t)(u.r0 + wr * 64 + fr) * 4096 + chb;
        u32x2 pv[2][4][4];
#pragma unroll
        for (int ai = 0; ai < 2; ++ai)
#pragma unroll
            for (int m = 0; m < 4; ++m)
#pragma unroll
                for (int br = 0; br < 4; ++br) pv[ai][m][br] = *(const u32x2*)(pr0 + (size_t)(ai * 128 + m * 16) * 4096 + br * 1024);
#pragma unroll
        for (int ai = 0; ai < 2; ++ai)
#pragma unroll
            for (int m = 0; m < 4; ++m) { const size_t row = (size_t)(u.r0 + ai * 128 + wr * 64 + m * 16 + fr);
                f32x4 sum = (f32x4){0.f, 0.f, 0.f, 0.f};
#pragma unroll
                for (int bj = 0; bj < 2; ++bj)
#pragma unroll
                    for (int n = 0; n < 2; ++n) { const f32x4 a = acc[ai][bj][m][n]; const u32x2 p = pv[ai][m][2 * bj + n];
                        sum[0] += __builtin_amdgcn_rcpf(1.0f + fast_exp2(-a[0] * LOG2E)) * bflo(p.x); sum[1] += __builtin_amdgcn_rcpf(1.0f + fast_exp2(-a[1] * LOG2E)) * bfhi(p.x);
                        sum[2] += __builtin_amdgcn_rcpf(1.0f + fast_exp2(-a[2] * LOG2E)) * bflo(p.y); sum[3] += __builtin_amdgcn_rcpf(1.0f + fast_exp2(-a[3] * LOG2E)) * bfhi(p.y); }
                u32x2 w; w.x = cvt_pk_bf16(sum[0], sum[1]); w.y = cvt_pk_bf16(sum[2], sum[3]); *(u32x2*)(S + row * D + chb) = w; }
    }
};
struct EpiResid {
    static constexpr bool PERM = false; const float* H; float* X1; const float* mod;
    __device__ __forceinline__ void operator()(const f32x4 (&acc)[2][2][4][2], const g8::Unit& u, int wr, int wc, int fr, int fq) const {
        const int col0 = u.c0 + wc * 32 + 4 * fq;
#pragma unroll
        for (int ai = 0; ai < 2; ++ai)
#pragma unroll
            for (int m = 0; m < 4; ++m) { const int row = u.r0 + ai * 128 + wr * 64 + m * 16 + fr; const float* g1 = mod + (size_t)mod_row(row) * 6144 + 2048; const size_t off = (size_t)row * D;
#pragma unroll
                for (int bj = 0; bj < 2; ++bj)
#pragma unroll
                    for (int n = 0; n < 2; ++n) { const int c = col0 + bj * 128 + n * 16; *(f32x4*)(X1 + off + c) = *(const f32x4*)(H + off + c) * DN_ALPHA + *(const f32x4*)(g1 + c) * acc[ai][bj][m][n]; } }
    }
};
__device__ __forceinline__ void phase_inproj(const Ctx& C, int l) {
    SchedDense S{(const char*)WSP(bf16, WS_U1), (const char*)(WSP(bf16, WS_WIN) + (size_t)l * NZ * D), (size_t)D * 2, (size_t)D * 2, (T / 256) * (NZ / 256), C.G, C.bid, NZ / 256};
    EpiStoreBf16 E{WSP(bf16, WS_Z), (size_t)NZ};
    g8::gemm_phase(C.lds, D, D * 2, D * 2, S, E, C.tid);
}
__device__ __forceinline__ void phase_c1(const Ctx& C, int l, int nrows) {
    SchedC1 S{(const char*)WSP(bf16, WS_Y), (const char*)(WSP(bf16, WS_WB) + (size_t)l * 4 * 1024 * 256), (nrows / 256) * 16, C.G, C.bid};
    EpiStoreBf16 E{WSP(bf16, WS_P), (size_t)4096};
    g8::gemm_phase(C.lds, 256, 512, 512, S, E, C.tid);
}
__device__ __forceinline__ void phase_c2(const Ctx& C, int l, int nrows) {
    SchedDense S{(const char*)WSP(bf16, WS_U1), (const char*)(WSP(bf16, WS_WG) + (size_t)l * 4096 * D), (size_t)D * 2, (size_t)D * 2, (nrows / 256) * 16, C.G, C.bid, 16};
    EpiGateMerge E{WSP(bf16, WS_P), WSP(bf16, WS_S)};
    g8::gemm_phase(C.lds, D, D * 2, D * 2, S, E, C.tid);
}
struct SchedDctx {
    const char* A; const char* B; int G, c;
    __device__ __forceinline__ bool next(int i, g8::Unit& u) const { const int L = unit_index(i, G, c, 128); if (L < 0) return false; const int pm = L >> 4, pn = (L >> 2) & 3, ks = L & 3;
        u.A = A + ((size_t)TL + pm * 256) * (D * 2) + (size_t)ks * 512; u.B = B + (size_t)pn * 256 * (D * 2) + (size_t)ks * 512; u.r0 = ks * TC + pm * 256; u.c0 = pn * 256; u.x = ks; return true; }
};
struct EpiRawF32 {
    static constexpr bool PERM = false; float* O;
    __device__ __forceinline__ void operator()(const f32x4 (&acc)[2][2][4][2], const g8::Unit& u, int wr, int wc, int fr, int fq) const {
        float* base = O + (size_t)(u.r0 + wr * 64 + fr) * D + u.c0 + wc * 32 + 4 * fq;
#pragma unroll
        for (int ai = 0; ai < 2; ++ai)
#pragma unroll
            for (int m = 0; m < 4; ++m)
#pragma unroll
                for (int bj = 0; bj < 2; ++bj)
#pragma unroll
                    for (int n = 0; n < 2; ++n) *(f32x4*)(base + (size_t)(ai * 128 + m * 16) * D + bj * 128 + n * 16) = acc[ai][bj][m][n];
    }
};
__device__ __forceinline__ void phase_d(const Ctx& C, int l, int nrows) {
    {
        SchedDense S{(const char*)WSP(bf16, WS_S), (const char*)(WSP(bf16, WS_WO) + (size_t)l * D * D), (size_t)D * 2, (size_t)D * 2, (TL / 256) * 4, C.G, C.bid, 4};
        EpiResid E{WSP(float, WS_H), WSP(float, WS_X1), WSP(float, WS_MOD) + (size_t)l * 9 * 6144};
        g8::gemm_phase(C.lds, D, D * 2, D * 2, S, E, C.tid);
    }
    if (nrows > TL) {
        SchedDctx S{(const char*)WSP(bf16, WS_S), (const char*)(WSP(bf16, WS_WO) + (size_t)l * D * D), C.G, C.bid};
        EpiRawF32 E{(float*)(C.ws + WS_XE + (size_t)4 * NE * 256 * D * 2)};
        g8::gemm_phase(C.lds, 256, D * 2, D * 2, S, E, C.tid);
    }
}
__device__ __forceinline__ void phase_g(const Ctx& C, int l, int mt) {
    LAS int* srow = (LAS int*)(C.lds + g8::STAGE_BYTES);
    const int per = mt * 16, nunits = NE * per; const int* SROW = WSP(int, WS_SROW);
    for (int i = 0; i < 9; ++i) { const int L = unit_index(i, C.G, C.bid, nunits); if (L >= 0 && C.tid < 256) { const int e = L / per, r = L - e * per, pm = r >> 4; srow[i * 256 + C.tid] = SROW[e * ESLOT + pm * 256 + C.tid]; } }
    __syncthreads();
    SchedGroup S{(const char*)WSP(bf16, WS_U2), (const char*)(WSP(bf16, WS_WGU) + (size_t)l * NE * 4096 * D), (size_t)0, (size_t)D * 2, (size_t)4096 * D * 2, nunits, C.G, C.bid, 16, per};
    EpiSwiGLU E{WSP(bf16, WS_ACT)};
    g8::gemm_phase<EpiSwiGLU, SchedGroup, true>(C.lds, D, D * 2, D * 2, S, E, C.tid, srow);
    __syncthreads();
}
struct SchedHctx {
    const char* A; const char* B; int G, c;
    __device__ __forceinline__ bool next(int i, g8::Unit& u) const { const int L = unit_index(i, G, c, NE * 16); if (L < 0) return false; const int e = L >> 4, pn = (L >> 2) & 3, ks = L & 3;
        u.A = A + ((size_t)e * ESLOT + NB * CAPL) * (FF * 2) + (size_t)ks * 1024; u.B = B + ((size_t)e * D + pn * 256) * (FF * 2) + (size_t)ks * 1024; u.r0 = ks * (NE * 256) + e * 256; u.c0 = pn * 256; u.x = e; return true; }
};
__device__ __forceinline__ void phase_h(const Ctx& C, int l, int mt) {
    {
        SchedGroup S{(const char*)WSP(bf16, WS_ACT), (const char*)(WSP(bf16, WS_WD) + (size_t)l * NE * D * FF), (size_t)FF * 2, (size_t)FF * 2, (size_t)D * FF * 2, NE * 8 * 4, C.G, C.bid, 4, 8 * 4};
        EpiStoreBf16 E{WSP(bf16, WS_YE), (size_t)D};
        g8::gemm_phase(C.lds, FF, FF * 2, FF * 2, S, E, C.tid);
    }
    if (mt == 9) {
        SchedHctx S{(const char*)WSP(bf16, WS_ACT), (const char*)(WSP(bf16, WS_WD) + (size_t)l * NE * D * FF), C.G, C.bid};
        EpiStoreBf16 E{WSP(bf16, WS_XE), (size_t)D};
        g8::gemm_phase(C.lds, 512, FF * 2, FF * 2, S, E, C.tid);
    }
}

__device__ __forceinline__ void na_unit_latent(const Ctx& C, int l, int u) {
    const int b = u >> 5, hh = (u >> 3) & 3, rr = u & 7, w = C.wave;
    const bf16* Z = WSP(bf16, WS_Z);
    LAS float* btab = (LAS float*)(C.lds + 110 * 1024 + 256);
    for (int i = C.tid; i < 15 * 31; i += 512) btab[i] = C.in[I_RPB][((size_t)l * 4 + hh) * 465 + i] * LOG2E;
    {
        const int kx = u & 31;
        for (int it = 0; it < 3; ++it) { const int i = (it * 32 + kx) * 512 + C.tid, r = i >> 4, hl = i & 15;
            if (r < 2304) { const size_t row = (r < 256) ? (size_t)TL + (size_t)b * CTX + r : (size_t)b * SEQ + (r - 256); l2_touch(C, (const char*)(Z + row * NZ + ZK) + hl * 64); } }
    }
    __syncthreads();
    const int R = 4 * rr + (w >> 1), qc0 = 32 * (w & 1);
    int kr_lo = 4 * rr - 4; kr_lo = kr_lo < 0 ? 0 : (kr_lo > 24 ? 24 : kr_lo);
    int kr_hi = 4 * rr - 1; kr_hi = (kr_hi < 0 ? 0 : (kr_hi > 24 ? 24 : kr_hi)) + 8;
    int r0w = R - 4; r0w = r0w < 0 ? 0 : (r0w > 24 ? 24 : r0w);
    const size_t lat0 = (size_t)b * SEQ, ctx0 = (size_t)TL + (size_t)b * CTX;
    const bf16* q = Z + (lat0 + R * 64 + qc0) * NZ + ZQ + hh * 64;
    bf16* o = WSP(bf16, WS_Y) + (lat0 + R * 64 + qc0) * 256 + hh * 64;
    attn_unit<64, true>(C, q, NZ, Z + ctx0 * NZ + ZK + hh * 64, Z + ctx0 * NZ + ZV + hh * 64, 4,
                        Z + (lat0 + kr_lo * 64) * NZ + ZK + hh * 64, Z + (lat0 + kr_lo * 64) * NZ + ZV + hh * 64, kr_hi - kr_lo,
                        NZ, NZ, o, 256, r0w - kr_lo, r0w - kr_lo + 8, kr_lo - R + 7, qc0, btab);
    __syncthreads();
}
__device__ __forceinline__ void na_unit_ctx(const Ctx& C, int u) {
    const int b = u >> 2, hh = u & 3, w = C.wave;
    const bf16* Z = WSP(bf16, WS_Z);
    const size_t ctx0 = (size_t)TL + (size_t)b * CTX;
    const bf16* q = Z + (ctx0 + 32 * w) * NZ + ZQ + hh * 64;
    bf16* o = WSP(bf16, WS_Y) + (ctx0 + 32 * w) * 256 + hh * 64;
    attn_unit<64, false>(C, q, NZ, Z + ctx0 * NZ + ZK + hh * 64, Z + ctx0 * NZ + ZV + hh * 64, 4, nullptr, nullptr, 0, NZ, NZ, o, 256, 0, 0, 0, 0, nullptr);
    __syncthreads();
}
template <int NC>
__device__ __forceinline__ void row_rms(const Ctx& C, int tm, int zc, LAS float* rs) {
    const bf16* Z = WSP(bf16, WS_Z);
    const int r = C.tid >> 2, part = C.tid & 3;
    const bf16* p = Z + (size_t)(tm * 128 + r) * NZ + zc + part * (NC / 4);
    float s = 0.f;
#pragma unroll
    for (int i = 0; i < NC / 32; ++i) { const u32x4 v = *(const u32x4*)(p + 8 * i);
        const float a0 = bflo(v.x), a1 = bfhi(v.x), a2 = bflo(v.y), a3 = bfhi(v.y), a4 = bflo(v.z), a5 = bfhi(v.z), a6 = bflo(v.w), a7 = bfhi(v.w);
        s += a0 * a0 + a1 * a1 + a2 * a2 + a3 * a3 + a4 * a4 + a5 * a5 + a6 * a6 + a7 * a7; }
    s += __shfl_xor(s, 1); s += __shfl_xor(s, 2);
    if (part == 0) rs[r] = 1.0f / sqrtf(s * (1.0f / NC) + LN_EPS);
    __syncthreads();
}
__device__ __forceinline__ void mlaq_tile(const Ctx& C, int l, int u) {
    const int tm = u / 3, tn = u % 3;
    LAS float* rs = (LAS float*)(C.lds + 110 * 1024);
    row_rms<256>(C, tm, ZCQ, rs);
    const bf16* Z = WSP(bf16, WS_Z); const bf16* W = WSP(bf16, WS_WUQ) + (size_t)l * 384 * 256; bf16* QM = WSP(bf16, WS_QM);
    const float* rope = WSP(float, WS_ROPE);
    auto arow = [=](int r) { return Z + (size_t)(tm * 128 + r) * NZ + ZCQ; };
    auto brow = [=](int r) { return W + (size_t)(tn * 128 + r) * 256; };
    auto epi = [=](const f32x4 (&acc)[4][2], int wr, int wc, int fr, int fq) {
        f32x4 csv[4][2];
#pragma unroll
        for (int m = 0; m < 4; ++m)
#pragma unroll
            for (int n = 0; n < 2; ++n) { const int row = tm * 128 + wr * 64 + m * 16 + fr, cc = (tn * 128 + wc * 32 + n * 16 + 4 * fq) % 96, pi = cc >= 64 ? (cc - 64) >> 1 : 0;
                csv[m][n] = *(const f32x4*)(rope + (size_t)(row & 2047) * 32 + 2 * pi); }
#pragma unroll
        for (int m = 0; m < 4; ++m)
#pragma unroll
            for (int n = 0; n < 2; ++n) asm volatile("" : "+v"(csv[m][n]));
#pragma unroll
        for (int m = 0; m < 4; ++m)
#pragma unroll
            for (int n = 0; n < 2; ++n) { const int rl = wr * 64 + m * 16 + fr, row = tm * 128 + rl, col = tn * 128 + wc * 32 + n * 16 + 4 * fq;
                const float s = rs[rl] * MLA_QS; f32x4 v = acc[m][n] * s;
                const int cc = col % 96;
                if (cc >= 64 && row < TL) { const f32x4 cs = csv[m][n];
                    const float x1 = v[0], x2 = v[1], y1 = v[2], y2 = v[3];
                    v[0] = x1 * cs[0] - x2 * cs[1]; v[1] = x1 * cs[1] + x2 * cs[0]; v[2] = y1 * cs[2] - y2 * cs[3]; v[3] = y1 * cs[3] + y2 * cs[2]; }
                u32x2 w; w.x = cvt_pk_bf16(v[0], v[1]); w.y = cvt_pk_bf16(v[2], v[3]); *(u32x2*)(QM + (size_t)row * 384 + col) = w; }
    };
    sgemm_tile(C, arow, brow, 256, 0, epi);
}
__device__ __forceinline__ void mlakv_tile(const Ctx& C, int l, int u) {
    const int tm = u >> 2, tn = u & 3;
    LAS float* rs = (LAS float*)(C.lds + 110 * 1024);
    row_rms<128>(C, tm, ZCKV, rs);
    const bf16* Z = WSP(bf16, WS_Z); const bf16* W = WSP(bf16, WS_WUKV) + (size_t)l * 512 * 128; bf16* KM = WSP(bf16, WS_KM); bf16* VM = WSP(bf16, WS_VM);
    const float* rope = WSP(float, WS_ROPE);
    auto arow = [=](int r) { return Z + (size_t)(tm * 128 + r) * NZ + ZCKV; };
    auto brow = [=](int r) { return W + (size_t)(tn * 128 + r) * 128; };
    auto epi = [=](const f32x4 (&acc)[4][2], int wr, int wc, int fr, int fq) {
#pragma unroll
        for (int m = 0; m < 4; ++m)
#pragma unroll
            for (int n = 0; n < 2; ++n) { const int rl = wr * 64 + m * 16 + fr, row = tm * 128 + rl, c = wc * 32 + n * 16 + 4 * fq;
                const f32x4 v = acc[m][n] * rs[rl]; u32x2 w; w.x = cvt_pk_bf16(v[0], v[1]); w.y = cvt_pk_bf16(v[2], v[3]);
                if (c < 64) *(u32x2*)(KM + (size_t)row * 384 + tn * 96 + c) = w; else *(u32x2*)(VM + (size_t)row * 256 + tn * 64 + (c - 64)) = w; }
    };
    sgemm_tile(C, arow, brow, 128, 0, epi);
    {   u32x2 wv[2]; f32x4 csv[2];
#pragma unroll
        for (int q = 0; q < 2; ++q) { const int i = C.tid + 512 * q, rl = i >> 3, g4 = i & 7, row = tm * 128 + rl;
            wv[q] = *(const u32x2*)(Z + (size_t)row * NZ + ZKR + 4 * g4); csv[q] = *(const f32x4*)(rope + (size_t)(row & 2047) * 32 + 4 * g4); }
#pragma unroll
        for (int q = 0; q < 2; ++q) asm volatile("" : "+v"(wv[q]), "+v"(csv[q]));
#pragma unroll
        for (int q = 0; q < 2; ++q) { const int i = C.tid + 512 * q, rl = i >> 3, g4 = i & 7, row = tm * 128 + rl;
            const u32x2 w = wv[q]; float x1 = bflo(w.x), x2 = bfhi(w.x), y1 = bflo(w.y), y2 = bfhi(w.y);
            if (row < TL) { const f32x4 cs = csv[q];
                const float a = x1 * cs[0] - x2 * cs[1], b2 = x1 * cs[1] + x2 * cs[0], c2 = y1 * cs[2] - y2 * cs[3], d2 = y1 * cs[3] + y2 * cs[2]; x1 = a; x2 = b2; y1 = c2; y2 = d2; }
            u32x2 o; o.x = cvt_pk_bf16(x1, x2); o.y = cvt_pk_bf16(y1, y2); *(u32x2*)(KM + (size_t)row * 384 + tn * 96 + 64 + 4 * g4) = o; }
    }
}
__device__ __forceinline__ void fft1_tile(const Ctx& C, int u) {
    const bf16* Z = WSP(bf16, WS_Z); const bf16* T64 = WSP(bf16, WS_T64);
    int b, g, ch, L; size_t tok0; bf16* dst; int ldd, half;
    if (u < 256) { b = u >> 5; g = (u >> 3) & 3; ch = u & 7; L = SEQ; tok0 = (size_t)b * SEQ; dst = WSP(bf16, WS_FB) + (size_t)((b * 4 + g) * 64) * 2048 + ch * 128; ldd = 2048; half = 1024; }
    else { const int v = u - 256; b = v >> 2; g = v & 3; ch = 0; L = CTX; tok0 = (size_t)TL + (size_t)b * CTX; dst = WSP(bf16, WS_FBC) + (size_t)((b * 4 + g) * 64) * 256; ldd = 256; half = 128; }
    const bf16* Zg = Z + tok0 * NZ + ZF + g * 64;
    auto arow = [=](int r) { return T64 + (size_t)r * 128; };
    auto brow = [=](int r) { return Zg + (size_t)(ch * 128 + r) * NZ; };
    auto bstep = [=](int r) { const int n = ch * 128 + r, mir = (L - n) & (L - 1); return (long)(mir - n) * NZ; };
    auto epi = [=](const f32x4 (&acc)[4][2], int wr, int wc, int fr, int fq) {
#pragma unroll
        for (int m = 0; m < 4; ++m)
#pragma unroll
            for (int n = 0; n < 2; ++n) { const int mrow = wr * 64 + m * 16 + fr, col = wc * 32 + n * 16 + 4 * fq;
                u32x2 w; w.x = cvt_pk_bf16(acc[m][n][0], acc[m][n][1]); w.y = cvt_pk_bf16(acc[m][n][2], acc[m][n][3]);
                *(u32x2*)(dst + (size_t)(mrow & 63) * ldd + (mrow >> 6) * half + col) = w; }
    };
    sgemm_tile_s(C, arow, brow, bstep, 128, epi);
    if (ch == 0 && C.tid < 64) {
        const bf16* zr = Zg + (size_t)(L >> 1) * NZ; const bf16* tr = T64 + (size_t)C.tid * 128; float s = 0.f;
#pragma unroll
        for (int c8 = 0; c8 < 8; ++c8) { const u32x4 z = *(const u32x4*)(zr + c8 * 8), t = *(const u32x4*)(tr + c8 * 8);
            s += bflo(z.x) * bflo(t.x) + bfhi(z.x) * bfhi(t.x) + bflo(z.y) * bflo(t.y) + bfhi(z.y) * bfhi(t.y) + bflo(z.z) * bflo(t.z) + bfhi(z.z) * bfhi(t.z) + bflo(z.w) * bflo(t.w) + bfhi(z.w) * bfhi(t.w); }
        dst[(size_t)C.tid * ldd + half] = (bf16)(cvt_pk_bf16(s, 0.f) & 0xffff);
    }
}
__device__ __forceinline__ void pool_all(const Ctx& C) {
    const bf16* Z = WSP(bf16, WS_Z); bf16* Y1 = WSP(bf16, WS_Y) + (size_t)T * 256;
    const size_t gtid = (size_t)C.bid * 512 + C.tid, gth = (size_t)C.G * 512;
    for (size_t i = gtid; i < (size_t)T * 32; i += gth) {
        const int row = (int)(i >> 5), c8 = (int)(i & 31), g = c8 >> 3;
        const int L = row < TL ? SEQ : CTX, s0 = row < TL ? (row & ~2047) : TL + ((row - TL) & ~255), t = row - s0, half = 1 << g;
        int lo = t - half; lo = lo < 0 ? 0 : lo; int hi = t + half; hi = hi > L ? L : hi;
        float a[8];
#pragma unroll
        for (int q = 0; q < 8; ++q) a[q] = 0.f;
        u32x4 wv[16];
#pragma unroll
        for (int q = 0; q < 16; ++q) { const int tt = t - 8 + q; wv[q] = (u32x4){0u, 0u, 0u, 0u}; if (tt >= lo && tt < hi) wv[q] = *(const u32x4*)(Z + (size_t)(s0 + tt) * NZ + ZP + c8 * 8); }
        const u32x4 me = *(const u32x4*)(Z + (size_t)row * NZ + ZP + c8 * 8);
#pragma unroll
        for (int q = 0; q < 16; ++q) asm volatile("" : "+v"(wv[q]));
#pragma unroll
        for (int q = 0; q < 16; ++q) { const u32x4 v = wv[q];
            a[0] += bflo(v.x); a[1] += bfhi(v.x); a[2] += bflo(v.y); a[3] += bfhi(v.y); a[4] += bflo(v.z); a[5] += bfhi(v.z); a[6] += bflo(v.w); a[7] += bfhi(v.w); }
        const float inv = 1.0f / (float)(hi - lo);
        u32x4 o; o.x = cvt_pk_bf16(a[0] * inv - bflo(me.x), a[1] * inv - bfhi(me.x)); o.y = cvt_pk_bf16(a[2] * inv - bflo(me.y), a[3] * inv - bfhi(me.y));
        o.z = cvt_pk_bf16(a[4] * inv - bflo(me.z), a[5] * inv - bfhi(me.z)); o.w = cvt_pk_bf16(a[6] * inv - bflo(me.w), a[7] * inv - bfhi(me.w));
        *(u32x4*)(Y1 + (size_t)row * 256 + c8 * 8) = o;
    }
}
__device__ __forceinline__ void phase_b0(const Ctx& C, int l) {
    const bool wc = l < DEPTH - 1;
    const int n_na = 256, n_nac = wc ? 32 : 0, n_q = (T / 128) * 3, n_kv = (T / 128) * 4, n_f = wc ? 288 : 256;
    const int total = n_na + n_nac + n_q + n_kv + n_f;
    for (int u = C.bid; u < total; u += C.G) {
        int v = u;
        if (v < n_na) { na_unit_latent(C, l, v); continue; } v -= n_na;
        if (v < n_nac) { na_unit_ctx(C, v); continue; } v -= n_nac;
        if (v < n_q) { mlaq_tile(C, l, v); continue; } v -= n_q;
        if (v < n_kv) { mlakv_tile(C, l, v); continue; } v -= n_kv;
        fft1_tile(C, v);
    }
    pool_all(C);
}

__device__ __forceinline__ void mla_unit(const Ctx& C, int u, bool ctxq) {
    const bf16* QM = WSP(bf16, WS_QM); const bf16* KM = WSP(bf16, WS_KM); const bf16* VM = WSP(bf16, WS_VM);
    bf16* Y3 = WSP(bf16, WS_Y) + (size_t)3 * T * 256;
    const int w = C.wave;
    if (!ctxq) {
        const int b = u >> 5, hh = (u >> 3) & 3, qb = u & 7;
        const size_t lat0 = (size_t)b * SEQ, ctx0 = (size_t)TL + (size_t)b * CTX, q0 = lat0 + qb * 256 + w * 32;
        {
            const int kx = u & 31;
            for (int it = 0; it < 3; ++it) { const int i = (it * 32 + kx) * 512 + C.tid, r = i / 20, hl = i - r * 20;
                if (r < 2304) { const size_t row = (r < 2048) ? lat0 + r : ctx0 + (r - 2048);
                    l2_touch(C, hl < 12 ? (const char*)(KM + row * 384) + hl * 64 : (const char*)(VM + row * 256) + (hl - 12) * 64); } }
        }
        attn_unit<96, false>(C, QM + q0 * 384 + hh * 96, 384, KM + lat0 * 384 + hh * 96, VM + lat0 * 256 + hh * 64, 32,
                             KM + ctx0 * 384 + hh * 96, VM + ctx0 * 256 + hh * 64, 4, 384, 256, Y3 + q0 * 256 + hh * 64, 256, 0, 0, 0, 0, nullptr);
    } else {
        const int b = u >> 2, hh = u & 3;
        const size_t ctx0 = (size_t)TL + (size_t)b * CTX, q0 = ctx0 + w * 32;
        attn_unit<96, false>(C, QM + q0 * 384 + hh * 96, 384, KM + ctx0 * 384 + hh * 96, VM + ctx0 * 256 + hh * 64, 4,
                             nullptr, nullptr, 0, 384, 256, Y3 + q0 * 256 + hh * 64, 256, 0, 0, 0, 0, nullptr);
    }
    __syncthreads();
}
__device__ __forceinline__ void fft2_tile(const Ctx& C, int u, bool ctxq) {
    bf16* Y2 = WSP(bf16, WS_Y) + (size_t)2 * T * 256;
    if (!ctxq) {
        const int ux = u >> 5, uk = u & 31, tm = (ux >> 1) * 4 + (uk & 3), tn = (ux & 1) * 8 + (uk >> 2), b = tn >> 1;
        const bf16* A = WSP(bf16, WS_AFFT); const bf16* Bt = WSP(bf16, WS_FB);
        auto arow = [=](int r) { return A + (size_t)(tm * 128 + r) * 2048; };
        auto brow = [=](int r) { return Bt + (size_t)(tn * 128 + r) * 2048; };
        auto epi = [=](const f32x4 (&acc)[4][2], int wr, int wc, int fr, int fq) {
#pragma unroll
            for (int m = 0; m < 4; ++m)
#pragma unroll
                for (int n = 0; n < 2; ++n) { const int k1 = tm * 128 + wr * 64 + m * 16 + fr, chn = (tn & 1) * 128 + wc * 32 + n * 16 + 4 * fq;
                    u32x2 w; w.x = cvt_pk_bf16(acc[m][n][0], acc[m][n][1]); w.y = cvt_pk_bf16(acc[m][n][2], acc[m][n][3]);
                    *(u32x2*)(Y2 + ((size_t)b * SEQ + k1) * 256 + chn) = w; }
        };
        sgemm_tile_d4(C, arow, brow, 2048, epi);
    } else {
        const int tm = u >> 4, tn = u & 15, b = tn >> 1;
        const bf16* A = WSP(bf16, WS_AFFTC); const bf16* Bt = WSP(bf16, WS_FBC);
        auto arow = [=](int r) { return A + (size_t)(tm * 128 + r) * 256; };
        auto brow = [=](int r) { return Bt + (size_t)(tn * 128 + r) * 256; };
        auto epi = [=](const f32x4 (&acc)[4][2], int wr, int wc, int fr, int fq) {
#pragma unroll
            for (int m = 0; m < 4; ++m)
#pragma unroll
                for (int n = 0; n < 2; ++n) { const int k1 = tm * 128 + wr * 64 + m * 16 + fr, chn = (tn & 1) * 128 + wc * 32 + n * 16 + 4 * fq;
                    u32x2 w; w.x = cvt_pk_bf16(acc[m][n][0], acc[m][n][1]); w.y = cvt_pk_bf16(acc[m][n][2], acc[m][n][3]);
                    *(u32x2*)(Y2 + ((size_t)TL + (size_t)b * CTX + k1) * 256 + chn) = w; }
        };
        sgemm_tile_d4(C, arow, brow, 256, epi);
    }
}
__device__ __forceinline__ void phase_b1(const Ctx& C, int l) {
    const bool wc = l < DEPTH - 1;
    const int n_m = 256, n_f = 256, n_mc = wc ? 32 : 0, n_fc = wc ? 32 : 0;
    const int total = n_m + n_f + n_mc + n_fc;
    for (int u = C.bid; u < total; u += C.G) {
        int v = u;
        if (v < n_m) { mla_unit(C, v, false); continue; } v -= n_m;
        if (v < n_f) { fft2_tile(C, v, false); continue; } v -= n_f;
        if (v < n_mc) { mla_unit(C, v, true); continue; } v -= n_mc;
        fft2_tile(C, v, true);
    }
}

__device__ __forceinline__ void phase_e(const Ctx& C, int l, int nrows) {
    LAS float* wr = (LAS float*)C.lds;
    LAS float* lgl = (LAS float*)(C.lds + 65536);
    LAS float* lbl = lgl + 1024;
    LAS float* mdl = lbl + 1024;
    const int tid = C.tid, lane = C.lane, rg = lane >> 4, li = lane & 15;
    {   f32x4 wv[8];
#pragma unroll
        for (int q = 0; q < 8; ++q) wv[q] = *(const f32x4*)(C.in[I_WROUTER] + (size_t)l * 16384 + 4 * (tid + 512 * q));
        const f32x4 gv = *(const f32x4*)(C.in[(tid < 256) ? I_LN1G : I_LN1B] + l * D + 4 * (tid & 255));
#pragma unroll
        for (int q = 0; q < 8; ++q) { const int i4 = tid + 512 * q, d = i4 >> 2, e4 = (i4 & 3) * 4; wr[(e4 + 0) * 1024 + d] = wv[q][0]; wr[(e4 + 1) * 1024 + d] = wv[q][1]; wr[(e4 + 2) * 1024 + d] = wv[q][2]; wr[(e4 + 3) * 1024 + d] = wv[q][3]; }
        *(LAS f32x4*)(((tid < 256) ? lgl : lbl) + 4 * (tid & 255)) = gv; }
    const int bkk = blk_k(C), bxx = blk_x(C), bp = (bkk < 8) ? bxx * 8 + bkk : 64 + bxx * 24 + (bkk - 8);
    const int gw = bp * 8 + C.wave, NGW = C.G * 8, ngroups = nrows >> 2;
    const float* mod = WSP(float, WS_MOD) + (size_t)l * 9 * 6144;
    const float* X1 = WSP(float, WS_X1);
    float* AFFT = WSP(float, WS_AFF);
    f32x4 nx[16]; f32x4 nmd;
    const int mdv = tid >> 8, mdc = (tid & 255) * 4;
    if (gw < ngroups) {
        const int row = 4 * gw + rg; const float* mr = mod + (size_t)mod_row(4 * gw) * 6144;
#pragma unroll
        for (int j = 0; j < 16; ++j) nx[j] = *(const f32x4*)(X1 + (size_t)row * D + 4 * li + 64 * j);
        nmd = *(const f32x4*)(mr + (mdv ? 3072 : 4096) + mdc);
    }
    for (int g = gw, it = 0; g < ngroups; g += NGW, ++it) {
        {   f32x4 w = nmd; if (mdv == 0) w = w + 1.0f; *(LAS f32x4*)(mdl + (it & 1) * 2048 + mdv * 1024 + mdc) = w; }
        __syncthreads();
        const LAS float* scl = mdl + (it & 1) * 2048; const LAS float* shl = scl + 1024;
        f32x4 v[16]; float s = 0.f;
        const int row = 4 * g + rg;
        if (4 * g < TL) {
#pragma unroll
            for (int j = 0; j < 16; ++j) v[j] = nx[j];
        } else {
            const float* hr = WSP(float, WS_H) + (size_t)row * D + 4 * li; const float* g1 = mod + (size_t)8 * 6144 + 2048 + 4 * li;
            const float* pc = (const float*)(C.ws + WS_XE + (size_t)4 * NE * 256 * D * 2) + (size_t)(row - TL) * D + 4 * li;
#pragma unroll
            for (int j = 0; j < 16; ++j) { const f32x4 p0 = *(const f32x4*)(pc + 64 * j), p1 = *(const f32x4*)(pc + (size_t)TC * D + 64 * j), p2 = *(const f32x4*)(pc + (size_t)2 * TC * D + 64 * j), p3 = *(const f32x4*)(pc + (size_t)3 * TC * D + 64 * j);
                v[j] = *(const f32x4*)(hr + 64 * j) * DN_ALPHA + *(const f32x4*)(g1 + 64 * j) * ((p0 + p1) + (p2 + p3));
                *(f32x4*)(WSP(float, WS_X1) + (size_t)row * D + 4 * li + 64 * j) = v[j]; }
        }
#pragma unroll
        for (int j = 0; j < 16; ++j) s += (v[j][0] + v[j][1]) + (v[j][2] + v[j][3]);
        if (g + NGW < ngroups) { const int gn = g + NGW, rn = 4 * gn + rg; const float* mr = mod + (size_t)mod_row(4 * gn) * 6144;
            if (4 * gn < TL) {
#pragma unroll
                for (int j = 0; j < 16; ++j) nx[j] = *(const f32x4*)(X1 + (size_t)rn * D + 4 * li + 64 * j);
            }
            nmd = *(const f32x4*)(mr + (mdv ? 3072 : 4096) + mdc); }
        const float mean = row16_sum(s) * (1.0f / D); float q = 0.f;
#pragma unroll
        for (int j = 0; j < 16; ++j) { v[j] = v[j] - mean; q += (v[j][0] * v[j][0] + v[j][1] * v[j][1]) + (v[j][2] * v[j][2] + v[j][3] * v[j][3]); }
        const float rstd = 1.0f / sqrtf(row16_sum(q) * (1.0f / D) + LN_EPS);
        float lgt[16];
#pragma unroll
        for (int e = 0; e < 16; ++e) lgt[e] = 0.f;
        bf16* ud = WSP(bf16, WS_U2) + (size_t)row * D + 4 * li;
        if (li == 0) { typedef float f32x2v __attribute__((ext_vector_type(2))); *(f32x2v*)(WSP(float, WS_ST1) + (size_t)row * 2) = (f32x2v){mean, rstd}; }
#pragma unroll
        for (int j = 0; j < 16; ++j) { const int c = 4 * li + 64 * j;
            const f32x4 y = v[j] * rstd * *(const LAS f32x4*)(lgl + c) + *(const LAS f32x4*)(lbl + c);
            const f32x4 uu = y * *(const LAS f32x4*)(scl + c) + *(const LAS f32x4*)(shl + c);
            u32x2 w; w.x = cvt_pk_bf16(uu[0], uu[1]); w.y = cvt_pk_bf16(uu[2], uu[3]); st_wt8(ud + 64 * j, w);
#pragma unroll
            for (int eh = 0; eh < 4; ++eh) {
                f32x4 ww[4];
#pragma unroll
                for (int e = 0; e < 4; ++e) ww[e] = *(const LAS f32x4*)(wr + (4 * eh + e) * 1024 + c);
                __builtin_amdgcn_sched_barrier(0);
#pragma unroll
                for (int e = 0; e < 4; ++e) lgt[4 * eh + e] += (uu[0] * ww[e][0] + uu[1] * ww[e][1]) + (uu[2] * ww[e][2] + uu[3] * ww[e][3]);
                __builtin_amdgcn_sched_barrier(0);
            }
        }
        float mx = -1e30f;
#pragma unroll
        for (int e = 0; e < 16; ++e) { lgt[e] = row16_sum(lgt[e]); mx = fmaxf(mx, lgt[e]); }
        float den = 0.f;
#pragma unroll
        for (int e = 0; e < 16; ++e) { lgt[e] = __expf(lgt[e] - mx); den += lgt[e]; }
        const float inv = 1.0f / den; float mine = 0.f;
#pragma unroll
        for (int e = 0; e < 16; ++e) mine = (li == e) ? lgt[e] * inv : mine;
        AFFT[(size_t)li * T + row] = mine;
    }
    __syncthreads();
}
__device__ __forceinline__ void phase_f(const Ctx& C, int l) {
    const bool wc = l < DEPTH - 1;
    const int nunits = 128 + (wc ? 128 : 0);
    LAS unsigned* hist = (LAS unsigned*)(C.lds);
    LAS unsigned* wsum = (LAS unsigned*)(C.lds + 256);
    const int tid = C.tid, lane = C.lane, wave = C.wave;
    const float* AFF = WSP(float, WS_AFF); int* SLOT = WSP(int, WS_SLOT); float* GATEV = WSP(float, WS_GATEV); int* SROW = WSP(int, WS_SROW);
    {
        const int bx = blk_x(C), bk = blk_k(C); const int u = (bk < 16) ? bx * 16 + bk : 128 + bx * 16 + (bk - 16);
        if (u < nunits) {
        const bool isc = u >= 128; const int v = isc ? u - 128 : u, b = v >> 4, e = v & 15;
        const int cap = isc ? CAPC : CAPL, vpt = isc ? 1 : 4;
        const int row0 = isc ? TL + b * CTX : b * SEQ;
        const int sbase = e * ESLOT + (isc ? NB * CAPL + b * CAPC : b * CAPL);
        const bool have = isc ? (tid < 256) : true;
        unsigned key[4];
#pragma unroll
        for (int i = 0; i < 4; ++i) { key[i] = 0u; if (have && i < vpt) key[i] = __float_as_uint(AFF[(size_t)e * T + row0 + tid * vpt + i]); }
        if (tid < 48) hist[tid] = 0u;
        __syncthreads();
        unsigned prefix = 0u; int kth = cap;
#pragma unroll 1
        for (int it = 0; it < 8; ++it) {
            const int shift = 28 - 4 * it; LAS unsigned* hb = hist + 16 * (it % 3);
            if (tid < 16) hist[16 * ((it + 1) % 3) + tid] = 0u;
            unsigned mycnt = 0u;
#pragma unroll
            for (int i = 0; i < 4; ++i) {
                const bool in = have && i < vpt && (it == 0 || (key[i] >> (shift + 4)) == (prefix >> (shift + 4)));
                const unsigned dg = (key[i] >> shift) & 15u;
#pragma unroll
                for (int d = 0; d < 16; ++d) { const unsigned c = (unsigned)__popcll(__ballot(in && dg == (unsigned)d)); mycnt = (lane == d) ? mycnt + c : mycnt; }
            }
            if (lane < 16 && mycnt) atomicAdd((unsigned*)(hb + lane), mycnt);
            __syncthreads();
            unsigned cum = 0u; int dsel = 0; int kn = kth;
#pragma unroll
            for (int d = 15; d >= 0; --d) { const unsigned h = hb[d]; const bool hit = (cum < (unsigned)kth) && (cum + h >= (unsigned)kth); if (hit) { dsel = d; kn = kth - (int)cum; } cum += h; }
            prefix |= ((unsigned)dsel << shift); kth = kn;
        }
        const unsigned thr = prefix;
        unsigned neq = 0;
#pragma unroll
        for (int i = 0; i < 4; ++i) if (have && i < vpt) neq += (key[i] == thr);
        unsigned incl = neq;
#pragma unroll
        for (int o = 1; o < 64; o <<= 1) { const unsigned t2 = __shfl_up(incl, o); if (lane >= o) incl += t2; }
        if (lane == 63) wsum[wave] = incl;
        __syncthreads();
        unsigned woff = 0;
        for (int w2 = 0; w2 < wave; ++w2) woff += wsum[w2];
        unsigned eqrank = woff + incl - neq;
        unsigned sel[4]; unsigned nsel = 0;
#pragma unroll
        for (int i = 0; i < 4; ++i) { sel[i] = 0u; if (have && i < vpt) { if (key[i] > thr) sel[i] = 1u; else if (key[i] == thr) { sel[i] = ((int)eqrank < kth) ? 1u : 0u; ++eqrank; } nsel += sel[i]; } }
        incl = nsel;
#pragma unroll
        for (int o = 1; o < 64; o <<= 1) { const unsigned t2 = __shfl_up(incl, o); if (lane >= o) incl += t2; }
        if (lane == 63) wsum[8 + wave] = incl;
        __syncthreads();
        woff = 0;
        for (int w2 = 0; w2 < wave; ++w2) woff += wsum[8 + w2];
        unsigned pos = woff + incl - nsel;
#pragma unroll
        for (int i = 0; i < 4; ++i) if (have && i < vpt) { const int t = tid * vpt + i; int slot = -1;
            if (sel[i]) { slot = sbase + (int)pos; SROW[slot] = row0 + t; GATEV[slot] = __uint_as_float(key[i]); ++pos; }
            SLOT[(size_t)(row0 + t) * 16 + e] = slot; }
        __syncthreads();
    }
    }
}
__device__ __forceinline__ void phase_i(const Ctx& C, int l, int nrows) {
    LAS float* lgl = (LAS float*)C.lds;
    LAS float* lbl = lgl + 1024;
    LAS float* mdl = lbl + 1024;
    const int tid = C.tid, lane = C.lane, rg = lane >> 4, li = lane & 15;
    LAS float* l1g = mdl + 6144;
    LAS float* l1b = l1g + 1024;
    for (int i = tid; i < 1024; i += 512) { lgl[i] = C.in[I_LN2G][l * D + i]; lbl[i] = C.in[I_LN2B][l * D + i]; l1g[i] = C.in[I_LN1G][l * D + i]; l1b[i] = C.in[I_LN1B][l * D + i]; }
    const int bkk = blk_k(C), bxx = blk_x(C), bp = (bkk < 8) ? bxx * 8 + bkk : 64 + bxx * 24 + (bkk - 8);
    const int gw = bp * 8 + C.wave, NGW = C.G * 8, ngroups = nrows >> 2;
    const float* mod = WSP(float, WS_MOD) + (size_t)l * 9 * 6144;
    const float* modn = WSP(float, WS_MOD) + (size_t)(l + 1 < DEPTH ? l + 1 : l) * 9 * 6144;
    const int* SLOT = WSP(int, WS_SLOT); const float* GATEV = WSP(float, WS_GATEV); const bf16* YE = WSP(bf16, WS_YE); const bf16* YEC = WSP(bf16, WS_XE);
    float* Hb = WSP(float, WS_H); bf16* U1b = WSP(bf16, WS_U1); const float* X1b = WSP(float, WS_X1);
    const int mdv = tid >> 8, mdc = (tid & 255) * 4;
    auto mdload = [&](int g4row) -> f32x4 { const int r = mod_row(g4row); const float* p = (mdv == 0) ? mod + (size_t)r * 6144 + 5120 + mdc : modn + (size_t)r * 6144 + (mdv == 1 ? 1024 : 0) + mdc; return *(const f32x4*)p; };
    f32x4 nmd0 = (f32x4){0.f, 0.f, 0.f, 0.f}, nmd1 = nmd0;
    if (gw < ngroups) { nmd0 = mdload(4 * gw); if (tid < 256) { const int r = mod_row(4 * gw); nmd1 = *(const f32x4*)(modn + (size_t)r * 6144 + mdc); } }
    for (int g = gw, it = 0; g < ngroups; g += NGW, ++it) {
        {   LAS float* buf = mdl + (it & 1) * 3072;
            if (mdv < 2) { f32x4 w = nmd0; if (mdv == 1) w = w + 1.0f; *(LAS f32x4*)(buf + mdv * 1024 + mdc) = w; }
            if (tid < 256) *(LAS f32x4*)(buf + 2048 + mdc) = nmd1; }
        __syncthreads();
        const LAS float* g2l = mdl + (it & 1) * 3072; const LAS float* scl = g2l + 1024; const LAS float* shl = g2l + 2048;
        const int row = 4 * g + rg;
        const int myslot = SLOT[(size_t)row * 16 + li];
        f32x4 hv[16];
        typedef float f32x2v __attribute__((ext_vector_type(2))); const f32x2v st1 = *(const f32x2v*)(WSP(float, WS_ST1) + (size_t)row * 2);
#pragma unroll
        for (int j = 0; j < 16; ++j) hv[j] = *(const f32x4*)(X1b + (size_t)row * D + 4 * li + 64 * j);
        if (g + NGW < ngroups) { const int gn = g + NGW; nmd0 = mdload(4 * gn); if (tid < 256) { const int r = mod_row(4 * gn); nmd1 = *(const f32x4*)(modn + (size_t)r * 6144 + mdc); } }
        const unsigned long long bal = __ballot(myslot >= 0);
        unsigned m = (unsigned)(bal >> (16 * rg)) & 0xffffu;
#pragma unroll
        for (int j = 0; j < 16; ++j) { const int c = 4 * li + 64 * j; hv[j] = ((hv[j] - st1.x) * st1.y * *(const LAS f32x4*)(l1g + c) + *(const LAS f32x4*)(l1b + c)) * DN_ALPHA;
            if ((j & 3) == 3) __builtin_amdgcn_sched_barrier(0); }
        const bool isctx = (4 * g) >= TL;
        int ph = 0;
        while (__any(m != 0u)) {
            const bf16* p[2]; float gt[2];
            if (!isctx) {
#pragma unroll
                for (int k = 0; k < 2; ++k) { const bool ok = m != 0u; const int e = ok ? (int)__builtin_ctz(m) : 0; m = ok ? (m & (m - 1u)) : 0u;
                    const int sv = __shfl(myslot, (rg << 4) + e); const int se = ok ? sv : 0; gt[k] = ok ? GATEV[se] : 0.f; p[k] = YE + (size_t)se * D + 4 * li; }
            } else {
                const bool ok = m != 0u; const int e = ok ? (int)__builtin_ctz(m) : 0; if (ph) m = ok ? (m & (m - 1u)) : 0u;
                const int sv = __shfl(myslot, (rg << 4) + e); const int se = ok ? sv : NB * CAPL; const float gv = ok ? GATEV[se] : 0.f;
                const int ex = se / ESLOT, cr = se - ex * ESLOT - NB * CAPL; const bf16* base = YEC + ((size_t)ex * 256 + cr) * D + 4 * li + (size_t)(2 * ph) * (NE * 256) * D;
                p[0] = base; p[1] = base + (size_t)(NE * 256) * D; gt[0] = gv; gt[1] = gv; ph ^= 1;
            }
            const LAS float* g2p = g2l + 4 * li; asm volatile("" : "+v"(g2p));
            u32x2 w[2][16];
#pragma unroll
            for (int k = 0; k < 2; ++k)
#pragma unroll
                for (int j = 0; j < 16; ++j) w[k][j] = *(const u32x2*)(p[k] + 64 * j);
#pragma unroll
            for (int j = 0; j < 16; ++j) { const f32x4 g2v = *(const LAS f32x4*)(g2p + 64 * j);
#pragma unroll
                for (int k = 0; k < 2; ++k) { const f32x4 t = g2v * gt[k];
                    hv[j][0] += t[0] * bflo(w[k][j].x); hv[j][1] += t[1] * bfhi(w[k][j].x); hv[j][2] += t[2] * bflo(w[k][j].y); hv[j][3] += t[3] * bfhi(w[k][j].y); }
                if ((j & 3) == 3) __builtin_amdgcn_sched_barrier(0); }
        }
        float s = 0.f;
#pragma unroll
        for (int j = 0; j < 16; ++j) s += (hv[j][0] + hv[j][1]) + (hv[j][2] + hv[j][3]);
        const float mean = row16_sum(s) * (1.0f / D); float q = 0.f;
#pragma unroll
        for (int j = 0; j < 16; ++j) { hv[j] = hv[j] - mean; q += (hv[j][0] * hv[j][0] + hv[j][1] * hv[j][1]) + (hv[j][2] * hv[j][2] + hv[j][3] * hv[j][3]); }
        const float rstd = 1.0f / sqrtf(row16_sum(q) * (1.0f / D) + LN_EPS);
#pragma unroll
        for (int j = 0; j < 16; ++j) { const int c = 4 * li + 64 * j;
            const f32x4 y = hv[j] * rstd * *(const LAS f32x4*)(lgl + c) + *(const LAS f32x4*)(lbl + c);
            if (l + 1 < DEPTH) { *(f32x4*)(Hb + (size_t)row * D + c) = y; const f32x4 uu = y * *(const LAS f32x4*)(scl + c) + *(const LAS f32x4*)(shl + c);
                u32x2 w; w.x = cvt_pk_bf16(uu[0], uu[1]); w.y = cvt_pk_bf16(uu[2], uu[3]); *(u32x2*)(U1b + (size_t)row * D + c) = w; }
            else *(f32x4*)(C.out + (size_t)row * D + c) = y;
            if ((j & 3) == 3) __builtin_amdgcn_sched_barrier(0);
        }
    }
    __syncthreads();
}

constexpr int PH_PER_LAYER = 11, N_PHASES = 2 + DEPTH * PH_PER_LAYER;
__global__ void __launch_bounds__(512, 2) mega(Args args) {
    extern __shared__ __attribute__((aligned(16))) unsigned char lds_raw[];
#define MKCTX() Ctx C; { GAS unsigned char* w_ = (GAS unsigned char*)args.ws; asm volatile("" : "+s"(w_)); int t_ = threadIdx.x; asm volatile("" : "+v"(t_)); \
        C.lds = (LAS unsigned char*)lds_raw; C.ws = w_; C.in = args.in; C.out = args.out; C.tid = t_; C.lane = t_ & 63; C.wave = __builtin_amdgcn_readfirstlane(t_ >> 6); C.bid = (gridDim.x & 7u) ? blockIdx.x : (blockIdx.x & 7u) * (gridDim.x >> 3) + (blockIdx.x >> 3); C.G = gridDim.x; }
    LAS unsigned char* lds0 = (LAS unsigned char*)lds_raw;
    volatile LAS unsigned* misc = (volatile LAS unsigned*)(lds0 + LDS_MISC);
    if (threadIdx.x < 4) misc[threadIdx.x] = 0u;
    __syncthreads();
    const int lo = args.ph_lo, hi = args.ph_hi;
    const bool multi = (hi - lo) > 1;
    XcdBarrier bar; bar.bar = (unsigned*)(args.ws + WS_CTL) + 4096; bar.x = 0; bar.st = misc;
    if (multi) bar = xcd_barrier_post((unsigned*)(args.ws + WS_CTL) + 4096, misc);
#ifndef PHASE_MASK
#define PHASE_MASK 0xFFFFu
#endif
#define PM(i) (((PHASE_MASK) >> (i)) & 1u)
#define IN(k) (lo <= (k) && (k) < hi)
#define SEAM(k) do { if (IN((k) + 1)) xcd_barrier(bar); } while (0)
    if (PM(0) && IN(0)) { MKCTX(); phase_prep(C); SEAM(0); }
    if (PM(1) && IN(1)) { MKCTX(); phase_init(C); SEAM(1); }
    for (int l = 0; l < DEPTH; ++l) {
        const int p0 = 2 + l * PH_PER_LAYER;
        const int nrows = (l < DEPTH - 1) ? T : TL, mt = (l < DEPTH - 1) ? 9 : 8;
        if (PM(2) && IN(p0 + 0)) { MKCTX(); phase_inproj(C, l); SEAM(p0 + 0); }
        if (PM(3) && IN(p0 + 1)) { MKCTX(); phase_b0(C, l); SEAM(p0 + 1); }
        if (PM(4) && IN(p0 + 2)) { MKCTX(); phase_b1(C, l); SEAM(p0 + 2); }
        if (PM(5) && IN(p0 + 3)) { MKCTX(); phase_c1(C, l, nrows); if (l < DEPTH - 1 && blk_k(C) >= 16) slot_dn(C, l + 1, blk_x(C) * 16 + blk_k(C) - 16, DN_C1_FIRST, DN_C1_CNT); SEAM(p0 + 3); }
        if (PM(6) && IN(p0 + 4)) { MKCTX(); phase_c2(C, l, nrows); if (l < DEPTH - 1 && blk_k(C) >= 16) slot_gu(C, l + 1, blk_x(C) * 16 + blk_k(C) - 16, GU_C2_FIRST, GU_C2_CNT); SEAM(p0 + 4); }
        if (PM(7) && IN(p0 + 5)) { MKCTX(); phase_d(C, l, nrows); if (l < DEPTH - 1 && blk_k(C) >= 16) slot_gu(C, l + 1, blk_x(C) * 16 + blk_k(C) - 16, GU_D_FIRST, GU_D_CNT); SEAM(p0 + 5); }
        if (PM(8) && IN(p0 + 6)) { MKCTX(); phase_e(C, l, nrows); if (l < DEPTH - 1 && blk_k(C) >= 8) slot_dn(C, l + 1, blk_x(C) * 24 + blk_k(C) - 8, DN_E_FIRST, DN_E_CNT); SEAM(p0 + 6); }
        if (PM(9) && IN(p0 + 7)) { MKCTX(); phase_f(C, l); if (l < DEPTH - 1 && blk_k(C) >= 16) slot_gu(C, l + 1, blk_x(C) * 16 + blk_k(C) - 16, GU_F_FIRST, GU_F_CNT); SEAM(p0 + 7); }
        if (PM(10) && IN(p0 + 8)) { MKCTX(); phase_g(C, l, mt); SEAM(p0 + 8); }
        if (PM(11) && IN(p0 + 9)) { MKCTX(); phase_h(C, l, mt); SEAM(p0 + 9); }
        if (PM(12) && IN(p0 + 10)) { MKCTX(); phase_i(C, l, nrows); if (l < DEPTH - 1 && blk_k(C) >= 8) slot_dn(C, l + 1, blk_x(C) * 24 + blk_k(C) - 8, DN_I_FIRST, DN_I_CNT); SEAM(p0 + 10); }
    }
#undef IN
#undef SEAM
}

#ifdef DBG_STOP
__global__ void dbg_dump(const unsigned char* src, int mode, float* out, size_t n) {
    for (size_t i = (size_t)blockIdx.x * blockDim.x + threadIdx.x; i < n; i += (size_t)gridDim.x * blockDim.x) {
        if (mode == 0) out[i] = (float)((const unsigned short*)src)[i];
        else out[i] = (float)(((const unsigned*)src)[i] >> 8);
    }
}
__global__ void dbg_scan(const unsigned char* src, size_t n, int mode, float mark, float* out) {
    const size_t t = (size_t)blockIdx.x * blockDim.x + threadIdx.x, NT = (size_t)gridDim.x * blockDim.x;
    bool bad = false;
    for (size_t i = t; i < n; i += NT) { const float v = mode == 0 ? __uint_as_float(((unsigned)((const unsigned short*)src)[i]) << 16) : ((const float*)src)[i]; if (!(fabsf(v) < 1e6f)) bad = true; }
    out[t] = bad ? mark : 0.0f;
}
__global__ void dbg_check(const float* const* dummy, const float* x, const float* c, const float* cctx, const float* wmod, const float* bmod, const float* win, const unsigned char* ws, float* out) {
    const size_t t = (size_t)blockIdx.x * blockDim.x + threadIdx.x;
    const float* MOD = (const float*)(ws + WS_MOD); const bf16* WIN = (const bf16*)(ws + WS_WIN); const bf16* U1 = (const bf16*)(ws + WS_U1); const bf16* Z = (const bf16*)(ws + WS_Z);
    if ((DBG_SEG & 1) && t < 9 * 6144) { const int r = (int)(t / 6144), n = (int)(t % 6144); double s = 0; for (int k = 0; k < 1024; ++k) { const float v = r < 8 ? c[r * 1024 + k] : cctx[k]; s += (double)(v / (1.0f + expf(-v))) * wmod[(size_t)k * 6144 + n]; }
        s += bmod[n]; const float got = MOD[(size_t)r * 6144 + n]; out[t] = (fabs(got - s) > 1e-3 * fabs(s) + 1e-4) ? 1e6f : 0.f; }
    if (DBG_SEG & 2) { const size_t idx = (t * 6661) % ((size_t)1696 * 1024); const int n = (int)(idx / 1024), k = (int)(idx % 1024); const float ref = win[(size_t)k * IN_COLS + n] * (n < 256 ? NA_QS : 1.0f);
      const float got = __uint_as_float(((unsigned)WIN[(size_t)n * 1024 + k]) << 16); out[262144 + t] = (fabsf(got - ref) > 0.01f * fabsf(ref) + 1e-6f) ? 1e5f : 0.f; }
    if (DBG_SEG & 4) { const size_t idx = (t * 7919) % ((size_t)TL * 1024); const int row = (int)(idx / 1024), k = (int)(idx % 1024), r = row >> 11; const float ref = x[idx] * (1.0f + MOD[(size_t)r * 6144 + 1024 + k]) + MOD[(size_t)r * 6144 + k];
      const float got = __uint_as_float(((unsigned)U1[idx]) << 16); out[2 * 262144 + t] = (fabsf(got - ref) > 0.01f * fabsf(ref) + 1e-3f) ? 1e4f : 0.f; }
    if (DBG_SEG & 8) { const size_t idx = (t * 104729) % ((size_t)T * 1696); const int row = (int)(idx / 1696), col = (int)(idx % 1696); float sref = 0.f;
      for (int k = 0; k < 1024; ++k) sref += __uint_as_float(((unsigned)U1[(size_t)row * 1024 + k]) << 16) * __uint_as_float(((unsigned)WIN[(size_t)col * 1024 + k]) << 16);
      const float got = __uint_as_float(((unsigned)Z[(size_t)row * NZ + col]) << 16); out[3 * 262144 + t] = (fabsf(got - sref) > 0.02f * fabsf(sref) + 0.05f) ? 1e3f : 0.f; }
}
#endif
extern "C" void kernel_launch(void* const* d_in, const int* in_sizes, int n_in, void* d_out, int out_size, void* d_ws, size_t ws_size, hipStream_t stream) {
    static int grid = 0;
    if (grid == 0) {
        if (n_in != 24 || ws_size < WS_END) { fprintf(stderr, "kernel_launch: unexpected inputs (n_in %d, ws %zu, need %zu)\n", n_in, ws_size, (size_t)WS_END); grid = -1; return; }
        int dev = 0, cus = 0, per_cu = 0;
        if (hipGetDevice(&dev) != hipSuccess || hipDeviceGetAttribute(&cus, hipDeviceAttributeMultiprocessorCount, dev) != hipSuccess) { grid = -1; return; }
        if (hipFuncSetAttribute((const void*)mega, hipFuncAttributeMaxDynamicSharedMemorySize, LDS_BYTES) != hipSuccess) { fprintf(stderr, "kernel_launch: hipFuncSetAttribute failed\n"); grid = -1; return; }
        if (hipOccupancyMaxActiveBlocksPerMultiprocessor(&per_cu, (const void*)mega, 512, LDS_BYTES) != hipSuccess || per_cu < 1) fprintf(stderr, "kernel_launch: occupancy query says %d\n", per_cu);
        (void)hipGetLastError();
        grid = cus;
    }
    if (grid < 0) return;
#ifdef POISON_WS
    (void)hipMemsetAsync((char*)d_ws, 0x00, WS_END, stream);
#endif
    (void)hipMemsetAsync((char*)d_ws + WS_CTL, 0, CTL_BYTES, stream);
    Args a{};
    for (int i = 0; i < 24; ++i) a.in[i] = (const float*)d_in[i];
    a.out = (float*)d_out; a.ws = (unsigned char*)d_ws;
#if ONE_LAUNCH
    a.ph_lo = 0; a.ph_hi = N_PHASES;
    hipLaunchKernelGGL(mega, dim3(grid), dim3(512), LDS_BYTES, stream, a);
#else
#ifdef DBG_STOP
    for (int p = 0; p <= DBG_STOP; ++p) { a.ph_lo = p; a.ph_hi = p + 1; hipLaunchKernelGGL(mega, dim3(grid), dim3(512), LDS_BYTES, stream, a); }
    (void)hipMemsetAsync(d_out, 0, (size_t)out_size * 4, stream);
    hipLaunchKernelGGL(dbg_check, dim3(1024), dim3(256), 0, stream, (const float* const*)nullptr, (const float*)d_in[I_X], (const float*)d_in[I_C], (const float*)d_in[I_CCTX], (const float*)d_in[I_WMOD], (const float*)d_in[I_BMOD], (const float*)d_in[I_WIN], (const unsigned char*)d_ws, (float*)d_out);
#else
    for (int p = 0; p < N_PHASES; ++p) { a.ph_lo = p; a.ph_hi = p + 1; hipLaunchKernelGGL(mega, dim3(grid), dim3(512), LDS_BYTES, stream, a); }
#endif
#endif
}
```

```cpp
#include <hip/hip_runtime.h>
#include <cstdio>
#include <cstdint>

#ifndef ONE_LAUNCH
#define ONE_LAUNCH 1
#endif

#define GAS __attribute__((address_space(1)))
#define LAS __attribute__((address_space(3)))
typedef unsigned short bf16;
typedef short bf16x8 __attribute__((ext_vector_type(8)));
typedef short s16x4 __attribute__((ext_vector_type(4)));
typedef float f32x4 __attribute__((ext_vector_type(4)));
typedef float f32x16 __attribute__((ext_vector_type(16)));
typedef unsigned u32x4 __attribute__((ext_vector_type(4)));
typedef unsigned u32x2 __attribute__((ext_vector_type(2)));

constexpr int D = 1024, NB = 8, SEQ = 2048, CTX = 256, DEPTH = 4, GW = 64;
constexpr int TL = NB * SEQ, TC = NB * CTX, T = TL + TC;
constexpr int IN_COLS = 5792, NZ = 1792;
constexpr int ZQ = 0, ZK = 256, ZV = 512, ZP = 768, ZF = 1024, ZCQ = 1280, ZCKV = 1536, ZKR = 1664, ZEND = 1696;
constexpr int NE = 16, FF = 2048, CAPL = 256, CAPC = 32, ESLOT = NB * CAPL + NB * CAPC;
constexpr float LN_EPS = 1e-5f;
constexpr float DN_ALPHA = 1.681792830507429f;
constexpr float LOG2E = 1.4426950408889634f;
constexpr float NA_QS = 0.125f * LOG2E;
constexpr float MLA_QS = 0.10206207261596575f * LOG2E;

constexpr size_t al256(size_t x) { return (x + 255) & ~(size_t)255; }
constexpr size_t WS_CTL = 0, CTL_BYTES = 1u << 20;
constexpr size_t WS_MOD = WS_CTL + CTL_BYTES;
constexpr size_t WS_ROPE = al256(WS_MOD + (size_t)DEPTH * 9 * 6144 * 4);
constexpr size_t WS_T64 = al256(WS_ROPE + 2048 * 32 * 4);
constexpr size_t WS_AFFT = al256(WS_T64 + 128 * 128 * 2);
constexpr size_t WS_AFFTC = al256(WS_AFFT + (size_t)2048 * 2048 * 2);
constexpr size_t WS_WIN = al256(WS_AFFTC + 256 * 256 * 2);
constexpr size_t WS_WG = al256(WS_WIN + (size_t)DEPTH * NZ * D * 2);
constexpr size_t WS_WUQ = al256(WS_WG + (size_t)DEPTH * 4096 * D * 2);
constexpr size_t WS_WUKV = al256(WS_WUQ + (size_t)DEPTH * 384 * 256 * 2);
constexpr size_t WS_WB = al256(WS_WUKV + (size_t)DEPTH * 512 * 128 * 2);
constexpr size_t WS_WO = al256(WS_WB + (size_t)DEPTH * 4 * D * 256 * 2);
constexpr size_t WS_WGU = al256(WS_WO + (size_t)DEPTH * D * D * 2);
constexpr size_t WS_WD = al256(WS_WGU + (size_t)DEPTH * NE * 4096 * D * 2);
constexpr size_t WS_H = al256(WS_WD + (size_t)DEPTH * NE * D * FF * 2);
constexpr size_t WS_X1 = al256(WS_H + (size_t)T * D * 4);
constexpr size_t WS_U1 = al256(WS_X1 + (size_t)T * D * 4);
constexpr size_t WS_U2 = al256(WS_U1 + (size_t)T * D * 2);
constexpr size_t WS_Z = al256(WS_U2 + (size_t)T * D * 2);
constexpr size_t WS_QM = al256(WS_Z + (size_t)T * NZ * 2);
constexpr size_t WS_KM = al256(WS_QM + (size_t)T * 384 * 2);
constexpr size_t WS_VM = al256(WS_KM + (size_t)T * 384 * 2);
constexpr size_t WS_FB = al256(WS_VM + (size_t)T * 256 * 2);
constexpr size_t WS_FBC = al256(WS_FB + (size_t)2048 * 2048 * 2);
constexpr size_t WS_Y = al256(WS_FBC + (size_t)2048 * 256 * 2);
constexpr size_t WS_P = al256(WS_Y + (size_t)4 * T * 256 * 2);
constexpr size_t WS_AFF = al256(WS_P + (size_t)T * 4096 * 2);
constexpr size_t WS_SLOT = al256(WS_AFF + (size_t)T * 16 * 4);
constexpr size_t WS_GATEV = al256(WS_SLOT + (size_t)T * 16 * 4);
constexpr size_t WS_SROW = al256(WS_GATEV + (size_t)NE * ESLOT * 4);
constexpr size_t WS_XE = al256(WS_SROW + (size_t)NE * ESLOT * 4);
constexpr size_t WS_ACT = al256(WS_XE + (size_t)NE * ESLOT * D * 2);
constexpr size_t WS_YE = al256(WS_ACT + (size_t)NE * ESLOT * FF * 2);
constexpr size_t WS_S = al256(WS_YE + (size_t)NE * ESLOT * D * 2);
constexpr size_t WS_ST1 = al256(WS_S + (size_t)T * D * 2);
constexpr size_t WS_END = al256(WS_ST1 + (size_t)T * 2 * 4);
static_assert(WS_END <= (size_t)2047 * 1024 * 1024, "workspace map exceeds 2 GiB");

constexpr int LDS_BYTES = 147456;
constexpr int LDS_MISC = 140 * 1024;

typedef __bf16 bf16x2_t __attribute__((ext_vector_type(2)));
typedef float f32x2_t __attribute__((ext_vector_type(2)));
__device__ __forceinline__ unsigned cvt_pk_bf16(float lo, float hi) { f32x2_t v = {lo, hi}; bf16x2_t b = __builtin_convertvector(v, bf16x2_t); return __builtin_bit_cast(unsigned, b); }
__device__ __forceinline__ float bf2f(unsigned short b) { return __uint_as_float(((unsigned)b) << 16); }
__device__ __forceinline__ float bflo(unsigned w) { return __uint_as_float(w << 16); }
__device__ __forceinline__ float bfhi(unsigned w) { return __uint_as_float(w & 0xffff0000u); }
__device__ __forceinline__ float wave_sum(float v) {
    v += __builtin_bit_cast(float, __builtin_amdgcn_update_dpp(0, __builtin_bit_cast(int, v), 0xB1, 0xf, 0xf, true));
    v += __builtin_bit_cast(float, __builtin_amdgcn_update_dpp(0, __builtin_bit_cast(int, v), 0x4E, 0xf, 0xf, true));
    v += __builtin_bit_cast(float, __builtin_amdgcn_update_dpp(0, __builtin_bit_cast(int, v), 0x141, 0xf, 0xf, true));
    v += __builtin_bit_cast(float, __builtin_amdgcn_update_dpp(0, __builtin_bit_cast(int, v), 0x140, 0xf, 0xf, true));
    const int iv = __builtin_bit_cast(int, v);
    const float a = __builtin_bit_cast(float, __builtin_amdgcn_readlane(iv, 0)), b = __builtin_bit_cast(float, __builtin_amdgcn_readlane(iv, 16));
    const float c = __builtin_bit_cast(float, __builtin_amdgcn_readlane(iv, 32)), d = __builtin_bit_cast(float, __builtin_amdgcn_readlane(iv, 48));
    return (a + b) + (c + d);
}
__device__ __forceinline__ float row16_sum(float v) {
    v += __builtin_bit_cast(float, __builtin_amdgcn_update_dpp(0, __builtin_bit_cast(int, v), 0xB1, 0xf, 0xf, true));
    v += __builtin_bit_cast(float, __builtin_amdgcn_update_dpp(0, __builtin_bit_cast(int, v), 0x4E, 0xf, 0xf, true));
    v += __builtin_bit_cast(float, __builtin_amdgcn_update_dpp(0, __builtin_bit_cast(int, v), 0x141, 0xf, 0xf, true));
    v += __builtin_bit_cast(float, __builtin_amdgcn_update_dpp(0, __builtin_bit_cast(int, v), 0x140, 0xf, 0xf, true));
    return v;
}
__device__ __forceinline__ unsigned wave_sum_u(unsigned v) {
    v += (unsigned)__builtin_amdgcn_update_dpp(0, (int)v, 0xB1, 0xf, 0xf, true);
    v += (unsigned)__builtin_amdgcn_update_dpp(0, (int)v, 0x4E, 0xf, 0xf, true);
    v += (unsigned)__builtin_amdgcn_update_dpp(0, (int)v, 0x141, 0xf, 0xf, true);
    v += (unsigned)__builtin_amdgcn_update_dpp(0, (int)v, 0x140, 0xf, 0xf, true);
    return (unsigned)__builtin_amdgcn_readlane((int)v, 0) + (unsigned)__builtin_amdgcn_readlane((int)v, 16) + (unsigned)__builtin_amdgcn_readlane((int)v, 32) + (unsigned)__builtin_amdgcn_readlane((int)v, 48);
}
__device__ __forceinline__ void st_wt8(void* p, u32x2 v) { __hip_atomic_store((unsigned long long*)p, ((unsigned long long)v.y << 32) | v.x, __ATOMIC_RELAXED, __HIP_MEMORY_SCOPE_AGENT); }
__device__ __forceinline__ void st_wt16(void* p, u32x4 v) { __hip_atomic_store((unsigned long long*)p, ((unsigned long long)v.y << 32) | v.x, __ATOMIC_RELAXED, __HIP_MEMORY_SCOPE_AGENT); __hip_atomic_store((unsigned long long*)p + 1, ((unsigned long long)v.w << 32) | v.z, __ATOMIC_RELAXED, __HIP_MEMORY_SCOPE_AGENT); }
__device__ __forceinline__ float fast_exp2(float x) { return __builtin_amdgcn_exp2f(x); }
__device__ __forceinline__ float silu_f(float x) { return x / (1.0f + __expf(-x)); }

#define XB_TMO      128
#define XB_XCNT(j)  (256  + 64 * (j))
#define XB_XSUB(j)  (1280 + 64 * (j))
#define XB_XGEN(j)  (2304 + 64 * (j))
#define XB_TOP      3328
#define XB_TOPGEN   3392
#define XCD_BAR_WORDS 3456
#define XB_SPIN_CAP (1u << 18)
__device__ __forceinline__ unsigned xb_ld(unsigned* p)              { return __hip_atomic_load(p, __ATOMIC_RELAXED, __HIP_MEMORY_SCOPE_AGENT); }
__device__ __forceinline__ unsigned xb_add(unsigned* p, unsigned v) { return __hip_atomic_fetch_add(p, v, __ATOMIC_RELAXED, __HIP_MEMORY_SCOPE_AGENT); }
__device__ __forceinline__ unsigned xb_xcc_id() { return (unsigned)__builtin_amdgcn_s_getreg((3 << 11) | 20) & 0xFu; }
#define XB_SPIN(cond, bar) do { unsigned _sp = 0; while (cond) { __builtin_amdgcn_s_sleep(1); \
    if ((++_sp & 255u) == 0u) { if (xb_ld(&(bar)[XB_TMO])) break; if (_sp > XB_SPIN_CAP) { atomicAdd(&(bar)[XB_TMO], 1u); break; } } } } while (0)
struct XcdBarrier { unsigned* bar; unsigned x; volatile LAS unsigned* st; };
__device__ __forceinline__ XcdBarrier xcd_barrier_post(unsigned* bar, volatile LAS unsigned* st) {
    XcdBarrier b; b.bar = bar; b.x = xb_xcc_id(); b.st = st;
    if (threadIdx.x == 0) (void)xb_add(&bar[XB_XCNT(b.x)], 1u);
    return b;
}
__device__ __forceinline__ void xcd_barrier_complete(unsigned* bar, unsigned x, unsigned& nloc, unsigned& nx) {
    const unsigned G = gridDim.x * gridDim.y * gridDim.z;
    unsigned sum, cnt, mine, sp = 0u;
    for (;;) {
        sum = 0u; cnt = 0u; mine = 0u;
#pragma unroll
        for (unsigned j = 0; j < 16; ++j) { const unsigned c = xb_ld(&bar[XB_XCNT(j)]); sum += c; cnt += (c > 0u) ? 1u : 0u; mine = (j == x) ? c : mine; }
        if (sum == G) break;
        __builtin_amdgcn_s_sleep(1);
        if ((++sp & 255u) == 0u) { if (xb_ld(&bar[XB_TMO])) break; if (sp > XB_SPIN_CAP) { atomicAdd(&bar[XB_TMO], 1u); break; } }
    }
    nloc = mine > 0u ? mine : 1u; nx = cnt > 0u ? cnt : 1u;
}
__device__ __forceinline__ void xcd_barrier(const XcdBarrier& b) {
    asm volatile("s_waitcnt vmcnt(0)" ::: "memory");
    __syncthreads();
    if (threadIdx.x == 0) {
        unsigned* bar = b.bar;
        __builtin_amdgcn_s_waitcnt(0);
        unsigned nloc = b.st[0], nx = b.st[1];
        if (nloc == 0u) { xcd_barrier_complete(bar, b.x, nloc, nx); b.st[0] = nloc; b.st[1] = nx; }
        const unsigned old = xb_add(&bar[XB_XSUB(b.x)], 1u);
        const unsigned gen = old / nloc;
        if (old + 1u == (gen + 1u) * nloc) {
            __builtin_amdgcn_fence(__ATOMIC_RELEASE, "agent");
            asm volatile("s_waitcnt vmcnt(0)" ::: "memory");
            const unsigned og = xb_add(&bar[XB_TOP], 1u);
            const unsigned tg = og / nx;
            if (og + 1u == (tg + 1u) * nx) xb_add(&bar[XB_TOPGEN], 1u);
            else XB_SPIN(xb_ld(&bar[XB_TOPGEN]) == tg, bar);
            __builtin_amdgcn_fence(__ATOMIC_ACQUIRE, "agent");
            xb_add(&bar[XB_XGEN(b.x)], 1u);
            asm volatile("s_waitcnt vmcnt(0)" ::: "memory");
        } else {
            XB_SPIN(xb_ld(&bar[XB_XGEN(b.x)]) == gen, bar);
            __builtin_amdgcn_fence(__ATOMIC_ACQUIRE, "agent");
            asm volatile("s_waitcnt vmcnt(0)" ::: "memory");
        }
    }
    __syncthreads();
}

struct Args {
    const float* in[24];
    float* out;
    unsigned char* ws;
    int ph_lo, ph_hi;
};
enum { I_X = 0, I_C, I_CTX, I_CCTX, I_WMOD, I_BMOD, I_WIN, I_RPB, I_POOLW, I_POOLS, I_QNORM, I_WUQ, I_KVNORM, I_WUKV, I_WBR, I_WOUT,
       I_LN1G, I_LN1B, I_WROUTER, I_WGATE, I_WUP, I_WDOWN, I_LN2G, I_LN2B };

struct Ctx {
    LAS unsigned char* lds;
    GAS unsigned char* ws;
    const float* const* in;
    float* out;
    int tid, lane, wave, bid, G;
};
#define WSP(T_, off) ((T_*)(GAS T_*)(C.ws + (off)))

__device__ __forceinline__ void l2_touch(const Ctx& C, const void* p) {
    __builtin_amdgcn_global_load_lds((const unsigned*)p, (LAS unsigned*)(C.lds + 136 * 1024), 4, 0, 0);
}

__device__ __forceinline__ int mod_row(int row) { return row < TL ? (row >> 11) : 8; }

constexpr int SG_TILE_B = 128 * 128;
constexpr int SG_LDS = 4 * SG_TILE_B;
template <class AF, class BF, class BS, class EPI>
__device__ __forceinline__ void sgemm_tile_s(const Ctx& C, AF arow, BF brow, BS bstep, int K, EPI epi) {
    const int tid = C.tid, lane = C.lane, wid = C.wave, wr = wid >> 2, wc = wid & 3, fr = lane & 15, fq = lane >> 4;
    LAS unsigned char* lds = C.lds;
    const bf16* ap[2]; const bf16* bp[2]; int lo[2]; long bst[2];
#pragma unroll
    for (int i = 0; i < 2; ++i) { const int c = tid + 512 * i, r = c >> 3, kc = c & 7; ap[i] = arow(r) + kc * 8; bp[i] = brow(r) + kc * 8; bst[i] = bstep(r); lo[i] = r * 128 + ((kc ^ ((r >> 1) & 7)) << 4); }
    f32x4 acc[4][2];
#pragma unroll
    for (int m = 0; m < 4; ++m)
#pragma unroll
        for (int n = 0; n < 2; ++n) acc[m][n] = (f32x4){0.f, 0.f, 0.f, 0.f};
    u32x4 ra0[2], rb0[2], ra1[2], rb1[2];
    const int nt = K >> 6;
    const int sw = (fr >> 1) & 7;
    const int ra_off = (wr * 64 + fr) * 128, rb_off = (wc * 32 + fr) * 128;
#define SG_GLOAD(RA, RB, t) do { const int ka_ = (t) * 64; _Pragma("unroll") for (int i = 0; i < 2; ++i) { RA[i] = *(const u32x4*)(ap[i] + ka_); RB[i] = *(const u32x4*)(bp[i] + (long)(t) * bst[i]); } } while (0)
#define SG_LSTORE(RA, RB, buf) do { _Pragma("unroll") for (int i = 0; i < 2; ++i) { *(LAS u32x4*)(lds + (buf) * SG_TILE_B + lo[i]) = RA[i]; *(LAS u32x4*)(lds + (2 + (buf)) * SG_TILE_B + lo[i]) = RB[i]; } } while (0)
#define SG_COMPUTE(buf) do { const LAS unsigned char* la = lds + (buf) * SG_TILE_B + ra_off; const LAS unsigned char* lb = lds + (2 + (buf)) * SG_TILE_B + rb_off; \
        _Pragma("unroll") for (int kk = 0; kk < 2; ++kk) { bf16x8 af[4], bfr[2]; const int co = (((4 * kk + fq) ^ sw) << 4); \
            _Pragma("unroll") for (int m = 0; m < 4; ++m) af[m] = *(const LAS bf16x8*)(la + m * 2048 + co); \
            _Pragma("unroll") for (int n = 0; n < 2; ++n) bfr[n] = *(const LAS bf16x8*)(lb + n * 2048 + co); \
            _Pragma("unroll") for (int m = 0; m < 4; ++m) _Pragma("unroll") for (int n = 0; n < 2; ++n) acc[m][n] = __builtin_amdgcn_mfma_f32_16x16x32_bf16(bfr[n], af[m], acc[m][n], 0, 0, 0); } } while (0)
    SG_GLOAD(ra0, rb0, 0);
    if (nt > 1) SG_GLOAD(ra1, rb1, 1);
    SG_LSTORE(ra0, rb0, 0);
    __syncthreads();
    for (int t = 0; t < nt; t += 2) {
        if (t + 2 < nt) SG_GLOAD(ra0, rb0, t + 2);
        SG_COMPUTE(0);
        if (t + 1 < nt) SG_LSTORE(ra1, rb1, 1);
        __syncthreads();
        if (t + 1 >= nt) break;
        if (t + 3 < nt) SG_GLOAD(ra1, rb1, t + 3);
        SG_COMPUTE(1);
        if (t + 2 < nt) SG_LSTORE(ra0, rb0, 0);
        __syncthreads();
    }
#undef SG_GLOAD
#undef SG_LSTORE
#undef SG_COMPUTE
    epi(acc, wr, wc, fr, fq);
    __syncthreads();
}
template <class AF, class BF, class EPI>
__device__ __forceinline__ void sgemm_tile(const Ctx& C, AF arow, BF brow, int K, int, EPI epi) { sgemm_tile_s(C, arow, brow, [](int) { return 64L; }, K, epi); }
template <int RMSN, class AF, class BF, class BS, class EPI>
__device__ __forceinline__ void sgemm_tile_d4(const Ctx& C, AF arow, BF brow, BS bstep, int K, EPI epi, LAS float* rs = nullptr) {
    const int tid = C.tid, lane = C.lane, wid = C.wave, wr = wid >> 2, wc = wid & 3, fr = lane & 15, fq = lane >> 4;
    LAS unsigned char* lds = C.lds;
    const bf16* ap[2]; const bf16* bp[2]; int lo[2]; long bst[2];
#pragma unroll
    for (int i = 0; i < 2; ++i) { const int c = tid + 512 * i, r = c >> 3, kc = c & 7; ap[i] = arow(r) + kc * 8; bp[i] = brow(r) + kc * 8; bst[i] = bstep(r); lo[i] = r * 128 + ((kc ^ ((r >> 1) & 7)) << 4); }
    f32x4 acc[4][2];
#pragma unroll
    for (int m = 0; m < 4; ++m)
#pragma unroll
        for (int n = 0; n < 2; ++n) acc[m][n] = (f32x4){0.f, 0.f, 0.f, 0.f};
    u32x4 ra[4][2], rb[4][2];
    float ss[2] = {0.f, 0.f};
    const int nt = K >> 6;
    const int sw = (fr >> 1) & 7;
    const int ra_off = (wr * 64 + fr) * 128, rb_off = (wc * 32 + fr) * 128;
#define SG_GLOAD(q, t) do { const int ka_ = (t) * 64; _Pragma("unroll") for (int i = 0; i < 2; ++i) { ra[q][i] = *(const u32x4*)(ap[i] + ka_); rb[q][i] = *(const u32x4*)(bp[i] + (long)(t) * bst[i]); } } while (0)
#define SG_LSTORE(q, buf) do { _Pragma("unroll") for (int i = 0; i < 2; ++i) { *(LAS u32x4*)(lds + (buf) * SG_TILE_B + lo[i]) = ra[q][i]; *(LAS u32x4*)(lds + (2 + (buf)) * SG_TILE_B + lo[i]) = rb[q][i]; \
        if (RMSN > 0) { const u32x4 v_ = ra[q][i]; const float a0 = bflo(v_.x), a1 = bfhi(v_.x), a2 = bflo(v_.y), a3 = bfhi(v_.y), a4 = bflo(v_.z), a5 = bfhi(v_.z), a6 = bflo(v_.w), a7 = bfhi(v_.w); \
            ss[i] += a0 * a0 + a1 * a1 + a2 * a2 + a3 * a3 + a4 * a4 + a5 * a5 + a6 * a6 + a7 * a7; } } } while (0)
#define SG_RMSFIN() do { if (RMSN > 0) { _Pragma("unroll") for (int i = 0; i < 2; ++i) { float s_ = ss[i]; s_ += __shfl_xor(s_, 1); s_ += __shfl_xor(s_, 2); s_ += __shfl_xor(s_, 4); \
            if ((tid & 7) == 0) rs[(tid + 512 * i) >> 3] = 1.0f / sqrtf(s_ * (1.0f / (RMSN > 0 ? RMSN : 1)) + LN_EPS); } } } while (0)
#define SG_COMPUTE(buf) do { const LAS unsigned char* la = lds + (buf) * SG_TILE_B + ra_off; const LAS unsigned char* lb = lds + (2 + (buf)) * SG_TILE_B + rb_off; \
        _Pragma("unroll") for (int kk = 0; kk < 2; ++kk) { bf16x8 af[4], bfr[2]; const int co = (((4 * kk + fq) ^ sw) << 4); \
            _Pragma("unroll") for (int m = 0; m < 4; ++m) af[m] = *(const LAS bf16x8*)(la + m * 2048 + co); \
            _Pragma("unroll") for (int n = 0; n < 2; ++n) bfr[n] = *(const LAS bf16x8*)(lb + n * 2048 + co); \
            _Pragma("unroll") for (int m = 0; m < 4; ++m) _Pragma("unroll") for (int n = 0; n < 2; ++n) acc[m][n] = __builtin_amdgcn_mfma_f32_16x16x32_bf16(bfr[n], af[m], acc[m][n], 0, 0, 0); } } while (0)
    SG_GLOAD(0, 0);
    if (nt > 1) SG_GLOAD(1, 1);
    if (nt > 2) SG_GLOAD(2, 2);
    if (nt > 3) SG_GLOAD(3, 3);
    SG_LSTORE(0, 0);
    if (nt == 1) SG_RMSFIN();
    __syncthreads();
    for (int t = 0; t < nt; t += 4) {
#pragma unroll
        for (int q = 0; q < 4; ++q) {
            if (t + q < nt) {
                if (t + q + 4 < nt) SG_GLOAD(q, t + q + 4);
                SG_COMPUTE(q & 1);
                if (t + q + 1 < nt) { SG_LSTORE((q + 1) & 3, (q + 1) & 1); if (t + q + 2 == nt) SG_RMSFIN(); }
                __syncthreads();
            }
        }
    }
#undef SG_GLOAD
#undef SG_LSTORE
#undef SG_RMSFIN
#undef SG_COMPUTE
    epi(acc, wr, wc, fr, fq);
    __syncthreads();
}
template <class AF, class BF, class EPI>
__device__ __forceinline__ void sgemm_tile_d4(const Ctx& C, AF arow, BF brow, int K, EPI epi) { sgemm_tile_d4<0>(C, arow, brow, [](int) { return 64L; }, K, epi); }

namespace g8 {
constexpr int BM = 256, BK = 64, HALF = 128, HTB = HALF * BK * 2, STAGE_BYTES = 8 * HTB;
__device__ __forceinline__ int lds_byte(int r, int c) { const int st = (r >> 4) * 2 + (c >> 5), rr = r & 15, cc = c & 31, ob = rr * 64 + cc * 2; return st * 1024 + (ob ^ (((ob >> 9) & 1) << 5)); }
__device__ __forceinline__ void stage_rc(int b, int& R, int& C) { const int st = b / 1024, sb = b % 1024, swz = sb ^ (((sb >> 9) & 1) << 5); R = (st >> 1) * 16 + swz / 64; C = (st & 1) * 32 + (swz % 64) / 2; }
__device__ __forceinline__ int perm32(int rho) { const int n = rho >> 4, i = rho & 15; return 8 * (i >> 2) + 4 * n + (i & 3); }
struct Unit { const char* A; const char* B; int r0, c0, x; };
template <class Epi, class Sched, bool GATHER = false>
__device__ __forceinline__ void gemm_phase(LAS unsigned char* lds, const int K, const unsigned lda, const unsigned ldb, const Sched& S, const Epi& E, const int tid, const LAS int* srow = nullptr) {
    const int wid = __builtin_amdgcn_readfirstlane(tid >> 6), lane = tid & 63, wr = wid >> 2, wc = wid & 3, fr = lane & 15, fq = lane >> 4;
    const int nt = K / BK;
    unsigned voffA[2], voffB[2], vA1[2], nA0[2], nA1[2]; int gR[2]; unsigned gC[2];
#pragma unroll
    for (int i = 0; i < 2; ++i) { int R, Cc; stage_rc(tid * 16 + i * 8192, R, Cc); const int Rb = Epi::PERM ? ((R & ~31) + perm32(R & 31)) : R;
        voffA[i] = (unsigned)R * lda + (unsigned)Cc * 2u; voffB[i] = (unsigned)Rb * ldb + (unsigned)Cc * 2u; gR[i] = R; gC[i] = (unsigned)Cc * 2u; vA1[i] = voffA[i]; nA0[i] = voffA[i]; nA1[i] = voffA[i]; }
    if constexpr (GATHER) {
#pragma unroll
        for (int i = 0; i < 2; ++i) { voffA[i] = (unsigned)srow[gR[i]] * lda + gC[i]; vA1[i] = (unsigned)srow[128 + gR[i]] * lda + gC[i]; }
    }
    const size_t kstep = (size_t)(BK * 2);
    const size_t hstepA = GATHER ? (size_t)0 : (size_t)HALF * lda, hstepB = (size_t)HALF * ldb;
    const unsigned ldsw = (unsigned)wid * 1024u;
    const int aoff = lds_byte(wr * 64 + fr, fq * 8), boff = lds_byte(wc * 32 + fr, fq * 8);
#define PG8_SA(b, h) (((b) * 2 + (h)) * HTB)
#define PG8_SB(b, h) ((4 + (b) * 2 + (h)) * HTB)
#define PG8_STAGE(bufoff, gbase, voff) do { _Pragma("unroll") for (int _i = 0; _i < 2; ++_i) \
        __builtin_amdgcn_global_load_lds((const unsigned*)((const char*)(gbase) + (voff)[_i]), (LAS unsigned*)(lds + (bufoff) + ldsw + _i * 8192), 16, 0, 0); } while (0)
#define PG8_LDA(dst, b, h) do { _Pragma("unroll") for (int m = 0; m < 4; ++m) _Pragma("unroll") for (int k = 0; k < 2; ++k) dst[m][k] = *(const LAS bf16x8*)(lds + PG8_SA(b, h) + aoff + m * 2048 + k * 1024); } while (0)
#define PG8_LDB(dst, b, h) do { _Pragma("unroll") for (int n = 0; n < 2; ++n) _Pragma("unroll") for (int k = 0; k < 2; ++k) dst[n][k] = *(const LAS bf16x8*)(lds + PG8_SB(b, h) + boff + n * 2048 + k * 1024); } while (0)
#define PG8_MMA(ai, bj, At, Bt) do { __builtin_amdgcn_s_setprio(1); _Pragma("unroll") for (int m = 0; m < 4; ++m) _Pragma("unroll") for (int n = 0; n < 2; ++n) _Pragma("unroll") for (int k = 0; k < 2; ++k) \
        acc[ai][bj][m][n] = __builtin_amdgcn_mfma_f32_16x16x32_bf16(Bt[n][k], At[m][k], acc[ai][bj][m][n], 0, 0, 0); __builtin_amdgcn_s_setprio(0); } while (0)
#define PG8_WAIT_V(n) asm volatile("s_waitcnt vmcnt(" #n ")" ::: "memory")
#define PG8_WAIT_L(n) asm volatile("s_waitcnt lgkmcnt(" #n ")" ::: "memory")
#define PG8_BAR __builtin_amdgcn_s_barrier()
#define PG8_SCHED __builtin_amdgcn_sched_barrier(0)
    Unit cur, nxt; int ui = 0;
    if (!S.next(0, cur)) return;
    f32x4 acc[2][2][4][2];
#pragma unroll
    for (int a = 0; a < 2; ++a)
#pragma unroll
        for (int b = 0; b < 2; ++b)
#pragma unroll
            for (int m = 0; m < 4; ++m)
#pragma unroll
                for (int n = 0; n < 2; ++n) acc[a][b][m][n] = (f32x4){0.f, 0.f, 0.f, 0.f};
    bf16x8 At[4][2], B0[2][2], B1[2][2];
    const char* cA = cur.A; const char* cB = cur.B;
    PG8_STAGE(PG8_SB(0, 0), cB, voffB); PG8_STAGE(PG8_SB(0, 1), cB + hstepB, voffB); PG8_STAGE(PG8_SA(0, 0), cA, voffA); PG8_STAGE(PG8_SA(0, 1), cA + hstepA, vA1);
    if (wr == 1) PG8_BAR;
    PG8_WAIT_V(2); PG8_BAR;
    PG8_STAGE(PG8_SB(1, 0), cB + kstep, voffB); PG8_STAGE(PG8_SA(1, 0), cA + kstep, voffA); PG8_STAGE(PG8_SB(1, 1), cB + hstepB + kstep, voffB);
    PG8_WAIT_V(6); PG8_BAR;
    for (;;) {
        const bool has_next = S.next(ui + 1, nxt);
        const char* nA = has_next ? nxt.A : cA; const char* nB = has_next ? nxt.B : cB;
        if constexpr (GATHER) {
#pragma unroll
            for (int i = 0; i < 2; ++i) { nA0[i] = has_next ? (unsigned)srow[256 * (ui + 1) + gR[i]] * lda + gC[i] : voffA[i]; nA1[i] = has_next ? (unsigned)srow[256 * (ui + 1) + 128 + gR[i]] * lda + gC[i] : vA1[i]; }
        }
#pragma clang loop unroll(disable)
        for (int t = 0; t < nt; t += 2) {
            const bool last = (t == nt - 2);
            const char* a1 = cA + (size_t)(t + 1) * kstep;
            const char* a2 = last ? nA : cA + (size_t)(t + 2) * kstep; const char* b2 = last ? nB : cB + (size_t)(t + 2) * kstep;
            const char* a3 = a2 + kstep; const char* b3 = b2 + kstep;
            unsigned sA0[2], sA1[2];
#pragma unroll
            for (int i = 0; i < 2; ++i) { sA0[i] = (GATHER && last) ? nA0[i] : voffA[i]; sA1[i] = (GATHER && last) ? nA1[i] : vA1[i]; }
            PG8_LDB(B0, 0, 0); PG8_LDB(B1, 0, 1); PG8_SCHED; PG8_LDA(At, 0, 0); PG8_STAGE(PG8_SA(1, 1), a1 + hstepA, vA1);
            PG8_WAIT_V(8); PG8_WAIT_L(0); PG8_BAR; PG8_MMA(0, 0, At, B0); PG8_MMA(0, 1, At, B1); PG8_BAR; PG8_SCHED;
            PG8_LDA(At, 0, 1); PG8_STAGE(PG8_SB(0, 0), b2, voffB); PG8_STAGE(PG8_SB(0, 1), b2 + hstepB, voffB); PG8_STAGE(PG8_SA(0, 0), a2, sA0);
            PG8_WAIT_V(8); PG8_WAIT_L(0); PG8_BAR; PG8_MMA(1, 0, At, B0); PG8_MMA(1, 1, At, B1); PG8_BAR; PG8_SCHED;
            PG8_LDB(B0, 1, 0); PG8_LDB(B1, 1, 1); PG8_SCHED; PG8_LDA(At, 1, 0); PG8_STAGE(PG8_SA(0, 1), a2 + hstepA, sA1);
            PG8_WAIT_V(8); PG8_WAIT_L(0); PG8_BAR; PG8_MMA(0, 0, At, B0); PG8_MMA(0, 1, At, B1); PG8_BAR; PG8_SCHED;
            PG8_LDA(At, 1, 1); PG8_STAGE(PG8_SB(1, 0), b3, voffB); PG8_STAGE(PG8_SB(1, 1), b3 + hstepB, voffB); PG8_STAGE(PG8_SA(1, 0), a3, sA0);
            PG8_WAIT_V(8); PG8_WAIT_L(0); PG8_BAR; PG8_MMA(1, 0, At, B0); PG8_MMA(1, 1, At, B1); PG8_BAR; PG8_SCHED;
        }
        if (wr == 0) PG8_BAR;
        E(acc, cur, wr, wc, fr, fq);
        if (!has_next) break;
#pragma unroll
        for (int a = 0; a < 2; ++a)
#pragma unroll
            for (int b = 0; b < 2; ++b)
#pragma unroll
                for (int m = 0; m < 4; ++m)
#pragma unroll
                    for (int n = 0; n < 2; ++n) acc[a][b][m][n] = (f32x4){0.f, 0.f, 0.f, 0.f};
        cur = nxt; cA = nA; cB = nB; ++ui;
        if constexpr (GATHER) {
#pragma unroll
            for (int i = 0; i < 2; ++i) { voffA[i] = nA0[i]; vA1[i] = nA1[i]; }
        }
        if (wr == 1) PG8_BAR;
    }
    PG8_WAIT_V(0);
    PG8_BAR;
#undef PG8_SA
#undef PG8_SB
#undef PG8_STAGE
#undef PG8_LDA
#undef PG8_LDB
#undef PG8_MMA
#undef PG8_WAIT_V
#undef PG8_WAIT_L
#undef PG8_BAR
#undef PG8_SCHED
}
}

constexpr int AT_VS = 192;
template <int DK, bool WIN>
__device__ __forceinline__ void attn_unit(const Ctx& C,
        const bf16* qrow0, size_t ldq,
        const bf16* k0, const bf16* v0, int n0t,
        const bf16* k1, const bf16* v1, int n1t,
        size_t ldk, size_t ldv,
        bf16* orow0, size_t ldo,
        int w_lo, int w_hi, int dr0, int qc0, const LAS float* btab) {
    constexpr int KS = DK * 2 + 16;
    constexpr int KBUF = 64 * KS, VBUF = 64 * AT_VS;
    constexpr int KCH = DK / 8;
    constexpr int NS = DK / 16;
    const int tid = C.tid, lane = C.lane, l31 = lane & 31, h = lane >> 5;
    LAS unsigned char* lds = C.lds;
    LAS unsigned char* ldsK = lds; LAS unsigned char* ldsV = lds + 2 * KBUF;
    bf16x8 qf[NS];
#pragma unroll
    for (int s = 0; s < NS; ++s) qf[s] = *(const bf16x8*)(qrow0 + (size_t)l31 * ldq + 16 * s + 8 * h);
    f32x16 O0, O1;
#pragma unroll
    for (int i = 0; i < 16; ++i) { O0[i] = 0.f; O1[i] = 0.f; }
    float mrun = 0.f, lsum = 0.f;
    const int kc0 = tid, kr0 = kc0 / KCH, kk0 = kc0 % KCH;
    const int kc1 = tid + 512, kr1 = kc1 / KCH, kk1 = kc1 % KCH;
    constexpr bool HAS1 = (64 * KCH > 512);
    const bool has1 = HAS1 && (kc1 < 64 * KCH);
    const int vr = tid >> 3, vk = tid & 7;
    const int nt = n0t + n1t;
    u32x4 rk0, rk1, rv;
    auto gload = [&](int j, u32x4& a0, u32x4& a1, u32x4& av) {
        const bf16* kb = (j < n0t) ? k0 + (size_t)j * 64 * ldk : k1 + (size_t)(j - n0t) * 64 * ldk;
        const bf16* vb = (j < n0t) ? v0 + (size_t)j * 64 * ldv : v1 + (size_t)(j - n0t) * 64 * ldv;
        a0 = *(const u32x4*)(kb + (size_t)kr0 * ldk + kk0 * 8);
        if constexpr (HAS1) { if (has1) a1 = *(const u32x4*)(kb + (size_t)kr1 * ldk + kk1 * 8); }
        av = *(const u32x4*)(vb + (size_t)vr * ldv + vk * 8);
    };
    auto lstore = [&](int b, int vb3, const u32x4& a0, const u32x4& a1, const u32x4& av) {
        *(LAS u32x4*)(ldsK + b * KBUF + kr0 * KS + kk0 * 16) = a0;
        if constexpr (HAS1) { if (has1) *(LAS u32x4*)(ldsK + b * KBUF + kr1 * KS + kk1 * 16) = a1; }
        *(LAS u32x4*)(ldsV + vb3 * VBUF + vr * AT_VS + vk * 16) = av;
    };
    gload(0, rk0, rk1, rv);
    lstore(0, 0, rk0, rk1, rv);
    __syncthreads();
#pragma unroll
    for (int s = 0; s < NS; ++s) asm volatile("" : "+v"(qf[s]));
    const int trb = (4 * h + ((lane & 15) >> 2)) * AT_VS + (16 * ((lane >> 4) & 1) + 4 * (lane & 3)) * 2;
    int cq = qc0 + l31; asm volatile("" : "+v"(cq));
    int c0w = cq - 8; c0w = c0w < 0 ? 0 : (c0w > 48 ? 48 : c0w);
    const int mbase = 4 * h - c0w, bbase = 4 * h - cq + 15;
    const bool grpB = C.wave >= 4;
    union VF { bf16x8 v; s16x4 hlf[2]; };
    unsigned pfk[2][2][4];
#pragma unroll
    for (int a_ = 0; a_ < 2; ++a_)
#pragma unroll
        for (int b_ = 0; b_ < 2; ++b_)
#pragma unroll
            for (int c_ = 0; c_ < 4; ++c_) pfk[a_][b_][c_] = 0u;
    bool pend = false; int pend_vb = 0;
    auto vread = [&](int vbuf, VF (&vfr)[2][2][2]) {
        const LAS unsigned char* vb = ldsV + vbuf * VBUF + trb;
#pragma unroll
        for (int kb3 = 0; kb3 < 2; ++kb3)
#pragma unroll
            for (int s2 = 0; s2 < 2; ++s2)
#pragma unroll
                for (int db = 0; db < 2; ++db) { const int rowoff = (32 * kb3 + 16 * s2) * AT_VS;
                    vfr[kb3][s2][db].hlf[0] = __builtin_amdgcn_ds_read_tr16_b64_v4i16((LAS s16x4*)(vb + rowoff + db * 64));
                    vfr[kb3][s2][db].hlf[1] = __builtin_amdgcn_ds_read_tr16_b64_v4i16((LAS s16x4*)(vb + rowoff + 8 * AT_VS + db * 64)); }
    };
    auto pvmma = [&](const VF (&vfr)[2][2][2]) {
#pragma unroll
        for (int kb3 = 0; kb3 < 2; ++kb3)
#pragma unroll
            for (int s2 = 0; s2 < 2; ++s2) {
                union { bf16x8 v; unsigned u[4]; } pf;
#pragma unroll
                for (int q = 0; q < 4; ++q) pf.u[q] = pfk[kb3][s2][q];
                O0 = __builtin_amdgcn_mfma_f32_32x32x16_bf16(vfr[kb3][s2][0].v, pf.v, O0, 0, 0, 0);
                O1 = __builtin_amdgcn_mfma_f32_32x32x16_bf16(vfr[kb3][s2][1].v, pf.v, O1, 0, 0, 0);
            }
    };
    int vcur = 0;
    for (int j = 0; j < nt; ++j) {
        const int cur = j & 1; const int vnxt = (vcur == 2) ? 0 : vcur + 1;
        if (j + 1 < nt) gload(j + 1, rk0, rk1, rv);
        const bool act = !WIN || j < n0t || ((j - n0t) >= w_lo && (j - n0t) < w_hi);
        if (grpB && pend) { VF vfr[2][2][2]; vread(pend_vb, vfr); __builtin_amdgcn_sched_barrier(0); pvmma(vfr); pend = false; }
        if (act) {
            f32x16 S0, S1;
            const float nm = -mrun;
#pragma unroll
            for (int i = 0; i < 16; ++i) { S0[i] = nm; S1[i] = nm; }
            const LAS unsigned char* kb = ldsK + cur * KBUF + l31 * KS + 16 * h;
#pragma unroll
            for (int hs = 0; hs < 2; ++hs) {
                bf16x8 kfa[NS / 2], kfb[NS / 2];
#pragma unroll
                for (int s = 0; s < NS / 2; ++s) { kfa[s] = *(const LAS bf16x8*)(kb + 32 * (hs * (NS / 2) + s)); kfb[s] = *(const LAS bf16x8*)(kb + 32 * KS + 32 * (hs * (NS / 2) + s)); }
                __builtin_amdgcn_sched_barrier(0);
#pragma unroll
                for (int s = 0; s < NS / 2; ++s) {
                    S0 = __builtin_amdgcn_mfma_f32_32x32x16_bf16(kfa[s], qf[hs * (NS / 2) + s], S0, 0, 0, 0);
                    S1 = __builtin_amdgcn_mfma_f32_32x32x16_bf16(kfb[s], qf[hs * (NS / 2) + s], S1, 0, 0, 0);
                }
                __builtin_amdgcn_sched_barrier(0);
            }
            VF vfa[2][2][2];
            if (!grpB) { vread(vcur, vfa); __builtin_amdgcn_sched_barrier(0); }
            if (WIN && j >= n0t) {
                int mb = mbase; asm volatile("" : "+v"(mb));
                const LAS float* bt = btab + ((j - n0t) + dr0) * 31 + bbase;
                float bv0[16], bv1[16];
#pragma unroll
                for (int i = 0; i < 16; ++i) { const int kci = (i & 3) + 8 * (i >> 2); bv0[i] = bt[kci]; bv1[i] = bt[kci + 32]; }
#pragma unroll
                for (int i = 0; i < 16; ++i) asm volatile("" : "+v"(bv0[i]), "+v"(bv1[i]));
#pragma unroll
                for (int i = 0; i < 16; ++i) {
                    const int kci = (i & 3) + 8 * (i >> 2);
                    S0[i] = ((unsigned)(kci + mb) < 16u) ? S0[i] + bv0[i] : -1e30f;
                    S1[i] = ((unsigned)(kci + 32 + mb) < 16u) ? S1[i] + bv1[i] : -1e30f;
                }
            }
            float mx = fmaxf(S0[0], S1[0]);
#pragma unroll
            for (int i = 1; i < 16; ++i) mx = fmaxf(mx, fmaxf(S0[i], S1[i]));
            mx = fmaxf(mx, __shfl_xor(mx, 32));
            if (__any(mx > 8.0f)) {
                const float dl = fmaxf(mx, 0.f), alpha = fast_exp2(-dl);
                mrun += dl; lsum *= alpha;
#pragma unroll
                for (int i = 0; i < 16; ++i) { S0[i] -= dl; S1[i] -= dl; O0[i] *= alpha; O1[i] *= alpha; }
            }
            float ps = 0.f;
#pragma unroll
            for (int i = 0; i < 16; ++i) { S0[i] = fast_exp2(S0[i]); S1[i] = fast_exp2(S1[i]); ps += S0[i] + S1[i]; }
            lsum += ps;
#pragma unroll
            for (int s2 = 0; s2 < 2; ++s2)
#pragma unroll
                for (int q = 0; q < 4; ++q) { pfk[0][s2][q] = cvt_pk_bf16(S0[8 * s2 + 2 * q], S0[8 * s2 + 2 * q + 1]); pfk[1][s2][q] = cvt_pk_bf16(S1[8 * s2 + 2 * q], S1[8 * s2 + 2 * q + 1]); }
            if (!grpB) pvmma(vfa); else { pend = true; pend_vb = vcur; }
        }
        if (j + 1 < nt) lstore(cur ^ 1, vnxt, rk0, rk1, rv);
        __syncthreads();
        vcur = vnxt;
    }
    if (grpB && pend) { VF vfr[2][2][2]; vread(pend_vb, vfr); pvmma(vfr); }
    const float ltot = lsum + __shfl_xor(lsum, 32);
    const float inv = 1.0f / ltot;
    bf16* op = orow0 + (size_t)l31 * ldo + 4 * h;
#pragma unroll
    for (int g = 0; g < 4; ++g) {
        u32x2 w0, w1;
        w0.x = cvt_pk_bf16(O0[4 * g] * inv, O0[4 * g + 1] * inv); w0.y = cvt_pk_bf16(O0[4 * g + 2] * inv, O0[4 * g + 3] * inv);
        w1.x = cvt_pk_bf16(O1[4 * g] * inv, O1[4 * g + 1] * inv); w1.y = cvt_pk_bf16(O1[4 * g + 2] * inv, O1[4 * g + 3] * inv);
        *(u32x2*)(op + 8 * g) = w0;
        *(u32x2*)(op + 32 + 8 * g) = w1;
    }
}

template <class RM>
__device__ __forceinline__ void tconv64(const float* W, size_t ldw, int k0, int n0, int N, const float* kscale, RM rm, int lane) {
    const int q = lane >> 4, c = lane & 15, ncol = n0 + 4 * c;
    if (ncol >= N) return;
    const float* src = W + (size_t)(k0 + 16 * q) * ldw + ncol;
    f32x4 v[16];
#pragma unroll
    for (int i = 0; i < 16; ++i) v[i] = __builtin_nontemporal_load((const f32x4*)(src + (size_t)i * ldw));
    if (kscale) {
#pragma unroll
        for (int i = 0; i < 16; ++i) v[i] = v[i] * kscale[k0 + 16 * q + i];
    }
#pragma unroll
    for (int j = 0; j < 4; ++j) {
        float cs; bf16* dst = rm(ncol + j, cs);
        u32x4 o0, o1;
        o0.x = cvt_pk_bf16(v[0][j] * cs, v[1][j] * cs); o0.y = cvt_pk_bf16(v[2][j] * cs, v[3][j] * cs); o0.z = cvt_pk_bf16(v[4][j] * cs, v[5][j] * cs); o0.w = cvt_pk_bf16(v[6][j] * cs, v[7][j] * cs);
        o1.x = cvt_pk_bf16(v[8][j] * cs, v[9][j] * cs); o1.y = cvt_pk_bf16(v[10][j] * cs, v[11][j] * cs); o1.z = cvt_pk_bf16(v[12][j] * cs, v[13][j] * cs); o1.w = cvt_pk_bf16(v[14][j] * cs, v[15][j] * cs);
        *(u32x4*)(dst + k0 + 16 * q) = o0; *(u32x4*)(dst + k0 + 16 * q + 8) = o1;
    }
}
__device__ __forceinline__ void conv_gu_item(const Ctx& C, int L, int idx) {
    const int le = L * NE + (idx >> 9), t = idx & 511, kb = t >> 5, nb = t & 31;
    bf16* wgu = WSP(bf16, WS_WGU) + (size_t)le * 4096 * D;
    { auto rm = [=](int n, float& cs) -> bf16* { cs = 1.0f; return wgu + (size_t)(256 * (n >> 7) + (n & 127)) * D; };
      tconv64(C.in[I_WGATE] + (size_t)le * D * FF, FF, kb * 64, nb * 64, FF, nullptr, rm, C.lane); }
    { auto rm = [=](int n, float& cs) -> bf16* { cs = 1.0f; return wgu + (size_t)(256 * (n >> 7) + 128 + (n & 127)) * D; };
      tconv64(C.in[I_WUP] + (size_t)le * D * FF, FF, kb * 64, nb * 64, FF, nullptr, rm, C.lane); }
}
__device__ __forceinline__ void conv_dn_item(const Ctx& C, int L, int idx) {
    const int le = L * NE + (idx >> 9), t = idx & 511, kb = t >> 4, nb = t & 15;
    bf16* wd = WSP(bf16, WS_WD) + (size_t)le * D * FF;
    auto rm = [=](int n, float& cs) -> bf16* { cs = 1.0f; return wd + (size_t)n * FF; };
    tconv64(C.in[I_WDOWN] + (size_t)le * FF * D, D, kb * 64, nb * 64, D, nullptr, rm, C.lane);
}
constexpr int GU_C2_CNT = 3, GU_C2_FIRST = 0, GU_D_CNT = 1, GU_D_FIRST = 128 * 8 * GU_C2_CNT, GU_F_CNT = 1, GU_F_FIRST = GU_D_FIRST + 128 * 8 * GU_D_CNT, GU_SLOT_END = GU_F_FIRST + 128 * 8 * GU_F_CNT;
constexpr int DN_C1_CNT = 2, DN_C1_FIRST = 0, DN_E_CNT = 2, DN_E_FIRST = 128 * 8 * DN_C1_CNT, DN_I_CNT = 2, DN_I_FIRST = DN_E_FIRST + 192 * 8 * DN_E_CNT, DN_SLOT_END = DN_I_FIRST + 192 * 8 * DN_I_CNT;
static_assert(GU_SLOT_END <= 8192 && DN_SLOT_END <= 8192, "slot ranges");
__device__ __forceinline__ void slot_gu(const Ctx& C, int L, int pb, int first, int cnt) {
    for (int i = 0; i < cnt; ++i) { const int idx = first + (pb * 8 + C.wave) * cnt + i; if (idx < GU_SLOT_END) conv_gu_item(C, L, idx); }
}
__device__ __forceinline__ void slot_dn(const Ctx& C, int L, int pb, int first, int cnt) {
    for (int i = 0; i < cnt; ++i) { const int idx = first + (pb * 8 + C.wave) * cnt + i; if (idx < DN_SLOT_END) conv_dn_item(C, L, idx); }
}
__device__ __forceinline__ void phase_prep(const Ctx& C) {
    const int tid = C.tid, lane = C.lane;
    const size_t gtid = (size_t)C.bid * 512 + tid, gth = (size_t)C.G * 512;
    { bf16* afft = WSP(bf16, WS_AFFT); const float sc = 0.0027621358640099515f;
      for (size_t i = gtid; i < (size_t)2048 * 2048; i += gth) { const int k1 = (int)(i >> 11), j = (int)(i & 2047), n1 = j & 1023; const int m = (k1 * n1) & 2047;
          const float x = (float)m * (1.0f / 1024.0f); float v = (j < 1024) ? cospif(x) : -sinpif(x); if (j == 0) v = 0.5f; if (j == 1024) v = (k1 & 1) ? -1.0f : 1.0f;
          afft[i] = (bf16)(cvt_pk_bf16(v * sc, 0.f) & 0xffff); }
      bf16* afc = WSP(bf16, WS_AFFTC); const float scc = 0.0078125f;
      for (size_t i = gtid; i < (size_t)256 * 256; i += gth) { const int k1 = (int)(i >> 8), j = (int)(i & 255), n1 = j & 127; const int m = (k1 * n1) & 255;
          const float x = (float)m * (1.0f / 128.0f); float v = (j < 128) ? cospif(x) : -sinpif(x); if (j == 0) v = 0.5f; if (j == 128) v = (k1 & 1) ? -1.0f : 1.0f;
          afc[i] = (bf16)(cvt_pk_bf16(v * scc, 0.f) & 0xffff); }
      bf16* t64 = WSP(bf16, WS_T64);
      for (size_t i = gtid; i < 128 * 128; i += gth) { const int mrow = (int)(i >> 7), kk = (int)(i & 127), n2 = kk & 63, k2 = mrow & 63; const int m = (k2 * n2) & 63;
          const float x = (float)m * (1.0f / 32.0f); const float v = (mrow < 64) ? cospif(x) : ((kk < 64) ? sinpif(x) : -sinpif(x)); t64[i] = (bf16)(cvt_pk_bf16(v, 0.f) & 0xffff); }
      float* rope = WSP(float, WS_ROPE);
      for (size_t i = gtid; i < 2048 * 16; i += gth) { const int t = (int)(i >> 4), f = (int)(i & 15); const float pos = (f < 8) ? (float)(t >> 6) : (float)(t & 63);
          const float inv = powf(10000.0f, -(float)(f & 7) / 8.0f); const float ang = pos * inv; rope[2 * i] = cosf(ang); rope[2 * i + 1] = sinf(ang); }
      bf16* win = WSP(bf16, WS_WIN);
      for (size_t i = gtid; i < (size_t)DEPTH * 96 * 1024 / 8; i += gth) { const size_t l = i / (96 * 128), r = i % (96 * 128); *(u32x4*)(win + (l * NZ + ZEND) * D + r * 8) = (u32x4){0u, 0u, 0u, 0u}; }
    }
    {
        LAS float* sl = (LAS float*)(C.lds);
        LAS float* red = (LAS float*)(C.lds + 9 * 1024 * 4);
        for (int i = tid; i < 9 * 1024; i += 512) { const int r = i >> 10, k = i & 1023; const float v = (r < 8) ? C.in[I_C][r * 1024 + k] : C.in[I_CCTX][k]; sl[i] = silu_f(v); }
        __syncthreads();
        const int c32 = tid & 31, kg = tid >> 5;
        for (int it = C.bid; it < DEPTH * 192; it += C.G) {
            const int l = it / 192, n0 = (it % 192) * 32;
            const float* wm = C.in[I_WMOD] + (size_t)l * 1024 * 6144 + n0 + c32;
            float a[9];
#pragma unroll
            for (int r = 0; r < 9; ++r) a[r] = 0.f;
#pragma unroll
            for (int kh = 0; kh < 2; ++kh) {
                float wv[32];
#pragma unroll
                for (int kk = 0; kk < 32; ++kk) wv[kk] = wm[(size_t)(kg * 64 + kh * 32 + kk) * 6144];
#pragma unroll
                for (int kk = 0; kk < 32; ++kk) asm volatile("" : "+v"(wv[kk]));
#pragma unroll
                for (int kk = 0; kk < 32; ++kk) { const int k = kg * 64 + kh * 32 + kk;
#pragma unroll
                    for (int r = 0; r < 9; ++r) a[r] += sl[r * 1024 + k] * wv[kk]; }
            }
#pragma unroll
            for (int r = 0; r < 9; ++r) red[(kg * 9 + r) * 32 + c32] = a[r];
            __syncthreads();
            if (tid < 288) { const int r = tid >> 5; float s = 0.f;
#pragma unroll
                for (int g = 0; g < 16; ++g) s += red[(g * 9 + r) * 32 + c32];
                WSP(float, WS_MOD)[((size_t)l * 9 + r) * 6144 + n0 + c32] = s + C.in[I_BMOD][l * 6144 + n0 + c32]; }
            __syncthreads();
        }
    }
    {
        for (size_t i = gtid; i < (size_t)DEPTH * 4 * 1024; i += gth) {
            const int l = (int)(i >> 12), g = (int)((i >> 10) & 3), d = (int)(i & 1023);
            const float* wb = C.in[I_WBR] + (((size_t)l * 4 + 1) * 256 + g * 64) * 1024 + d;
            const float* pw = C.in[I_POOLW] + ((size_t)l * 4 + g) * 64 * 64;
            const float* ps = C.in[I_POOLS] + l * 256 + g * 64;
            float wv[64];
#pragma unroll
            for (int c2 = 0; c2 < 64; ++c2) wv[c2] = wb[(size_t)c2 * 1024] * ps[c2];
            bf16* dst = WSP(bf16, WS_WB) + (((size_t)l * 4 + 1) * 1024 + d) * 256 + g * 64;
#pragma unroll 1
            for (int c8 = 0; c8 < 8; ++c8) {
                float o[8];
#pragma unroll
                for (int cc = 0; cc < 8; ++cc) { float s = 0.f; const float* pr = pw + (c8 * 8 + cc) * 64;
#pragma unroll
                    for (int c2 = 0; c2 < 64; ++c2) s += pr[c2] * wv[c2];
                    o[cc] = s; }
                u32x4 w; w.x = cvt_pk_bf16(o[0], o[1]); w.y = cvt_pk_bf16(o[2], o[3]); w.z = cvt_pk_bf16(o[4], o[5]); w.w = cvt_pk_bf16(o[6], o[7]);
                *(u32x4*)(dst + c8 * 8) = w;
            }
        }
    }
    {
        const int gw = C.bid * 8 + C.wave, NGW = C.G * 8;
        for (int it = gw; it < DEPTH * 16 * 91; it += NGW) {
            const int l = it / (16 * 91), t = it - l * (16 * 91), kb = t / 91, nb = t - kb * 91;
            bf16* win = WSP(bf16, WS_WIN) + (size_t)l * NZ * D; bf16* wg = WSP(bf16, WS_WG) + (size_t)l * 4096 * D;
            auto rm = [=](int n, float& cs) -> bf16* { cs = (n < 256) ? NA_QS : 1.0f; if (n < ZEND) return win + (size_t)n * D;
                const int g = n - ZEND, br = g >> 10, d = g & 1023, pn = d >> 6, ch = d & 63;
                const int row = 256 * pn + 128 * (br >> 1) + 32 * (ch >> 4) + 16 * (br & 1) + (ch & 15);
                return wg + (size_t)row * D; };
            tconv64(C.in[I_WIN] + (size_t)l * D * IN_COLS, IN_COLS, kb * 64, nb * 64, IN_COLS, nullptr, rm, C.lane);
        }
        for (int it = gw; it < DEPTH * 256; it += NGW) {
            const int l = it >> 8, t = it & 255, kb = t >> 4, nb = t & 15;
            bf16* w = WSP(bf16, WS_WO) + (size_t)l * D * D; auto rm = [=](int n, float& cs) -> bf16* { cs = 1.0f; return w + (size_t)n * D; };
            tconv64(C.in[I_WOUT] + (size_t)l * D * D, D, kb * 64, nb * 64, D, nullptr, rm, C.lane);
        }
        for (int it = gw; it < DEPTH * 4 * 64; it += NGW) {
            const int ln = it >> 6, t = it & 63, kb = t >> 4, nb = t & 15;
            if ((ln & 3) == 1) continue;
            bf16* w = WSP(bf16, WS_WB) + (size_t)ln * 1024 * 256; auto rm = [=](int n, float& cs) -> bf16* { cs = 1.0f; return w + (size_t)n * 256; };
            tconv64(C.in[I_WBR] + (size_t)ln * 256 * 1024, 1024, kb * 64, nb * 64, 1024, nullptr, rm, C.lane);
        }
        for (int it = gw; it < DEPTH * 24; it += NGW) {
            const int l = it / 24, t = it - l * 24, kb = t / 6, nb = t - kb * 6;
            bf16* w = WSP(bf16, WS_WUQ) + (size_t)l * 384 * 256; auto rm = [=](int n, float& cs) -> bf16* { cs = 1.0f; return w + (size_t)n * 256; };
            tconv64(C.in[I_WUQ] + (size_t)l * 256 * 384, 384, kb * 64, nb * 64, 384, C.in[I_QNORM] + l * 256, rm, C.lane);
        }
        for (int it = gw; it < DEPTH * 16; it += NGW) {
            const int l = it >> 4, t = it & 15, kb = t >> 3, nb = t & 7;
            bf16* w = WSP(bf16, WS_WUKV) + (size_t)l * 512 * 128; auto rm = [=](int n, float& cs) -> bf16* { cs = 1.0f; return w + (size_t)n * 128; };
            tconv64(C.in[I_WUKV] + (size_t)l * 128 * 512, 512, kb * 64, nb * 64, 512, C.in[I_KVNORM] + l * 128, rm, C.lane);
        }
    }
    {
        const int gw = C.bid * 8 + C.wave, NGW = C.G * 8;
        for (int it = gw; it < 8192; it += NGW) conv_gu_item(C, 0, it);
        for (int it = gw; it < 8192; it += NGW) conv_dn_item(C, 0, it);
        constexpr int GU_REST = 8192 - GU_SLOT_END, DN_REST = 8192 - DN_SLOT_END;
        for (int it = gw; it < 3 * GU_REST; it += NGW) conv_gu_item(C, 1 + it / GU_REST, GU_SLOT_END + it % GU_REST);
        if (DN_REST > 0) for (int it = gw; it < 3 * DN_REST; it += NGW) conv_dn_item(C, 1 + it / (DN_REST > 0 ? DN_REST : 1), DN_SLOT_END + it % (DN_REST > 0 ? DN_REST : 1));
    }
}

__device__ __forceinline__ void phase_init(const Ctx& C) {
    const int gw = C.bid * 8 + C.wave, NGW = C.G * 8, lane = C.lane;
    const float* mod = WSP(float, WS_MOD);
    for (int row = gw; row < T; row += NGW) {
        const float* src = (row < TL) ? C.in[I_X] + (size_t)row * D : C.in[I_CTX] + (size_t)(row - TL) * D;
        const float* mr = mod + (size_t)mod_row(row) * 6144;
        float* hd = WSP(float, WS_H) + (size_t)row * D; bf16* ud = WSP(bf16, WS_U1) + (size_t)row * D;
#pragma unroll
        for (int j = 0; j < 4; ++j) { const int c = 4 * lane + 256 * j; const f32x4 v = *(const f32x4*)(src + c); const f32x4 sh = *(const f32x4*)(mr + c), sc = *(const f32x4*)(mr + 1024 + c);
            *(f32x4*)(hd + c) = v; const f32x4 u = v * (sc + 1.0f) + sh; u32x2 w; w.x = cvt_pk_bf16(u[0], u[1]); w.y = cvt_pk_bf16(u[2], u[3]); *(u32x2*)(ud + c) = w; }
    }
}


__device__ __forceinline__ int unit_index(int i, int G, int c, int nunits) {
    const int full = nunits / G;
    if (i < full) return i * G + c;
    if (i > full) return -1;
    const int R = nunits - full * G; if (R == 0) return -1;
    const int cpx = G >> 3, per = (R + 7) >> 3, x = c / cpx, k = c - x * cpx, r = x * per + k;
    return (k < per && r < R) ? full * G + r : -1;
}
__device__ __forceinline__ int blk_x(const Ctx& C) { return C.bid / (C.G >> 3); }
__device__ __forceinline__ int blk_k(const Ctx& C) { return C.bid % (C.G >> 3); }
struct SchedDense {
    const char* A; const char* B; size_t lda, ldb; int nunits, G, c, nN;
    __device__ __forceinline__ bool next(int i, g8::Unit& u) const { const int L = unit_index(i, G, c, nunits); if (L < 0) return false; const int pm = L / nN, pn = L - pm * nN;
        u.A = A + (size_t)pm * 256 * lda; u.B = B + (size_t)pn * 256 * ldb; u.r0 = pm * 256; u.c0 = pn * 256; u.x = 0; return true; }
};
struct SchedGroup {
    const char* A; const char* B; size_t lda, ldb, bstride; int nunits, G, c, nN, per;
    __device__ __forceinline__ bool next(int i, g8::Unit& u) const { const int L = unit_index(i, G, c, nunits); if (L < 0) return false; const int e = L / per, r = L - e * per, pm = r / nN, pn = r - pm * nN;
        u.A = A + ((size_t)e * ESLOT + pm * 256) * lda; u.B = B + (size_t)e * bstride + (size_t)pn * 256 * ldb; u.r0 = e * ESLOT + pm * 256; u.c0 = pn * 256; u.x = e; return true; }
};
struct SchedC1 {
    const char* Y; const char* W; int nunits, G, c;
    __device__ __forceinline__ bool next(int i, g8::Unit& u) const { const int L = unit_index(i, G, c, nunits); if (L < 0) return false; const int pm = L >> 4, nb = (L >> 2) & 3, pn = L & 3;
        u.A = Y + ((size_t)nb * T + pm * 256) * 512; u.B = W + ((size_t)nb * 1024 + pn * 256) * 512; u.r0 = pm * 256; u.c0 = nb * 1024 + pn * 256; u.x = 0; return true; }
};
struct EpiStoreBf16 {
    static constexpr bool PERM = true; bf16* O; size_t ldc;
    __device__ __forceinline__ void operator()(const f32x4 (&acc)[2][2][4][2], const g8::Unit& u, int wr, int wc, int fr, int fq) const {
        bf16* base = O + (size_t)(u.r0 + wr * 64 + fr) * ldc + u.c0 + wc * 32 + 8 * fq;
#pragma unroll
        for (int ai = 0; ai < 2; ++ai)
#pragma unroll
            for (int m = 0; m < 4; ++m) { bf16* rowp = base + (size_t)(ai * 128 + m * 16) * ldc;
#pragma unroll
                for (int bj = 0; bj < 2; ++bj) { const f32x4 v0 = acc[ai][bj][m][0], v1 = acc[ai][bj][m][1];
                    u32x4 w; w.x = cvt_pk_bf16(v0[0], v0[1]); w.y = cvt_pk_bf16(v0[2], v0[3]); w.z = cvt_pk_bf16(v1[0], v1[1]); w.w = cvt_pk_bf16(v1[2], v1[3]); *(u32x4*)(rowp + bj * 128) = w; } }
    }
};
struct EpiSwiGLU {
    static constexpr bool PERM = true; bf16* O;
    __device__ __forceinline__ void operator()(const f32x4 (&acc)[2][2][4][2], const g8::Unit& u, int wr, int wc, int fr, int fq) const {
        bf16* base = O + (size_t)(u.r0 + wr * 64 + fr) * FF + (u.c0 >> 1) + wc * 32 + 8 * fq;
#pragma unroll
        for (int ai = 0; ai < 2; ++ai)
#pragma unroll
            for (int m = 0; m < 4; ++m) { float h[8];
#pragma unroll
                for (int n = 0; n < 2; ++n)
#pragma unroll
                    for (int j = 0; j < 4; ++j) { const float a = acc[ai][0][m][n][j], b = acc[ai][1][m][n][j]; h[4 * n + j] = a * __builtin_amdgcn_rcpf(1.0f + fast_exp2(-a * LOG2E)) * b; }
                u32x4 w; w.x = cvt_pk_bf16(h[0], h[1]); w.y = cvt_pk_bf16(h[2], h[3]); w.z = cvt_pk_bf16(h[4], h[5]); w.w = cvt_pk_bf16(h[6], h[7]);
                *(u32x4*)(base + (size_t)(ai * 128 + m * 16) * FF) = w; }
    }
};
struct EpiGateMerge {
    static constexpr bool PERM = false; const bf16* P; bf16* S;
    __device__ __forceinline__ void operator()(const f32x4 (&acc)[2][2][4][2], const g8::Unit& u, int wr, int wc, int fr, int fq) const {
        const int chb = (u.c0 >> 2) + wc * 16 + 4 * fq;
        const bf16* pr0 = P + (size_t)(u.r0 + wr * 64 + fr) * 4096 + chb;
        u32x2 pv[2][4][4];
#pragma unroll
        for (int ai = 0; ai < 2; ++ai)
#pragma unroll
            for (int m = 0; m < 4; ++m)
#pragma unroll
                for (int br = 0; br < 4; ++br) pv[ai][m][br] = *(const u32x2*)(pr0 + (size_t)(ai * 128 + m * 16) * 4096 + br * 1024);
#pragma unroll
        for (int ai = 0; ai < 2; ++ai)
#pragma unroll
            for (int m = 0; m < 4; ++m) { const size_t row = (size_t)(u.r0 + ai * 128 + wr * 64 + m * 16 + fr);
                f32x4 sum = (f32x4){0.f, 0.f, 0.f, 0.f};
#pragma unroll
                for (int bj = 0; bj < 2; ++bj)
#pragma unroll
                    for (int n = 0; n < 2; ++n) { const f32x4 a = acc[ai][bj][m][n]; const u32x2 p = pv[ai][m][2 * bj + n];
                        sum[0] += __builtin_amdgcn_rcpf(1.0f + fast_exp2(-a[0] * LOG2E)) * bflo(p.x); sum[1] += __builtin_amdgcn_rcpf(1.0f + fast_exp2(-a[1] * LOG2E)) * bfhi(p.x);
                        sum[2] += __builtin_amdgcn_rcpf(1.0f + fast_exp2(-a[2] * LOG2E)) * bflo(p.y); sum[3] += __builtin_amdgcn_rcpf(1.0f + fast_exp2(-a[3] * LOG2E)) * bfhi(p.y); }
                u32x2 w; w.x = cvt_pk_bf16(sum[0], sum[1]); w.y = cvt_pk_bf16(sum[2], sum[3]); *(u32x2*)(S + row * D + chb) = w; }
    }
};
struct EpiResid {
    static constexpr bool PERM = false; const float* H; float* X1; const float* mod;
    __device__ __forceinline__ void operator()(const f32x4 (&acc)[2][2][4][2], const g8::Unit& u, int wr, int wc, int fr, int fq) const {
        const int col0 = u.c0 + wc * 32 + 4 * fq;
#pragma unroll
        for (int ai = 0; ai < 2; ++ai)
#pragma unroll
            for (int m = 0; m < 4; ++m) { const int row = u.r0 + ai * 128 + wr * 64 + m * 16 + fr; const float* g1 = mod + (size_t)mod_row(row) * 6144 + 2048; const size_t off = (size_t)row * D;
#pragma unroll
                for (int bj = 0; bj < 2; ++bj)
#pragma unroll
                    for (int n = 0; n < 2; ++n) { const int c = col0 + bj * 128 + n * 16; *(f32x4*)(X1 + off + c) = *(const f32x4*)(H + off + c) * DN_ALPHA + *(const f32x4*)(g1 + c) * acc[ai][bj][m][n]; } }
    }
};
__device__ __forceinline__ void phase_inproj(const Ctx& C, int l) {
    SchedDense S{(const char*)WSP(bf16, WS_U1), (const char*)(WSP(bf16, WS_WIN) + (size_t)l * NZ * D), (size_t)D * 2, (size_t)D * 2, (T / 256) * (NZ / 256), C.G, C.bid, NZ / 256};
    EpiStoreBf16 E{WSP(bf16, WS_Z), (size_t)NZ};
    g8::gemm_phase(C.lds, D, D * 2, D * 2, S, E, C.tid);
}
__device__ __forceinline__ void phase_c1(const Ctx& C, int l, int nrows) {
    SchedC1 S{(const char*)WSP(bf16, WS_Y), (const char*)(WSP(bf16, WS_WB) + (size_t)l * 4 * 1024 * 256), (nrows / 256) * 16, C.G, C.bid};
    EpiStoreBf16 E{WSP(bf16, WS_P), (size_t)4096};
    g8::gemm_phase(C.lds, 256, 512, 512, S, E, C.tid);
}
__device__ __forceinline__ void phase_c2(const Ctx& C, int l, int nrows) {
    SchedDense S{(const char*)WSP(bf16, WS_U1), (const char*)(WSP(bf16, WS_WG) + (size_t)l * 4096 * D), (size_t)D * 2, (size_t)D * 2, (nrows / 256) * 16, C.G, C.bid, 16};
    EpiGateMerge E{WSP(bf16, WS_P), WSP(bf16, WS_S)};
    g8::gemm_phase(C.lds, D, D * 2, D * 2, S, E, C.tid);
}
struct SchedDctx {
    const char* A; const char* B; int G, c;
    __device__ __forceinline__ bool next(int i, g8::Unit& u) const { const int L = unit_index(i, G, c, 128); if (L < 0) return false; const int pm = L >> 4, pn = (L >> 2) & 3, ks = L & 3;
        u.A = A + ((size_t)TL + pm * 256) * (D * 2) + (size_t)ks * 512; u.B = B + (size_t)pn * 256 * (D * 2) + (size_t)ks * 512; u.r0 = ks * TC + pm * 256; u.c0 = pn * 256; u.x = ks; return true; }
};
struct EpiRawF32 {
    static constexpr bool PERM = false; float* O;
    __device__ __forceinline__ void operator()(const f32x4 (&acc)[2][2][4][2], const g8::Unit& u, int wr, int wc, int fr, int fq) const {
        float* base = O + (size_t)(u.r0 + wr * 64 + fr) * D + u.c0 + wc * 32 + 4 * fq;
#pragma unroll
        for (int ai = 0; ai < 2; ++ai)
#pragma unroll
            for (int m = 0; m < 4; ++m)
#pragma unroll
                for (int bj = 0; bj < 2; ++bj)
#pragma unroll
                    for (int n = 0; n < 2; ++n) *(f32x4*)(base + (size_t)(ai * 128 + m * 16) * D + bj * 128 + n * 16) = acc[ai][bj][m][n];
    }
};
__device__ __forceinline__ void phase_d(const Ctx& C, int l, int nrows) {
    {
        SchedDense S{(const char*)WSP(bf16, WS_S), (const char*)(WSP(bf16, WS_WO) + (size_t)l * D * D), (size_t)D * 2, (size_t)D * 2, (TL / 256) * 4, C.G, C.bid, 4};
        EpiResid E{WSP(float, WS_H), WSP(float, WS_X1), WSP(float, WS_MOD) + (size_t)l * 9 * 6144};
        g8::gemm_phase(C.lds, D, D * 2, D * 2, S, E, C.tid);
    }
    if (nrows > TL) {
        SchedDctx S{(const char*)WSP(bf16, WS_S), (const char*)(WSP(bf16, WS_WO) + (size_t)l * D * D), C.G, C.bid};
        EpiRawF32 E{(float*)(C.ws + WS_XE + (size_t)4 * NE * 256 * D * 2)};
        g8::gemm_phase(C.lds, 256, D * 2, D * 2, S, E, C.tid);
    }
}
__device__ __forceinline__ void phase_g(const Ctx& C, int l, int mt) {
    LAS int* srow = (LAS int*)(C.lds + g8::STAGE_BYTES);
    const int per = mt * 16, nunits = NE * per; const int* SROW = WSP(int, WS_SROW);
    for (int i = 0; i < 9; ++i) { const int L = unit_index(i, C.G, C.bid, nunits); if (L >= 0 && C.tid < 256) { const int e = L / per, r = L - e * per, pm = r >> 4; srow[i * 256 + C.tid] = SROW[e * ESLOT + pm * 256 + C.tid]; } }
    __syncthreads();
    SchedGroup S{(const char*)WSP(bf16, WS_U2), (const char*)(WSP(bf16, WS_WGU) + (size_t)l * NE * 4096 * D), (size_t)0, (size_t)D * 2, (size_t)4096 * D * 2, nunits, C.G, C.bid, 16, per};
    EpiSwiGLU E{WSP(bf16, WS_ACT)};
    g8::gemm_phase<EpiSwiGLU, SchedGroup, true>(C.lds, D, D * 2, D * 2, S, E, C.tid, srow);
    __syncthreads();
}
struct SchedHctx {
    const char* A; const char* B; int G, c;
    __device__ __forceinline__ bool next(int i, g8::Unit& u) const { const int L = unit_index(i, G, c, NE * 16); if (L < 0) return false; const int e = L >> 4, pn = (L >> 2) & 3, ks = L & 3;
        u.A = A + ((size_t)e * ESLOT + NB * CAPL) * (FF * 2) + (size_t)ks * 1024; u.B = B + ((size_t)e * D + pn * 256) * (FF * 2) + (size_t)ks * 1024; u.r0 = ks * (NE * 256) + e * 256; u.c0 = pn * 256; u.x = e; return true; }
};
__device__ __forceinline__ void phase_h(const Ctx& C, int l, int mt) {
    {
        SchedGroup S{(const char*)WSP(bf16, WS_ACT), (const char*)(WSP(bf16, WS_WD) + (size_t)l * NE * D * FF), (size_t)FF * 2, (size_t)FF * 2, (size_t)D * FF * 2, NE * 8 * 4, C.G, C.bid, 4, 8 * 4};
        EpiStoreBf16 E{WSP(bf16, WS_YE), (size_t)D};
        g8::gemm_phase(C.lds, FF, FF * 2, FF * 2, S, E, C.tid);
    }
    if (mt == 9) {
        SchedHctx S{(const char*)WSP(bf16, WS_ACT), (const char*)(WSP(bf16, WS_WD) + (size_t)l * NE * D * FF), C.G, C.bid};
        EpiStoreBf16 E{WSP(bf16, WS_XE), (size_t)D};
        g8::gemm_phase(C.lds, 512, FF * 2, FF * 2, S, E, C.tid);
    }
}

__device__ __forceinline__ void na_unit_latent(const Ctx& C, int l, int u) {
    const int b = u >> 5, hh = (u >> 3) & 3, rr = u & 7, w = C.wave;
    const bf16* Z = WSP(bf16, WS_Z);
    LAS float* btab = (LAS float*)(C.lds + 110 * 1024 + 256);
    for (int i = C.tid; i < 15 * 31; i += 512) btab[i] = C.in[I_RPB][((size_t)l * 4 + hh) * 465 + i] * LOG2E;
    {
        const int kx = u & 31;
        for (int it = 0; it < 3; ++it) { const int i = (it * 32 + kx) * 512 + C.tid, r = i >> 4, hl = i & 15;
            if (r < 2304) { const size_t row = (r < 256) ? (size_t)TL + (size_t)b * CTX + r : (size_t)b * SEQ + (r - 256); l2_touch(C, (const char*)(Z + row * NZ + ZK) + hl * 64); } }
    }
    __syncthreads();
    const int R = 4 * rr + (w >> 1), qc0 = 32 * (w & 1);
    int kr_lo = 4 * rr - 4; kr_lo = kr_lo < 0 ? 0 : (kr_lo > 24 ? 24 : kr_lo);
    int kr_hi = 4 * rr - 1; kr_hi = (kr_hi < 0 ? 0 : (kr_hi > 24 ? 24 : kr_hi)) + 8;
    int r0w = R - 4; r0w = r0w < 0 ? 0 : (r0w > 24 ? 24 : r0w);
    const size_t lat0 = (size_t)b * SEQ, ctx0 = (size_t)TL + (size_t)b * CTX;
    const bf16* q = Z + (lat0 + R * 64 + qc0) * NZ + ZQ + hh * 64;
    bf16* o = WSP(bf16, WS_Y) + (lat0 + R * 64 + qc0) * 256 + hh * 64;
    attn_unit<64, true>(C, q, NZ, Z + ctx0 * NZ + ZK + hh * 64, Z + ctx0 * NZ + ZV + hh * 64, 4,
                        Z + (lat0 + kr_lo * 64) * NZ + ZK + hh * 64, Z + (lat0 + kr_lo * 64) * NZ + ZV + hh * 64, kr_hi - kr_lo,
                        NZ, NZ, o, 256, r0w - kr_lo, r0w - kr_lo + 8, kr_lo - R + 7, qc0, btab);
    __syncthreads();
}
__device__ __forceinline__ void na_unit_ctx(const Ctx& C, int u) {
    const int b = u >> 2, hh = u & 3, w = C.wave;
    const bf16* Z = WSP(bf16, WS_Z);
    const size_t ctx0 = (size_t)TL + (size_t)b * CTX;
    const bf16* q = Z + (ctx0 + 32 * w) * NZ + ZQ + hh * 64;
    bf16* o = WSP(bf16, WS_Y) + (ctx0 + 32 * w) * 256 + hh * 64;
    attn_unit<64, false>(C, q, NZ, Z + ctx0 * NZ + ZK + hh * 64, Z + ctx0 * NZ + ZV + hh * 64, 4, nullptr, nullptr, 0, NZ, NZ, o, 256, 0, 0, 0, 0, nullptr);
    __syncthreads();
}
template <int NC>
__device__ __forceinline__ void row_rms(const Ctx& C, int tm, int zc, LAS float* rs) {
    const bf16* Z = WSP(bf16, WS_Z);
    const int r = C.tid >> 2, part = C.tid & 3;
    const bf16* p = Z + (size_t)(tm * 128 + r) * NZ + zc + part * (NC / 4);
    float s = 0.f;
#pragma unroll
    for (int i = 0; i < NC / 32; ++i) { const u32x4 v = *(const u32x4*)(p + 8 * i);
        const float a0 = bflo(v.x), a1 = bfhi(v.x), a2 = bflo(v.y), a3 = bfhi(v.y), a4 = bflo(v.z), a5 = bfhi(v.z), a6 = bflo(v.w), a7 = bfhi(v.w);
        s += a0 * a0 + a1 * a1 + a2 * a2 + a3 * a3 + a4 * a4 + a5 * a5 + a6 * a6 + a7 * a7; }
    s += __shfl_xor(s, 1); s += __shfl_xor(s, 2);
    if (part == 0) rs[r] = 1.0f / sqrtf(s * (1.0f / NC) + LN_EPS);
    __syncthreads();
}
__device__ __forceinline__ void mlaq_tile(const Ctx& C, int l, int u) {
    const int tm = u / 3, tn = u % 3;
    LAS float* rs = (LAS float*)(C.lds + 110 * 1024);
    const bf16* Z = WSP(bf16, WS_Z); const bf16* W = WSP(bf16, WS_WUQ) + (size_t)l * 384 * 256; bf16* QM = WSP(bf16, WS_QM);
    const float* rope = WSP(float, WS_ROPE);
    auto arow = [=](int r) { return Z + (size_t)(tm * 128 + r) * NZ + ZCQ; };
    auto brow = [=](int r) { return W + (size_t)(tn * 128 + r) * 256; };
    auto epi = [=](const f32x4 (&acc)[4][2], int wr, int wc, int fr, int fq) {
        f32x4 csv[4][2];
#pragma unroll
        for (int m = 0; m < 4; ++m)
#pragma unroll
            for (int n = 0; n < 2; ++n) { const int row = tm * 128 + wr * 64 + m * 16 + fr, cc = (tn * 128 + wc * 32 + n * 16 + 4 * fq) % 96, pi = cc >= 64 ? (cc - 64) >> 1 : 0;
                csv[m][n] = *(const f32x4*)(rope + (size_t)(row & 2047) * 32 + 2 * pi); }
#pragma unroll
        for (int m = 0; m < 4; ++m)
#pragma unroll
            for (int n = 0; n < 2; ++n) asm volatile("" : "+v"(csv[m][n]));
#pragma unroll
        for (int m = 0; m < 4; ++m)
#pragma unroll
            for (int n = 0; n < 2; ++n) { const int rl = wr * 64 + m * 16 + fr, row = tm * 128 + rl, col = tn * 128 + wc * 32 + n * 16 + 4 * fq;
                const float s = rs[rl] * MLA_QS; f32x4 v = acc[m][n] * s;
                const int cc = col % 96;
                if (cc >= 64 && row < TL) { const f32x4 cs = csv[m][n];
                    const float x1 = v[0], x2 = v[1], y1 = v[2], y2 = v[3];
                    v[0] = x1 * cs[0] - x2 * cs[1]; v[1] = x1 * cs[1] + x2 * cs[0]; v[2] = y1 * cs[2] - y2 * cs[3]; v[3] = y1 * cs[3] + y2 * cs[2]; }
                u32x2 w; w.x = cvt_pk_bf16(v[0], v[1]); w.y = cvt_pk_bf16(v[2], v[3]); *(u32x2*)(QM + (size_t)row * 384 + col) = w; }
    };
    sgemm_tile_d4<256>(C, arow, brow, [](int) { return 64L; }, 256, epi, rs);
}
__device__ __forceinline__ void mlakv_tile(const Ctx& C, int l, int u) {
    const int tm = u >> 2, tn = u & 3;
    LAS float* rs = (LAS float*)(C.lds + 110 * 1024);
    const bf16* Z = WSP(bf16, WS_Z); const bf16* W = WSP(bf16, WS_WUKV) + (size_t)l * 512 * 128; bf16* KM = WSP(bf16, WS_KM); bf16* VM = WSP(bf16, WS_VM);
    const float* rope = WSP(float, WS_ROPE);
    u32x2 wv[2]; f32x4 csv[2];
#pragma unroll
    for (int q = 0; q < 2; ++q) { const int i = C.tid + 512 * q, rl = i >> 3, g4 = i & 7, row = tm * 128 + rl;
        wv[q] = *(const u32x2*)(Z + (size_t)row * NZ + ZKR + 4 * g4); csv[q] = *(const f32x4*)(rope + (size_t)(row & 2047) * 32 + 4 * g4); }
    auto arow = [=](int r) { return Z + (size_t)(tm * 128 + r) * NZ + ZCKV; };
    auto brow = [=](int r) { return W + (size_t)(tn * 128 + r) * 128; };
    auto epi = [=](const f32x4 (&acc)[4][2], int wr, int wc, int fr, int fq) {
#pragma unroll
        for (int m = 0; m < 4; ++m)
#pragma unroll
            for (int n = 0; n < 2; ++n) { const int rl = wr * 64 + m * 16 + fr, row = tm * 128 + rl, c = wc * 32 + n * 16 + 4 * fq;
                const f32x4 v = acc[m][n] * rs[rl]; u32x2 w; w.x = cvt_pk_bf16(v[0], v[1]); w.y = cvt_pk_bf16(v[2], v[3]);
                if (c < 64) *(u32x2*)(KM + (size_t)row * 384 + tn * 96 + c) = w; else *(u32x2*)(VM + (size_t)row * 256 + tn * 64 + (c - 64)) = w; }
    };
    sgemm_tile_d4<128>(C, arow, brow, [](int) { return 64L; }, 128, epi, rs);
#pragma unroll
    for (int q = 0; q < 2; ++q) { const int i = C.tid + 512 * q, rl = i >> 3, g4 = i & 7, row = tm * 128 + rl;
        const u32x2 w = wv[q]; float x1 = bflo(w.x), x2 = bfhi(w.x), y1 = bflo(w.y), y2 = bfhi(w.y);
        if (row < TL) { const f32x4 cs = csv[q];
            const float a = x1 * cs[0] - x2 * cs[1], b2 = x1 * cs[1] + x2 * cs[0], c2 = y1 * cs[2] - y2 * cs[3], d2 = y1 * cs[3] + y2 * cs[2]; x1 = a; x2 = b2; y1 = c2; y2 = d2; }
        u32x2 o; o.x = cvt_pk_bf16(x1, x2); o.y = cvt_pk_bf16(y1, y2); *(u32x2*)(KM + (size_t)row * 384 + tn * 96 + 64 + 4 * g4) = o; }
}
__device__ __forceinline__ void fft1_tile(const Ctx& C, int u) {
    const bf16* Z = WSP(bf16, WS_Z); const bf16* T64 = WSP(bf16, WS_T64);
    int b, g, ch, L; size_t tok0; bf16* dst; int ldd, half;
    if (u < 256) { b = u >> 5; g = (u >> 3) & 3; ch = u & 7; L = SEQ; tok0 = (size_t)b * SEQ; dst = WSP(bf16, WS_FB) + (size_t)((b * 4 + g) * 64) * 2048 + ch * 128; ldd = 2048; half = 1024; }
    else { const int v = u - 256; b = v >> 2; g = v & 3; ch = 0; L = CTX; tok0 = (size_t)TL + (size_t)b * CTX; dst = WSP(bf16, WS_FBC) + (size_t)((b * 4 + g) * 64) * 256; ldd = 256; half = 128; }
    const bf16* Zg = Z + tok0 * NZ + ZF + g * 64;
    auto arow = [=](int r) { return T64 + (size_t)r * 128; };
    auto brow = [=](int r) { return Zg + (size_t)(ch * 128 + r) * NZ; };
    auto bstep = [=](int r) { const int n = ch * 128 + r, mir = (L - n) & (L - 1); return (long)(mir - n) * NZ; };
    auto epi = [=](const f32x4 (&acc)[4][2], int wr, int wc, int fr, int fq) {
#pragma unroll
        for (int m = 0; m < 4; ++m)
#pragma unroll
            for (int n = 0; n < 2; ++n) { const int mrow = wr * 64 + m * 16 + fr, col = wc * 32 + n * 16 + 4 * fq;
                u32x2 w; w.x = cvt_pk_bf16(acc[m][n][0], acc[m][n][1]); w.y = cvt_pk_bf16(acc[m][n][2], acc[m][n][3]);
                *(u32x2*)(dst + (size_t)(mrow & 63) * ldd + (mrow >> 6) * half + col) = w; }
    };
    sgemm_tile_d4<0>(C, arow, brow, bstep, 128, epi);
    if (ch == 0 && C.tid < 64) {
        const bf16* zr = Zg + (size_t)(L >> 1) * NZ; const bf16* tr = T64 + (size_t)C.tid * 128; float s = 0.f;
#pragma unroll
        for (int c8 = 0; c8 < 8; ++c8) { const u32x4 z = *(const u32x4*)(zr + c8 * 8), t = *(const u32x4*)(tr + c8 * 8);
            s += bflo(z.x) * bflo(t.x) + bfhi(z.x) * bfhi(t.x) + bflo(z.y) * bflo(t.y) + bfhi(z.y) * bfhi(t.y) + bflo(z.z) * bflo(t.z) + bfhi(z.z) * bfhi(t.z) + bflo(z.w) * bflo(t.w) + bfhi(z.w) * bfhi(t.w); }
        dst[(size_t)C.tid * ldd + half] = (bf16)(cvt_pk_bf16(s, 0.f) & 0xffff);
    }
}
__device__ __forceinline__ void pool_all(const Ctx& C) {
    const bf16* Z = WSP(bf16, WS_Z); bf16* Y1 = WSP(bf16, WS_Y) + (size_t)T * 256;
    const size_t gtid = (size_t)C.bid * 512 + C.tid, gth = (size_t)C.G * 512;
    for (size_t i = gtid; i < (size_t)T * 32; i += gth) {
        const int row = (int)(i >> 5), c8 = (int)(i & 31), g = c8 >> 3;
        const int L = row < TL ? SEQ : CTX, s0 = row < TL ? (row & ~2047) : TL + ((row - TL) & ~255), t = row - s0, half = 1 << g;
        int lo = t - half; lo = lo < 0 ? 0 : lo; int hi = t + half; hi = hi > L ? L : hi;
        float a[8];
#pragma unroll
        for (int q = 0; q < 8; ++q) a[q] = 0.f;
        u32x4 wv[16];
#pragma unroll
        for (int q = 0; q < 16; ++q) { const int tt = t - 8 + q; wv[q] = (u32x4){0u, 0u, 0u, 0u}; if (tt >= lo && tt < hi) wv[q] = *(const u32x4*)(Z + (size_t)(s0 + tt) * NZ + ZP + c8 * 8); }
        const u32x4 me = *(const u32x4*)(Z + (size_t)row * NZ + ZP + c8 * 8);
#pragma unroll
        for (int q = 0; q < 16; ++q) asm volatile("" : "+v"(wv[q]));
#pragma unroll
        for (int q = 0; q < 16; ++q) { const u32x4 v = wv[q];
            a[0] += bflo(v.x); a[1] += bfhi(v.x); a[2] += bflo(v.y); a[3] += bfhi(v.y); a[4] += bflo(v.z); a[5] += bfhi(v.z); a[6] += bflo(v.w); a[7] += bfhi(v.w); }
        const float inv = 1.0f / (float)(hi - lo);
        u32x4 o; o.x = cvt_pk_bf16(a[0] * inv - bflo(me.x), a[1] * inv - bfhi(me.x)); o.y = cvt_pk_bf16(a[2] * inv - bflo(me.y), a[3] * inv - bfhi(me.y));
        o.z = cvt_pk_bf16(a[4] * inv - bflo(me.z), a[5] * inv - bfhi(me.z)); o.w = cvt_pk_bf16(a[6] * inv - bflo(me.w), a[7] * inv - bfhi(me.w));
        *(u32x4*)(Y1 + (size_t)row * 256 + c8 * 8) = o;
    }
}
__device__ __forceinline__ void phase_b0(const Ctx& C, int l) {
    const bool wc = l < DEPTH - 1;
    const int n_na = 256, n_nac = wc ? 32 : 0, n_q = (T / 128) * 3, n_kv = (T / 128) * 4, n_f = wc ? 288 : 256;
    const int total = n_na + n_nac + n_q + n_kv + n_f;
    for (int u = C.bid; u < total; u += C.G) {
        int v = u;
        if (v < n_na) { na_unit_latent(C, l, v); continue; } v -= n_na;
        if (v < n_nac) { na_unit_ctx(C, v); continue; } v -= n_nac;
        if (v < n_q) { mlaq_tile(C, l, v); continue; } v -= n_q;
        if (v < n_kv) { mlakv_tile(C, l, v); continue; } v -= n_kv;
        fft1_tile(C, v);
    }
    pool_all(C);
}

__device__ __forceinline__ void mla_unit(const Ctx& C, int u, bool ctxq) {
    const bf16* QM = WSP(bf16, WS_QM); const bf16* KM = WSP(bf16, WS_KM); const bf16* VM = WSP(bf16, WS_VM);
    bf16* Y3 = WSP(bf16, WS_Y) + (size_t)3 * T * 256;
    const int w = C.wave;
    if (!ctxq) {
        const int b = u >> 5, hh = (u >> 3) & 3, qb = u & 7;
        const size_t lat0 = (size_t)b * SEQ, ctx0 = (size_t)TL + (size_t)b * CTX, q0 = lat0 + qb * 256 + w * 32;
        {
            const int kx = u & 31;
            for (int it = 0; it < 3; ++it) { const int i = (it * 32 + kx) * 512 + C.tid, r = i / 20, hl = i - r * 20;
                if (r < 2304) { const size_t row = (r < 2048) ? lat0 + r : ctx0 + (r - 2048);
                    l2_touch(C, hl < 12 ? (const char*)(KM + row * 384) + hl * 64 : (const char*)(VM + row * 256) + (hl - 12) * 64); } }
        }
        attn_unit<96, false>(C, QM + q0 * 384 + hh * 96, 384, KM + lat0 * 384 + hh * 96, VM + lat0 * 256 + hh * 64, 32,
                             KM + ctx0 * 384 + hh * 96, VM + ctx0 * 256 + hh * 64, 4, 384, 256, Y3 + q0 * 256 + hh * 64, 256, 0, 0, 0, 0, nullptr);
    } else {
        const int b = u >> 2, hh = u & 3;
        const size_t ctx0 = (size_t)TL + (size_t)b * CTX, q0 = ctx0 + w * 32;
        attn_unit<96, false>(C, QM + q0 * 384 + hh * 96, 384, KM + ctx0 * 384 + hh * 96, VM + ctx0 * 256 + hh * 64, 4,
                             nullptr, nullptr, 0, 384, 256, Y3 + q0 * 256 + hh * 64, 256, 0, 0, 0, 0, nullptr);
    }
    __syncthreads();
}
__device__ __forceinline__ void fft2_tile(const Ctx& C, int u, bool ctxq) {
    bf16* Y2 = WSP(bf16, WS_Y) + (size_t)2 * T * 256;
    if (!ctxq) {
        const int ux = u >> 5, uk = u & 31, tm = (ux >> 1) * 4 + (uk & 3), tn = (ux & 1) * 8 + (uk >> 2), b = tn >> 1;
        const bf16* A = WSP(bf16, WS_AFFT); const bf16* Bt = WSP(bf16, WS_FB);
        auto arow = [=](int r) { return A + (size_t)(tm * 128 + r) * 2048; };
        auto brow = [=](int r) { return Bt + (size_t)(tn * 128 + r) * 2048; };
        auto epi = [=](const f32x4 (&acc)[4][2], int wr, int wc, int fr, int fq) {
#pragma unroll
            for (int m = 0; m < 4; ++m)
#pragma unroll
                for (int n = 0; n < 2; ++n) { const int k1 = tm * 128 + wr * 64 + m * 16 + fr, chn = (tn & 1) * 128 + wc * 32 + n * 16 + 4 * fq;
                    u32x2 w; w.x = cvt_pk_bf16(acc[m][n][0], acc[m][n][1]); w.y = cvt_pk_bf16(acc[m][n][2], acc[m][n][3]);
                    *(u32x2*)(Y2 + ((size_t)b * SEQ + k1) * 256 + chn) = w; }
        };
        sgemm_tile_d4(C, arow, brow, 2048, epi);
    } else {
        const int tm = u >> 4, tn = u & 15, b = tn >> 1;
        const bf16* A = WSP(bf16, WS_AFFTC); const bf16* Bt = WSP(bf16, WS_FBC);
        auto arow = [=](int r) { return A + (size_t)(tm * 128 + r) * 256; };
        auto brow = [=](int r) { return Bt + (size_t)(tn * 128 + r) * 256; };
        auto epi = [=](const f32x4 (&acc)[4][2], int wr, int wc, int fr, int fq) {
#pragma unroll
            for (int m = 0; m < 4; ++m)
#pragma unroll
                for (int n = 0; n < 2; ++n) { const int k1 = tm * 128 + wr * 64 + m * 16 + fr, chn = (tn & 1) * 128 + wc * 32 + n * 16 + 4 * fq;
                    u32x2 w; w.x = cvt_pk_bf16(acc[m][n][0], acc[m][n][1]); w.y = cvt_pk_bf16(acc[m][n][2], acc[m][n][3]);
                    *(u32x2*)(Y2 + ((size_t)TL + (size_t)b * CTX + k1) * 256 + chn) = w; }
        };
        sgemm_tile_d4(C, arow, brow, 256, epi);
    }
}
__device__ __forceinline__ void phase_b1(const Ctx& C, int l) {
    const bool wc = l < DEPTH - 1;
    const int n_m = 256, n_f = 256, n_mc = wc ? 32 : 0, n_fc = wc ? 32 : 0;
    const int total = n_m + n_f + n_mc + n_fc;
    for (int u = C.bid; u < total; u += C.G) {
        int v = u;
        if (v < n_m) { mla_unit(C, v, false); continue; } v -= n_m;
        if (v < n_f) { fft2_tile(C, v, false); continue; } v -= n_f;
        if (v < n_mc) { mla_unit(C, v, true); continue; } v -= n_mc;
        fft2_tile(C, v, true);
    }
}

__device__ __forceinline__ void phase_e(const Ctx& C, int l, int nrows) {
    LAS float* wr = (LAS float*)C.lds;
    LAS float* lgl = (LAS float*)(C.lds + 65536);
    LAS float* lbl = lgl + 1024;
    LAS float* mdl = lbl + 1024;
    const int tid = C.tid, lane = C.lane, rg = lane >> 4, li = lane & 15;
    {   f32x4 wv[8];
#pragma unroll
        for (int q = 0; q < 8; ++q) wv[q] = *(const f32x4*)(C.in[I_WROUTER] + (size_t)l * 16384 + 4 * (tid + 512 * q));
        const f32x4 gv = *(const f32x4*)(C.in[(tid < 256) ? I_LN1G : I_LN1B] + l * D + 4 * (tid & 255));
#pragma unroll
        for (int q = 0; q < 8; ++q) { const int i4 = tid + 512 * q, d = i4 >> 2, e4 = (i4 & 3) * 4; wr[(e4 + 0) * 1024 + d] = wv[q][0]; wr[(e4 + 1) * 1024 + d] = wv[q][1]; wr[(e4 + 2) * 1024 + d] = wv[q][2]; wr[(e4 + 3) * 1024 + d] = wv[q][3]; }
        *(LAS f32x4*)(((tid < 256) ? lgl : lbl) + 4 * (tid & 255)) = gv; }
    const int bkk = blk_k(C), bxx = blk_x(C), bp = (bkk < 8) ? bxx * 8 + bkk : 64 + bxx * 24 + (bkk - 8);
    const int gw = bp * 8 + C.wave, NGW = C.G * 8, ngroups = nrows >> 2;
    const float* mod = WSP(float, WS_MOD) + (size_t)l * 9 * 6144;
    const float* X1 = WSP(float, WS_X1);
    float* AFFT = WSP(float, WS_AFF);
    f32x4 nx[16]; f32x4 nmd;
    const int mdv = tid >> 8, mdc = (tid & 255) * 4;
    if (gw < ngroups) {
        const int row = 4 * gw + rg; const float* mr = mod + (size_t)mod_row(4 * gw) * 6144;
#pragma unroll
        for (int j = 0; j < 16; ++j) nx[j] = *(const f32x4*)(X1 + (size_t)row * D + 4 * li + 64 * j);
        nmd = *(const f32x4*)(mr + (mdv ? 3072 : 4096) + mdc);
    }
    for (int g = gw, it = 0; g < ngroups; g += NGW, ++it) {
        {   f32x4 w = nmd; if (mdv == 0) w = w + 1.0f; *(LAS f32x4*)(mdl + (it & 1) * 2048 + mdv * 1024 + mdc) = w; }
        __syncthreads();
        const LAS float* scl = mdl + (it & 1) * 2048; const LAS float* shl = scl + 1024;
        f32x4 v[16]; float s = 0.f;
        const int row = 4 * g + rg;
        if (4 * g < TL) {
#pragma unroll
            for (int j = 0; j < 16; ++j) v[j] = nx[j];
        } else {
            const float* hr = WSP(float, WS_H) + (size_t)row * D + 4 * li; const float* g1 = mod + (size_t)8 * 6144 + 2048 + 4 * li;
            const float* pc = (const float*)(C.ws + WS_XE + (size_t)4 * NE * 256 * D * 2) + (size_t)(row - TL) * D + 4 * li;
#pragma unroll
            for (int j = 0; j < 16; ++j) v[j] = *(const f32x4*)(hr + 64 * j);
#pragma unroll
            for (int jb = 0; jb < 4; ++jb) {
#pragma unroll
                for (int jj = 0; jj < 4; ++jj)
#pragma unroll
                    for (int k = 0; k < 4; ++k) nx[4 * jj + k] = *(const f32x4*)(pc + (size_t)k * TC * D + 64 * (4 * jb + jj));
                f32x4 gq[4];
#pragma unroll
                for (int jj = 0; jj < 4; ++jj) gq[jj] = *(const f32x4*)(g1 + 64 * (4 * jb + jj));
#pragma unroll
                for (int q = 0; q < 16; ++q) asm volatile("" : "+v"(nx[q]));
#pragma unroll
                for (int jj = 0; jj < 4; ++jj) asm volatile("" : "+v"(gq[jj]));
#pragma unroll
                for (int jj = 0; jj < 4; ++jj) { const int j = 4 * jb + jj;
                    v[j] = v[j] * DN_ALPHA + gq[jj] * ((nx[4 * jj] + nx[4 * jj + 1]) + (nx[4 * jj + 2] + nx[4 * jj + 3])); }
            }
#pragma unroll
            for (int j = 0; j < 16; ++j) *(f32x4*)(WSP(float, WS_X1) + (size_t)row * D + 4 * li + 64 * j) = v[j];
        }
#pragma unroll
        for (int j = 0; j < 16; ++j) s += (v[j][0] + v[j][1]) + (v[j][2] + v[j][3]);
        if (g + NGW < ngroups) { const int gn = g + NGW, rn = 4 * gn + rg; const float* mr = mod + (size_t)mod_row(4 * gn) * 6144;
            if (4 * gn < TL) {
#pragma unroll
                for (int j = 0; j < 16; ++j) nx[j] = *(const f32x4*)(X1 + (size_t)rn * D + 4 * li + 64 * j);
            }
            nmd = *(const f32x4*)(mr + (mdv ? 3072 : 4096) + mdc); }
        const float mean = row16_sum(s) * (1.0f / D); float q = 0.f;
#pragma unroll
        for (int j = 0; j < 16; ++j) { v[j] = v[j] - mean; q += (v[j][0] * v[j][0] + v[j][1] * v[j][1]) + (v[j][2] * v[j][2] + v[j][3] * v[j][3]); }
        const float rstd = 1.0f / sqrtf(row16_sum(q) * (1.0f / D) + LN_EPS);
        typedef float f32x2r __attribute__((ext_vector_type(2)));
        f32x2r lg2[16];
#pragma unroll
        for (int e = 0; e < 16; ++e) lg2[e] = (f32x2r){0.f, 0.f};
        bf16* ud = WSP(bf16, WS_U2) + (size_t)row * D + 4 * li;
        if (li == 0) { typedef float f32x2v __attribute__((ext_vector_type(2))); *(f32x2v*)(WSP(float, WS_ST1) + (size_t)row * 2) = (f32x2v){mean, rstd}; }
#pragma unroll
        for (int j = 0; j < 16; ++j) { const int c = 4 * li + 64 * j;
            const f32x4 y = v[j] * rstd * *(const LAS f32x4*)(lgl + c) + *(const LAS f32x4*)(lbl + c);
            const f32x4 uu = y * *(const LAS f32x4*)(scl + c) + *(const LAS f32x4*)(shl + c);
            u32x2 w; w.x = cvt_pk_bf16(uu[0], uu[1]); w.y = cvt_pk_bf16(uu[2], uu[3]); st_wt8(ud + 64 * j, w);
#pragma unroll
            for (int eh = 0; eh < 4; ++eh) {
                f32x4 ww[4];
#pragma unroll
                for (int e = 0; e < 4; ++e) ww[e] = *(const LAS f32x4*)(wr + (4 * eh + e) * 1024 + c);
                __builtin_amdgcn_sched_barrier(0);
#pragma unroll
                for (int e = 0; e < 4; ++e) { lg2[4 * eh + e] = __builtin_elementwise_fma((f32x2r){uu[0], uu[1]}, (f32x2r){ww[e][0], ww[e][1]}, lg2[4 * eh + e]);
                    lg2[4 * eh + e] = __builtin_elementwise_fma((f32x2r){uu[2], uu[3]}, (f32x2r){ww[e][2], ww[e][3]}, lg2[4 * eh + e]); }
                __builtin_amdgcn_sched_barrier(0);
            }
        }
        float lgt[16];
        float mx = -1e30f;
#pragma unroll
        for (int e = 0; e < 16; ++e) { lgt[e] = row16_sum(lg2[e][0] + lg2[e][1]); mx = fmaxf(mx, lgt[e]); }
        float den = 0.f;
#pragma unroll
        for (int e = 0; e < 16; ++e) { lgt[e] = __expf(lgt[e] - mx); den += lgt[e]; }
        const float inv = 1.0f / den; float mine = 0.f;
#pragma unroll
        for (int e = 0; e < 16; ++e) mine = (li == e) ? lgt[e] * inv : mine;
        AFFT[(size_t)li * T + row] = mine;
    }
    __syncthreads();
}
__device__ __forceinline__ void phase_f(const Ctx& C, int l) {
    const bool wc = l < DEPTH - 1;
    const int nunits = 128 + (wc ? 128 : 0);
    LAS unsigned* hist = (LAS unsigned*)(C.lds);
    LAS unsigned* wsum = (LAS unsigned*)(C.lds + 256);
    const int tid = C.tid, lane = C.lane, wave = C.wave;
    const float* AFF = WSP(float, WS_AFF); int* SLOT = WSP(int, WS_SLOT); float* GATEV = WSP(float, WS_GATEV); int* SROW = WSP(int, WS_SROW);
    {
        const int bx = blk_x(C), bk = blk_k(C); const int u = (bk < 16) ? bx * 16 + bk : 128 + bx * 16 + (bk - 16);
        if (u < nunits) {
        const bool isc = u >= 128; const int v = isc ? u - 128 : u, b = v >> 4, e = v & 15;
        const int cap = isc ? CAPC : CAPL, vpt = isc ? 1 : 4;
        const int row0 = isc ? TL + b * CTX : b * SEQ;
        const int sbase = e * ESLOT + (isc ? NB * CAPL + b * CAPC : b * CAPL);
        const bool have = isc ? (tid < 256) : true;
        unsigned key[4];
#pragma unroll
        for (int i = 0; i < 4; ++i) { key[i] = 0u; if (have && i < vpt) key[i] = __float_as_uint(AFF[(size_t)e * T + row0 + tid * vpt + i]); }
        if (tid < 48) hist[tid] = 0u;
        __syncthreads();
        unsigned prefix = 0u; int kth = cap;
#pragma unroll 1
        for (int it = 0; it < 8; ++it) {
            const int shift = 28 - 4 * it; LAS unsigned* hb = hist + 16 * (it % 3);
            if (tid < 16) hist[16 * ((it + 1) % 3) + tid] = 0u;
            unsigned mycnt = 0u;
#pragma unroll
            for (int i = 0; i < 4; ++i) {
                const bool in = have && i < vpt && (it == 0 || (key[i] >> (shift + 4)) == (prefix >> (shift + 4)));
                const unsigned dg = (key[i] >> shift) & 15u;
#pragma unroll
                for (int d = 0; d < 16; ++d) { const unsigned c = (unsigned)__popcll(__ballot(in && dg == (unsigned)d)); mycnt = (lane == d) ? mycnt + c : mycnt; }
            }
            if (lane < 16 && mycnt) atomicAdd((unsigned*)(hb + lane), mycnt);
            __syncthreads();
            unsigned cum = 0u; int dsel = 0; int kn = kth;
#pragma unroll
            for (int d = 15; d >= 0; --d) { const unsigned h = hb[d]; const bool hit = (cum < (unsigned)kth) && (cum + h >= (unsigned)kth); if (hit) { dsel = d; kn = kth - (int)cum; } cum += h; }
            prefix |= ((unsigned)dsel << shift); kth = kn;
        }
        const unsigned thr = prefix;
        unsigned neq = 0;
#pragma unroll
        for (int i = 0; i < 4; ++i) if (have && i < vpt) neq += (key[i] == thr);
        unsigned incl = neq;
#pragma unroll
        for (int o = 1; o < 64; o <<= 1) { const unsigned t2 = __shfl_up(incl, o); if (lane >= o) incl += t2; }
        if (lane == 63) wsum[wave] = incl;
        __syncthreads();
        unsigned woff = 0;
        for (int w2 = 0; w2 < wave; ++w2) woff += wsum[w2];
        unsigned eqrank = woff + incl - neq;
        unsigned sel[4]; unsigned nsel = 0;
#pragma unroll
        for (int i = 0; i < 4; ++i) { sel[i] = 0u; if (have && i < vpt) { if (key[i] > thr) sel[i] = 1u; else if (key[i] == thr) { sel[i] = ((int)eqrank < kth) ? 1u : 0u; ++eqrank; } nsel += sel[i]; } }
        incl = nsel;
#pragma unroll
        for (int o = 1; o < 64; o <<= 1) { const unsigned t2 = __shfl_up(incl, o); if (lane >= o) incl += t2; }
        if (lane == 63) wsum[8 + wave] = incl;
        __syncthreads();
        woff = 0;
        for (int w2 = 0; w2 < wave; ++w2) woff += wsum[8 + w2];
        unsigned pos = woff + incl - nsel;
#pragma unroll
        for (int i = 0; i < 4; ++i) if (have && i < vpt) { const int t = tid * vpt + i; int slot = -1;
            if (sel[i]) { slot = sbase + (int)pos; SROW[slot] = row0 + t; GATEV[slot] = __uint_as_float(key[i]); ++pos; }
            SLOT[(size_t)(row0 + t) * 16 + e] = slot; }
        __syncthreads();
    }
    }
}
__device__ __forceinline__ void phase_i(const Ctx& C, int l, int nrows) {
    LAS float* lgl = (LAS float*)C.lds;
    LAS float* lbl = lgl + 1024;
    LAS float* mdl = lbl + 1024;
    const int tid = C.tid, lane = C.lane, rg = lane >> 4, li = lane & 15;
    LAS float* l1g = mdl + 6144;
    LAS float* l1b = l1g + 1024;
    for (int i = tid; i < 1024; i += 512) { lgl[i] = C.in[I_LN2G][l * D + i]; lbl[i] = C.in[I_LN2B][l * D + i]; l1g[i] = C.in[I_LN1G][l * D + i]; l1b[i] = C.in[I_LN1B][l * D + i]; }
    const int bkk = blk_k(C), bxx = blk_x(C), bp = (bkk < 8) ? bxx * 8 + bkk : 64 + bxx * 24 + (bkk - 8);
    const int gw = bp * 8 + C.wave, NGW = C.G * 8, ngroups = nrows >> 2;
    const float* mod = WSP(float, WS_MOD) + (size_t)l * 9 * 6144;
    const float* modn = WSP(float, WS_MOD) + (size_t)(l + 1 < DEPTH ? l + 1 : l) * 9 * 6144;
    const int* SLOT = WSP(int, WS_SLOT); const float* GATEV = WSP(float, WS_GATEV); const bf16* YE = WSP(bf16, WS_YE); const bf16* YEC = WSP(bf16, WS_XE);
    float* Hb = WSP(float, WS_H); bf16* U1b = WSP(bf16, WS_U1); const float* X1b = WSP(float, WS_X1);
    const int mdv = tid >> 8, mdc = (tid & 255) * 4;
    auto mdload = [&](int g4row) -> f32x4 { const int r = mod_row(g4row); const float* p = (mdv == 0) ? mod + (size_t)r * 6144 + 5120 + mdc : modn + (size_t)r * 6144 + (mdv == 1 ? 1024 : 0) + mdc; return *(const f32x4*)p; };
    f32x4 nmd0 = (f32x4){0.f, 0.f, 0.f, 0.f}, nmd1 = nmd0;
    if (gw < ngroups) { nmd0 = mdload(4 * gw); if (tid < 256) { const int r = mod_row(4 * gw); nmd1 = *(const f32x4*)(modn + (size_t)r * 6144 + mdc); } }
    for (int g = gw, it = 0; g < ngroups; g += NGW, ++it) {
        {   LAS float* buf = mdl + (it & 1) * 3072;
            if (mdv < 2) { f32x4 w = nmd0; if (mdv == 1) w = w + 1.0f; *(LAS f32x4*)(buf + mdv * 1024 + mdc) = w; }
            if (tid < 256) *(LAS f32x4*)(buf + 2048 + mdc) = nmd1; }
        __syncthreads();
        const LAS float* g2l = mdl + (it & 1) * 3072; const LAS float* scl = g2l + 1024; const LAS float* shl = g2l + 2048;
        const int row = 4 * g + rg;
        const int myslot = SLOT[(size_t)row * 16 + li];
        f32x4 hv[16];
        typedef float f32x2v __attribute__((ext_vector_type(2))); const f32x2v st1 = *(const f32x2v*)(WSP(float, WS_ST1) + (size_t)row * 2);
#pragma unroll
        for (int j = 0; j < 16; ++j) hv[j] = *(const f32x4*)(X1b + (size_t)row * D + 4 * li + 64 * j);
        if (g + NGW < ngroups) { const int gn = g + NGW; nmd0 = mdload(4 * gn); if (tid < 256) { const int r = mod_row(4 * gn); nmd1 = *(const f32x4*)(modn + (size_t)r * 6144 + mdc); } }
        const unsigned long long bal = __ballot(myslot >= 0);
        unsigned m = (unsigned)(bal >> (16 * rg)) & 0xffffu;
#pragma unroll
        for (int j = 0; j < 16; ++j) { const int c = 4 * li + 64 * j; hv[j] = ((hv[j] - st1.x) * st1.y * *(const LAS f32x4*)(l1g + c) + *(const LAS f32x4*)(l1b + c)) * DN_ALPHA;
            if ((j & 3) == 3) __builtin_amdgcn_sched_barrier(0); }
        const bool isctx = (4 * g) >= TL;
        int ph = 0;
        while (__any(m != 0u)) {
            const bf16* p[2]; float gt[2];
            if (!isctx) {
#pragma unroll
                for (int k = 0; k < 2; ++k) { const bool ok = m != 0u; const int e = ok ? (int)__builtin_ctz(m) : 0; m = ok ? (m & (m - 1u)) : 0u;
                    const int sv = __shfl(myslot, (rg << 4) + e); const int se = ok ? sv : 0; gt[k] = ok ? GATEV[se] : 0.f; p[k] = YE + (size_t)se * D + 4 * li; }
            } else {
                const bool ok = m != 0u; const int e = ok ? (int)__builtin_ctz(m) : 0; if (ph) m = ok ? (m & (m - 1u)) : 0u;
                const int sv = __shfl(myslot, (rg << 4) + e); const int se = ok ? sv : NB * CAPL; const float gv = ok ? GATEV[se] : 0.f;
                const int ex = se / ESLOT, cr = se - ex * ESLOT - NB * CAPL; const bf16* base = YEC + ((size_t)ex * 256 + cr) * D + 4 * li + (size_t)(2 * ph) * (NE * 256) * D;
                p[0] = base; p[1] = base + (size_t)(NE * 256) * D; gt[0] = gv; gt[1] = gv; ph ^= 1;
            }
            const LAS float* g2p = g2l + 4 * li; asm volatile("" : "+v"(g2p));
            u32x2 w[2][16];
#pragma unroll
            for (int k = 0; k < 2; ++k)
#pragma unroll
                for (int j = 0; j < 16; ++j) w[k][j] = *(const u32x2*)(p[k] + 64 * j);
#pragma unroll
            for (int j = 0; j < 16; ++j) { const f32x4 g2v = *(const LAS f32x4*)(g2p + 64 * j);
#pragma unroll
                for (int k = 0; k < 2; ++k) { const f32x4 t = g2v * gt[k];
                    hv[j][0] += t[0] * bflo(w[k][j].x); hv[j][1] += t[1] * bfhi(w[k][j].x); hv[j][2] += t[2] * bflo(w[k][j].y); hv[j][3] += t[3] * bfhi(w[k][j].y); }
                if ((j & 3) == 3) __builtin_amdgcn_sched_barrier(0); }
        }
        float s = 0.f;
#pragma unroll
        for (int j = 0; j < 16; ++j) s += (hv[j][0] + hv[j][1]) + (hv[j][2] + hv[j][3]);
        const float mean = row16_sum(s) * (1.0f / D); float q = 0.f;
#pragma unroll
        for (int j = 0; j < 16; ++j) { hv[j] = hv[j] - mean; q += (hv[j][0] * hv[j][0] + hv[j][1] * hv[j][1]) + (hv[j][2] * hv[j][2] + hv[j][3] * hv[j][3]); }
        const float rstd = 1.0f / sqrtf(row16_sum(q) * (1.0f / D) + LN_EPS);
#pragma unroll
        for (int j = 0; j < 16; ++j) { const int c = 4 * li + 64 * j;
            const f32x4 y = hv[j] * rstd * *(const LAS f32x4*)(lgl + c) + *(const LAS f32x4*)(lbl + c);
            if (l + 1 < DEPTH) { *(f32x4*)(Hb + (size_t)row * D + c) = y; const f32x4 uu = y * *(const LAS f32x4*)(scl + c) + *(const LAS f32x4*)(shl + c);
                u32x2 w; w.x = cvt_pk_bf16(uu[0], uu[1]); w.y = cvt_pk_bf16(uu[2], uu[3]); *(u32x2*)(U1b + (size_t)row * D + c) = w; }
            else *(f32x4*)(C.out + (size_t)row * D + c) = y;
            if ((j & 3) == 3) __builtin_amdgcn_sched_barrier(0);
        }
    }
    __syncthreads();
}

constexpr int PH_PER_LAYER = 11, N_PHASES = 2 + DEPTH * PH_PER_LAYER;
__global__ void __launch_bounds__(512, 2) mega(Args args) {
    extern __shared__ __attribute__((aligned(16))) unsigned char lds_raw[];
#define MKCTX() Ctx C; { GAS unsigned char* w_ = (GAS unsigned char*)args.ws; asm volatile("" : "+s"(w_)); int t_ = threadIdx.x; asm volatile("" : "+v"(t_)); \
        C.lds = (LAS unsigned char*)lds_raw; C.ws = w_; C.in = args.in; C.out = args.out; C.tid = t_; C.lane = t_ & 63; C.wave = __builtin_amdgcn_readfirstlane(t_ >> 6); C.bid = (gridDim.x & 7u) ? blockIdx.x : (blockIdx.x & 7u) * (gridDim.x >> 3) + (blockIdx.x >> 3); C.G = gridDim.x; }
    LAS unsigned char* lds0 = (LAS unsigned char*)lds_raw;
    volatile LAS unsigned* misc = (volatile LAS unsigned*)(lds0 + LDS_MISC);
    if (threadIdx.x < 4) misc[threadIdx.x] = 0u;
    __syncthreads();
    const int lo = args.ph_lo, hi = args.ph_hi;
    const bool multi = (hi - lo) > 1;
    XcdBarrier bar; bar.bar = (unsigned*)(args.ws + WS_CTL) + 4096; bar.x = 0; bar.st = misc;
    if (multi) bar = xcd_barrier_post((unsigned*)(args.ws + WS_CTL) + 4096, misc);
#ifndef PHASE_MASK
#define PHASE_MASK 0xFFFFu
#endif
#define PM(i) (((PHASE_MASK) >> (i)) & 1u)
#define IN(k) (lo <= (k) && (k) < hi)
#define SEAM(k) do { if (IN((k) + 1)) xcd_barrier(bar); } while (0)
    if (PM(0) && IN(0)) { MKCTX(); phase_prep(C); SEAM(0); }
    if (PM(1) && IN(1)) { MKCTX(); phase_init(C); SEAM(1); }
    for (int l = 0; l < DEPTH; ++l) {
        const int p0 = 2 + l * PH_PER_LAYER;
        const int nrows = (l < DEPTH - 1) ? T : TL, mt = (l < DEPTH - 1) ? 9 : 8;
        if (PM(2) && IN(p0 + 0)) { MKCTX(); phase_inproj(C, l); SEAM(p0 + 0); }
        if (PM(3) && IN(p0 + 1)) { MKCTX(); phase_b0(C, l); SEAM(p0 + 1); }
        if (PM(4) && IN(p0 + 2)) { MKCTX(); phase_b1(C, l); SEAM(p0 + 2); }
        if (PM(5) && IN(p0 + 3)) { MKCTX(); phase_c1(C, l, nrows); if (l < DEPTH - 1 && blk_k(C) >= 16) slot_dn(C, l + 1, blk_x(C) * 16 + blk_k(C) - 16, DN_C1_FIRST, DN_C1_CNT); SEAM(p0 + 3); }
        if (PM(6) && IN(p0 + 4)) { MKCTX(); phase_c2(C, l, nrows); if (l < DEPTH - 1 && blk_k(C) >= 16) slot_gu(C, l + 1, blk_x(C) * 16 + blk_k(C) - 16, GU_C2_FIRST, GU_C2_CNT); SEAM(p0 + 4); }
        if (PM(7) && IN(p0 + 5)) { MKCTX(); phase_d(C, l, nrows); if (l < DEPTH - 1 && blk_k(C) >= 16) slot_gu(C, l + 1, blk_x(C) * 16 + blk_k(C) - 16, GU_D_FIRST, GU_D_CNT); SEAM(p0 + 5); }
        if (PM(8) && IN(p0 + 6)) { MKCTX(); phase_e(C, l, nrows); if (l < DEPTH - 1 && blk_k(C) >= 8) slot_dn(C, l + 1, blk_x(C) * 24 + blk_k(C) - 8, DN_E_FIRST, DN_E_CNT); SEAM(p0 + 6); }
        if (PM(9) && IN(p0 + 7)) { MKCTX(); phase_f(C, l); if (l < DEPTH - 1 && blk_k(C) >= 16) slot_gu(C, l + 1, blk_x(C) * 16 + blk_k(C) - 16, GU_F_FIRST, GU_F_CNT); SEAM(p0 + 7); }
        if (PM(10) && IN(p0 + 8)) { MKCTX(); phase_g(C, l, mt); SEAM(p0 + 8); }
        if (PM(11) && IN(p0 + 9)) { MKCTX(); phase_h(C, l, mt); SEAM(p0 + 9); }
        if (PM(12) && IN(p0 + 10)) { MKCTX(); phase_i(C, l, nrows); if (l < DEPTH - 1 && blk_k(C) >= 8) slot_dn(C, l + 1, blk_x(C) * 24 + blk_k(C) - 8, DN_I_FIRST, DN_I_CNT); SEAM(p0 + 10); }
    }
#undef IN
#undef SEAM
}

#ifdef DBG_STOP
__global__ void dbg_dump(const unsigned char* src, int mode, float* out, size_t n) {
    for (size_t i = (size_t)blockIdx.x * blockDim.x + threadIdx.x; i < n; i += (size_t)gridDim.x * blockDim.x) {
        if (mode == 0) out[i] = (float)((const unsigned short*)src)[i];
        else out[i] = (float)(((const unsigned*)src)[i] >> 8);
    }
}
__global__ void dbg_scan(const unsigned char* src, size_t n, int mode, float mark, float* out) {
    const size_t t = (size_t)blockIdx.x * blockDim.x + threadIdx.x, NT = (size_t)gridDim.x * blockDim.x;
    bool bad = false;
    for (size_t i = t; i < n; i += NT) { const float v = mode == 0 ? __uint_as_float(((unsigned)((const unsigned short*)src)[i]) << 16) : ((const float*)src)[i]; if (!(fabsf(v) < 1e6f)) bad = true; }
    out[t] = bad ? mark : 0.0f;
}
__global__ void dbg_check(const float* const* dummy, const float* x, const float* c, const float* cctx, const float* wmod, const float* bmod, const float* win, const unsigned char* ws, float* out) {
    const size_t t = (size_t)blockIdx.x * blockDim.x + threadIdx.x;
    const float* MOD = (const float*)(ws + WS_MOD); const bf16* WIN = (const bf16*)(ws + WS_WIN); const bf16* U1 = (const bf16*)(ws + WS_U1); const bf16* Z = (const bf16*)(ws + WS_Z);
    if ((DBG_SEG & 1) && t < 9 * 6144) { const int r = (int)(t / 6144), n = (int)(t % 6144); double s = 0; for (int k = 0; k < 1024; ++k) { const float v = r < 8 ? c[r * 1024 + k] : cctx[k]; s += (double)(v / (1.0f + expf(-v))) * wmod[(size_t)k * 6144 + n]; }
        s += bmod[n]; const float got = MOD[(size_t)r * 6144 + n]; out[t] = (fabs(got - s) > 1e-3 * fabs(s) + 1e-4) ? 1e6f : 0.f; }
    if (DBG_SEG & 2) { const size_t idx = (t * 6661) % ((size_t)1696 * 1024); const int n = (int)(idx / 1024), k = (int)(idx % 1024); const float ref = win[(size_t)k * IN_COLS + n] * (n < 256 ? NA_QS : 1.0f);
      const float got = __uint_as_float(((unsigned)WIN[(size_t)n * 1024 + k]) << 16); out[262144 + t] = (fabsf(got - ref) > 0.01f * fabsf(ref) + 1e-6f) ? 1e5f : 0.f; }
    if (DBG_SEG & 4) { const size_t idx = (t * 7919) % ((size_t)TL * 1024); const int row = (int)(idx / 1024), k = (int)(idx % 1024), r = row >> 11; const float ref = x[idx] * (1.0f + MOD[(size_t)r * 6144 + 1024 + k]) + MOD[(size_t)r * 6144 + k];
      const float got = __uint_as_float(((unsigned)U1[idx]) << 16); out[2 * 262144 + t] = (fabsf(got - ref) > 0.01f * fabsf(ref) + 1e-3f) ? 1e4f : 0.f; }
    if (DBG_SEG & 8) { const size_t idx = (t * 104729) % ((size_t)T * 1696); const int row = (int)(idx / 1696), col = (int)(idx % 1696); float sref = 0.f;
      for (int k = 0; k < 1024; ++k) sref += __uint_as_float(((unsigned)U1[(size_t)row * 1024 + k]) << 16) * __uint_as_float(((unsigned)WIN[(size_t)col * 1024 + k]) << 16);
      const float got = __uint_as_float(((unsigned)Z[(size_t)row * NZ + col]) << 16); out[3 * 262144 + t] = (fabsf(got - sref) > 0.02f * fabsf(sref) + 0.05f) ? 1e3f : 0.f; }
}
#endif
extern "C" void kernel_launch(void* const* d_in, const int* in_sizes, int n_in, void* d_out, int out_size, void* d_ws, size_t ws_size, hipStream_t stream) {
    static int grid = 0;
    if (grid == 0) {
        if (n_in != 24 || ws_size < WS_END) { fprintf(stderr, "kernel_launch: unexpected inputs (n_in %d, ws %zu, need %zu)\n", n_in, ws_size, (size_t)WS_END); grid = -1; return; }
        int dev = 0, cus = 0, per_cu = 0;
        if (hipGetDevice(&dev) != hipSuccess || hipDeviceGetAttribute(&cus, hipDeviceAttributeMultiprocessorCount, dev) != hipSuccess) { grid = -1; return; }
        if (hipFuncSetAttribute((const void*)mega, hipFuncAttributeMaxDynamicSharedMemorySize, LDS_BYTES) != hipSuccess) { fprintf(stderr, "kernel_launch: hipFuncSetAttribute failed\n"); grid = -1; return; }
        if (hipOccupancyMaxActiveBlocksPerMultiprocessor(&per_cu, (const void*)mega, 512, LDS_BYTES) != hipSuccess || per_cu < 1) fprintf(stderr, "kernel_launch: occupancy query says %d\n", per_cu);
        (void)hipGetLastError();
        grid = cus;
    }
    if (grid < 0) return;
#ifdef POISON_WS
    (void)hipMemsetAsync((char*)d_ws, 0x00, WS_END, stream);
#endif
    (void)hipMemsetAsync((char*)d_ws + WS_CTL, 0, CTL_BYTES, stream);
    Args a{};
    for (int i = 0; i < 24; ++i) a.in[i] = (const float*)d_in[i];
    a.out = (float*)d_out; a.ws = (unsigned char*)d_ws;
#if ONE_LAUNCH
    a.ph_lo = 0; a.ph_hi = N_PHASES;
    hipLaunchKernelGGL(mega, dim3(grid), dim3(512), LDS_BYTES, stream, a);
#else
#ifdef DBG_STOP
    for (int p = 0; p <= DBG_STOP; ++p) { a.ph_lo = p; a.ph_hi = p + 1; hipLaunchKernelGGL(mega, dim3(grid), dim3(512), LDS_BYTES, stream, a); }
    (void)hipMemsetAsync(d_out, 0, (size_t)out_size * 4, stream);
    hipLaunchKernelGGL(dbg_check, dim3(1024), dim3(256), 0, stream, (const float* const*)nullptr, (const float*)d_in[I_X], (const float*)d_in[I_C], (const float*)d_in[I_CCTX], (const float*)d_in[I_WMOD], (const float*)d_in[I_BMOD], (const float*)d_in[I_WIN], (const unsigned char*)d_ws, (float*)d_out);
#else
    for (int p = 0; p < N_PHASES; ++p) { a.ph_lo = p; a.ph_hi = p + 1; hipLaunchKernelGGL(mega, dim3(grid), dim3(512), LDS_BYTES, stream, a); }
#endif
#endif
}
```
